# Optimizing an MI355X kernel written in HIP

```python
import math
import jax
import jax.numpy as jnp
from jax import lax
import numpy as np


D_MODEL = 2048
BATCH = 8
SEQ = 4096
DEPTH = 2

GRID_W = 64
EPS = 1e-6
A_HEADS = 8
A_DK = 128
A_DV = 128
A_CHUNK = 64
CONV_W = 5
B_HEADS = 8
B_KV_HEADS = 2
B_HD = 128
Q_BLOCK = 128
ROPE_THETA = 10000.0
C_WIDTH = 2048
C_GROUPS = 16
C_CHUNK = 128

A_W = A_HEADS * A_DK
B_W = B_HEADS * B_HD
B_KV_W = B_KV_HEADS * B_HD
IN0_SIZES = (A_W, A_W, A_HEADS * A_DV, A_HEADS * A_DV, 4 * A_HEADS, B_W, B_KV_W, B_KV_W, B_W)

kernel_name = "hybrid_deltanet_gqa_gmlp_encoder"


def rms_norm(x, g):
    xf = x.astype(jnp.float32)
    y = xf * lax.rsqrt(jnp.mean(xf * xf, axis=-1, keepdims=True) + EPS)
    return (y * g.astype(jnp.float32)).astype(x.dtype)


def layer_norm(x, g, b):
    xf = x.astype(jnp.float32)
    mu = jnp.mean(xf, axis=-1, keepdims=True)
    var = jnp.mean(jnp.square(xf - mu), axis=-1, keepdims=True)
    y = (xf - mu) * lax.rsqrt(var + EPS) * g.astype(jnp.float32) + b.astype(jnp.float32)
    return y.astype(x.dtype)


def l2norm(t):
    tf = t.astype(jnp.float32)
    return tf * lax.rsqrt(jnp.sum(tf * tf, axis=-1, keepdims=True) + EPS)


def split_cols(t, sizes):
    offs = []
    acc = 0
    for s in sizes[:-1]:
        acc += s
        offs.append(acc)
    return jnp.split(t, offs, axis=-1)


def centred_dwconv(x, w):
    pad = w.shape[0] // 2
    return lax.conv_general_dilated(
        x, w[:, None, :].astype(x.dtype), window_strides=(1,), padding=[(pad, pad)],
        dimension_numbers=("NWC", "WIO", "NWC"), feature_group_count=x.shape[-1])


def gated_delta_chunked(q, k, v, g, beta):
    f32 = jnp.float32
    bsz, nh, L, dk = q.shape
    dv = v.shape[-1]
    C = A_CHUNK
    n = L // C
    q = (q.astype(f32) * (dk ** -0.5)).reshape(bsz, nh, n, C, dk)
    k = k.astype(f32).reshape(bsz, nh, n, C, dk)
    v = v.astype(f32).reshape(bsz, nh, n, C, dv)
    g = jnp.cumsum(g.astype(f32).reshape(bsz, nh, n, C), axis=-1)
    beta = beta.astype(f32).reshape(bsz, nh, n, C)
    idx = jnp.arange(C)
    incl = idx[:, None] >= idx[None, :]
    strict = idx[:, None] > idx[None, :]
    decay = jnp.exp(jnp.where(incl, g[..., :, None] - g[..., None, :], -jnp.inf))
    k_beta = k * beta[..., None]
    m = jnp.where(strict, jnp.einsum('bhnid,bhnjd->bhnij', k_beta, k) * decay, 0.0)
    eye = jnp.eye(C, dtype=f32)
    t_inv = lax.linalg.triangular_solve(eye + m, jnp.broadcast_to(eye, m.shape),
                                        left_side=True, lower=True, unit_diagonal=True)
    u = jnp.einsum('bhnij,bhnje->bhnie', t_inv, v * beta[..., None])
    w = jnp.einsum('bhnij,bhnjd->bhnid', t_inv, k_beta * jnp.exp(g)[..., None])
    attn = jnp.einsum('bhnid,bhnjd->bhnij', q, k) * decay
    q_dec = q * jnp.exp(g)[..., None]
    k_dec = k * jnp.exp(g[..., -1:] - g)[..., None]
    g_last = jnp.exp(g[..., -1])
    xs = tuple(jnp.moveaxis(t, 2, 0) for t in (q_dec, k_dec, u, w, attn, g_last))

    def step(S, inp):
        q_c, k_c, u_c, w_c, a_c, gl_c = inp
        v_new = u_c - jnp.einsum('bhcd,bhde->bhce', w_c, S)
        o_c = jnp.einsum('bhcd,bhde->bhce', q_c, S) + jnp.einsum('bhij,bhje->bhie', a_c, v_new)
        S = S * gl_c[..., None, None] + jnp.einsum('bhcd,bhce->bhde', k_c, v_new)
        return S, o_c

    S0 = jnp.zeros((bsz, nh, dk, dv), f32)
    _, o = lax.scan(step, S0, xs)
    return jnp.moveaxis(o, 0, 2).reshape(bsz, nh, L, dv)


def mixer_a(aq, ak, av, agate, alog_in, conv_w, a_log, dt_bias, onorm_g):
    bsz, L, _ = aq.shape
    qkv = jax.nn.silu(centred_dwconv(jnp.concatenate([aq, ak, av], axis=-1), conv_w))
    q, k, v = split_cols(qkv, (A_W, A_W, A_HEADS * A_DV))
    q = l2norm(jnp.transpose(q.reshape(bsz, L, A_HEADS, A_DK), (0, 2, 1, 3)))
    k = l2norm(jnp.transpose(k.reshape(bsz, L, A_HEADS, A_DK), (0, 2, 1, 3)))
    v = jnp.transpose(v.reshape(bsz, L, A_HEADS, A_DV), (0, 2, 1, 3))
    a_f, a_b, b_f, b_b = jnp.split(alog_in.astype(jnp.float32), 4, axis=-1)

    def log_decay(a, d):
        gd = -jnp.exp(a_log[d].astype(jnp.float32)) * jax.nn.softplus(a + dt_bias[d].astype(jnp.float32))
        return jnp.transpose(gd, (0, 2, 1))

    def flip(t):
        return jnp.flip(t, axis=2)

    o_f = gated_delta_chunked(q, k, v, log_decay(a_f, 0), jnp.transpose(jax.nn.sigmoid(b_f), (0, 2, 1)))
    o_b = flip(gated_delta_chunked(flip(q), flip(k), flip(v), flip(log_decay(a_b, 1)),
                                   flip(jnp.transpose(jax.nn.sigmoid(b_b), (0, 2, 1)))))
    o = jnp.transpose(o_f + o_b, (0, 2, 1, 3))
    o = rms_norm(o, onorm_g).reshape(bsz, L, A_HEADS * A_DV)
    return (o * jax.nn.silu(agate.astype(jnp.float32))).astype(aq.dtype)


def axial_rope_tables(L):
    rows = L // GRID_W
    t = jnp.arange(rows * GRID_W)
    row = (t // GRID_W).astype(jnp.float32)
    col = (t % GRID_W).astype(jnp.float32)
    n_freq = B_HD // 4
    inv = ROPE_THETA ** (-jnp.arange(n_freq, dtype=jnp.float32) / n_freq)
    ang = jnp.concatenate([row[:, None] * inv, col[:, None] * inv], axis=-1)
    return jnp.cos(ang), jnp.sin(ang)


def apply_axial_rope(x, cos, sin):
    xf = x.astype(jnp.float32)
    nf = B_HD // 4
    half = B_HD // 2
    c = cos[None, :, None, :]
    s = sin[None, :, None, :]

    def rot(xh, cc, ss):
        x1 = xh[..., :nf]
        x2 = xh[..., nf:]
        return jnp.concatenate([x1 * cc - x2 * ss, x2 * cc + x1 * ss], axis=-1)

    out = jnp.concatenate([rot(xf[..., :half], c[..., :nf], s[..., :nf]),
                           rot(xf[..., half:], c[..., nf:], s[..., nf:])], axis=-1)
    return out.astype(x.dtype)


def mixer_b(bq, bk, bv, bgate, qn_g, kn_g):
    bsz, L, _ = bq.shape
    grp = B_HEADS // B_KV_HEADS
    q = rms_norm(bq.reshape(bsz, L, B_HEADS, B_HD), qn_g)
    k = rms_norm(bk.reshape(bsz, L, B_KV_HEADS, B_HD), kn_g)
    v = bv.reshape(bsz, L, B_KV_HEADS, B_HD)
    cos, sin = axial_rope_tables(L)
    q = apply_axial_rope(q, cos, sin)
    k = apply_axial_rope(k, cos, sin)
    q = jnp.moveaxis(q.reshape(bsz, L // Q_BLOCK, Q_BLOCK, B_KV_HEADS, grp, B_HD), 1, 0)
    scale = B_HD ** -0.5

    def attend(qb):
        s = jnp.einsum('bqkgd,bskd->bkgqs', qb, k, preferred_element_type=jnp.float32) * scale
        p = jax.nn.softmax(s, axis=-1)
        return jnp.einsum('bkgqs,bskd->bqkgd', p.astype(v.dtype), v)

    o = lax.map(attend, q)
    o = jnp.moveaxis(o, 0, 1).reshape(bsz, L, B_W)
    return o * jax.nn.silu(bgate)


def hybrid_layer(x, norm_g, w_in, conv_w, a_log, dt_bias, a_onorm_g, qn_g, kn_g, w_out):
    h = rms_norm(x, norm_g)
    aq, ak, av, agate, alog_in, bq, bk, bv, bgate = split_cols(h @ w_in, IN0_SIZES)
    ya = mixer_a(aq, ak, av, agate, alog_in, conv_w, a_log, dt_bias, a_onorm_g)
    yb = mixer_b(bq, bk, bv, bgate, qn_g, kn_g)
    return x + jnp.concatenate([ya, yb.astype(ya.dtype)], axis=-1) @ w_out


def gmlp_layer(x, norm_g, w_in, ln_g, ln_b, w_s, b_s, w_out):
    bsz, L, _ = x.shape
    h = rms_norm(x, norm_g)
    u, v, gate = jnp.split(h @ w_in, 3, axis=-1)
    u = jax.nn.gelu(u, approximate=False)
    v = layer_norm(jax.nn.gelu(v, approximate=False), ln_g, ln_b)
    n = L // C_CHUNK
    cg = C_WIDTH // C_GROUPS
    vc = v.reshape(bsz, n, C_CHUNK, C_GROUPS, cg)
    s = jnp.einsum('gts,bnsgc->bntgc', w_s, vc) + jnp.transpose(b_s)[None, None, :, :, None]
    z = u * s.reshape(bsz, L, C_WIDTH) * jax.nn.silu(gate)
    return x + z @ w_out


def setup_inputs(seed: int = 0) -> dict:
    key = jax.random.key(seed)
    ks = jax.random.split(key, 20)
    ne = (DEPTH + 1) // 2
    no = DEPTH // 2
    f32 = jnp.float32

    def nrm(k, shape, scale):
        return jax.random.normal(k, shape, f32) * scale

    in0 = sum(IN0_SIZES)
    x = nrm(ks[0], (BATCH, SEQ, D_MODEL), 1.0)
    norm0_g = 1.0 + nrm(ks[1], (ne, D_MODEL), 0.02)
    w_in0 = nrm(ks[2], (ne, D_MODEL, in0), D_MODEL ** -0.5)
    conv0_w = nrm(ks[3], (ne, CONV_W, 3 * A_W), CONV_W ** -0.5)
    a_log0 = jnp.log(jax.random.uniform(ks[4], (ne, 2, A_HEADS), f32, 1.0, 16.0))
    dt = jnp.exp(jax.random.uniform(ks[5], (ne, 2, A_HEADS), f32, math.log(1e-3), math.log(1e-1)))
    dt_bias0 = dt + jnp.log(-jnp.expm1(-dt))
    a_onorm_g0 = 1.0 + nrm(ks[6], (ne, A_DV), 0.02)
    b_qnorm_g0 = 1.0 + nrm(ks[7], (ne, B_HD), 0.02)
    b_knorm_g0 = 1.0 + nrm(ks[8], (ne, B_HD), 0.02)
    w_out0 = nrm(ks[9], (ne, A_HEADS * A_DV + B_W, D_MODEL), (A_HEADS * A_DV + B_W) ** -0.5)
    norm1_g = 1.0 + nrm(ks[10], (no, D_MODEL), 0.02)
    w_in1 = nrm(ks[11], (no, D_MODEL, 3 * C_WIDTH), D_MODEL ** -0.5)
    c_ln_g1 = 1.0 + nrm(ks[12], (no, C_WIDTH), 0.02)
    c_ln_b1 = nrm(ks[13], (no, C_WIDTH), 0.02)
    c_ws1 = nrm(ks[14], (no, C_GROUPS, C_CHUNK, C_CHUNK), C_CHUNK ** -0.5)
    c_bs1 = 1.0 + nrm(ks[15], (no, C_GROUPS, C_CHUNK), 0.01)
    w_out1 = nrm(ks[16], (no, C_WIDTH, D_MODEL), C_WIDTH ** -0.5)
    return {"x": x, "norm0_g": norm0_g, "w_in0": w_in0, "conv0_w": conv0_w, "a_log0": a_log0,
            "dt_bias0": dt_bias0, "a_onorm_g0": a_onorm_g0, "b_qnorm_g0": b_qnorm_g0,
            "b_knorm_g0": b_knorm_g0, "w_out0": w_out0, "norm1_g": norm1_g, "w_in1": w_in1,
            "c_ln_g1": c_ln_g1, "c_ln_b1": c_ln_b1, "c_ws1": c_ws1, "c_bs1": c_bs1, "w_out1": w_out1}


def reference(x, norm0_g, w_in0, conv0_w, a_log0, dt_bias0, a_onorm_g0, b_qnorm_g0, b_knorm_g0, w_out0,
              norm1_g, w_in1, c_ln_g1, c_ln_b1, c_ws1, c_bs1, w_out1):
    for layer in range(DEPTH):
        i = layer // 2
        if layer % 2 == 0:
            x = hybrid_layer(x, norm0_g[i], w_in0[i], conv0_w[i], a_log0[i], dt_bias0[i],
                             a_onorm_g0[i], b_qnorm_g0[i], b_knorm_g0[i], w_out0[i])
        else:
            x = gmlp_layer(x, norm1_g[i], w_in1[i], c_ln_g1[i], c_ln_b1[i], c_ws1[i], c_bs1[i], w_out1[i])
    return x
```

```cpp
#include <hip/hip_runtime.h>
#include <hip/hip_cooperative_groups.h>
#include <cstdio>
#include <cstdint>
namespace cg = cooperative_groups;
#ifndef MK_LAUNCHES
#define MK_LAUNCHES 1
#define DUP_PHASE -1

#endif
namespace pg8 {
#define PG8_LAS __attribute__((address_space(3)))
typedef unsigned short bf16_t;
typedef short bf16x8 __attribute__((ext_vector_type(8)));
typedef float f32x4 __attribute__((ext_vector_type(4)));
typedef unsigned u32x4 __attribute__((ext_vector_type(4)));
constexpr int BM = 256, BK = 64, HALF = 128, HTB = HALF * BK * 2  , STAGE_BYTES = 8 * HTB, NXCD = 8, WGM = 8;

__host__ __device__ __forceinline__ int lds_byte(int r, int c) { const int st = (r >> 4) * 2 + (c >> 5), rr = r & 15, cc = c & 31, ob = rr * 64 + cc * 2; return st * 1024 + (ob ^ (((ob >> 9) & 1) << 5)); }
__host__ __device__ __forceinline__ void stage_rc(int b, int& R, int& C) { const int st = b / 1024, sb = b % 1024, swz = sb ^ (((sb >> 9) & 1) << 5); R = (st >> 1) * 16 + swz / 64; C = (st & 1) * 32 + (swz % 64) / 2; }
__host__ __device__ __forceinline__ int perm32(int rho) { const int n = rho >> 4, i = rho & 15; return 8 * (i >> 2) + 4 * n + (i & 3); }

struct Unit { int pm, pn; };
struct Gemm { const bf16_t* A; const bf16_t* Bt; int M, N, K, ld; };

struct StaticOrder {
    int nM, nN, nwg, G, c;
    __host__ __device__ void init(int M, int N, int G_, int c_) { nM = M / BM; nN = N / BM; nwg = nM * nN; G = G_; c = c_; }
    __host__ __device__ bool next(int i, Unit& u) const {
        const long L = (long)i * G + c; if (L >= nwg) return false;
        int wgid = (int)L; { const int q = nwg / NXCD, r = nwg % NXCD, xcd = wgid % NXCD, off = wgid / NXCD; wgid = (xcd < r ? xcd * (q + 1) : r * (q + 1) + (xcd - r) * q) + off; }
        const int nig = WGM * nN, gid = wgid / nig, fm = gid * WGM, gsz = (nM - fm) < WGM ? (nM - fm) : WGM;
        u.pm = fm + ((wgid % nig) % gsz); u.pn = (wgid % nig) / gsz; return true;
    }
    __device__ __forceinline__ void a_ready(const Unit&) const {}
    __device__ __forceinline__ void done(const Unit&) const {}
};

typedef float f32x2c_t __attribute__((ext_vector_type(2))); typedef __bf16 bf16x2c_t __attribute__((ext_vector_type(2)));
__device__ __forceinline__ unsigned cvt_pk_bf16(float lo, float hi) { f32x2c_t v = {lo, hi}; bf16x2c_t b = __builtin_convertvector(v, bf16x2c_t); return __builtin_bit_cast(unsigned, b); }
typedef float f32x2 __attribute__((ext_vector_type(2)));
__device__ __forceinline__ f32x2 gelu_pk(f32x2 v) {
    const f32x2 av = __builtin_elementwise_abs(v), d = av * 0.2316418882f + 1.0f;
    f32x2 t; t.x = __builtin_amdgcn_rcpf(d.x); t.y = __builtin_amdgcn_rcpf(d.y);
    f32x2 q = t * 0.5307027145f + (-0.7265760135f); q = q * t + 0.7107068705f; q = q * t + (-0.142248368f); q = q * t + 0.127414796f; q = q * t;
    const f32x2 s = (v * v) * (-0.72134752044f);
    f32x2 e; e.x = __builtin_amdgcn_exp2f(s.x); e.y = __builtin_amdgcn_exp2f(s.y);
    const f32x2 m = v * (q * e), r = v - m;
    f32x2 o; o.x = v.x < 0.f ? m.x : r.x; o.y = v.y < 0.f ? m.y : r.y; return o;
}

template <class Epi, class Sched, bool ALIGN_EPI = false, bool SP2 = false>
__device__ __forceinline__ void gemm_phase(PG8_LAS unsigned char* lds, const Gemm g, const Sched& S, const Epi& E) {
    const int tid = threadIdx.x, wid = __builtin_amdgcn_readfirstlane(tid >> 6), lane = tid & 63, wr = wid >> 2, wc = wid & 3, fr = lane & 15, fq = lane >> 4;
    const int K = g.ld, nt = g.K / BK;
    unsigned voffA[2], voffB[2];
#pragma unroll
    for (int i = 0; i < 2; ++i) { int R, C; stage_rc(tid * 16 + i * 8192, R, C); const int Rb = Epi::PERM ? ((R & ~31) + perm32(R & 31)) : R;
        voffA[i] = (unsigned)(R * K + C) * 2u; voffB[i] = (unsigned)(Rb * K + C) * 2u; }
    const size_t kstep = (size_t)(BK * 2);
    const size_t hstep = (size_t)HALF * K * 2;
    const size_t tstep = 2 * hstep;
    const unsigned ldsw = (unsigned)wid * 1024u;
    const int aoff = lds_byte(wr * 64 + fr, fq * 8), boff = lds_byte(wc * 32 + fr, fq * 8);
#define PG8_SA(b, h) (((b) * 2 + (h)) * HTB)
#define PG8_SB(b, h) ((4 + (b) * 2 + (h)) * HTB)
#define PG8_STAGE(bufoff, gbase, voff) do { _Pragma("unroll") for (int _i = 0; _i < 2; ++_i) \
        __builtin_amdgcn_global_load_lds((const unsigned*)((const char*)(gbase) + (voff)[_i]), (PG8_LAS unsigned*)(lds + (bufoff) + ldsw + _i * 8192), 16, 0, 0); } while (0)
#define PG8_LDA(dst, b, h) do { _Pragma("unroll") for (int m = 0; m < 4; ++m) _Pragma("unroll") for (int k = 0; k < 2; ++k) dst[m][k] = *(const PG8_LAS bf16x8*)(lds + PG8_SA(b, h) + aoff + m * 2048 + k * 1024); } while (0)
#define PG8_LDB(dst, b, h) do { _Pragma("unroll") for (int n = 0; n < 2; ++n) _Pragma("unroll") for (int k = 0; k < 2; ++k) dst[n][k] = *(const PG8_LAS bf16x8*)(lds + PG8_SB(b, h) + boff + n * 2048 + k * 1024); } while (0)
#define PG8_MMA(ai, bj, At, Bt) do { __builtin_amdgcn_s_setprio(1); _Pragma("unroll") for (int m = 0; m < 4; ++m) _Pragma("unroll") for (int n = 0; n < 2; ++n) _Pragma("unroll") for (int k = 0; k < 2; ++k) \
        acc[ai][bj][m][n] = __builtin_amdgcn_mfma_f32_16x16x32_bf16(Bt[n][k], At[m][k], acc[ai][bj][m][n], 0, 0, 0); __builtin_amdgcn_s_setprio(0); } while (0)
#define PG8_WAIT_V(n) asm volatile("s_waitcnt vmcnt(" #n ")" ::: "memory")
#define PG8_WAIT_L(n) asm volatile("s_waitcnt lgkmcnt(" #n ")" ::: "memory")
#define PG8_BAR __builtin_amdgcn_s_barrier()
#define PG8_SCHED __builtin_amdgcn_sched_barrier(0)
    Unit cur, nxt; int ui = 0;
    if (!S.next(0, cur)) return;
    f32x4 acc[2][2][4][2];
#pragma unroll
    for (int a = 0; a < 2; ++a)
#pragma unroll
        for (int b = 0; b < 2; ++b)
#pragma unroll
            for (int m = 0; m < 4; ++m)
#pragma unroll
                for (int n = 0; n < 2; ++n) acc[a][b][m][n] = (f32x4){0.f, 0.f, 0.f, 0.f};
    bf16x8 At[4][2], B0[2][2], B1[2][2];
    const char* cA = (const char*)g.A + (size_t)cur.pm * tstep; const char* cB = (const char*)g.Bt + (size_t)cur.pn * tstep;
    S.a_ready(cur);
    if constexpr (SP2) {
        PG8_STAGE(PG8_SB(0, 0), cB, voffB); PG8_STAGE(PG8_SB(0, 1), cB + hstep, voffB); PG8_STAGE(PG8_SA(0, 0), cA, voffA); PG8_STAGE(PG8_SA(0, 1), cA + hstep, voffA);
        if (wr == 1) PG8_BAR;
        PG8_WAIT_V(2); PG8_BAR;
        PG8_STAGE(PG8_SB(1, 0), cB + kstep, voffB); PG8_STAGE(PG8_SA(1, 0), cA + kstep, voffA); PG8_STAGE(PG8_SB(1, 1), cB + hstep + kstep, voffB);
        PG8_WAIT_V(6); PG8_BAR;
    } else {
        PG8_STAGE(PG8_SB(0, 0), cB, voffB); PG8_STAGE(PG8_SA(0, 0), cA, voffA); PG8_STAGE(PG8_SB(0, 1), cB + hstep, voffB); PG8_STAGE(PG8_SA(0, 1), cA + hstep, voffA);
        if (wr == 1) PG8_BAR;
        PG8_WAIT_V(4); PG8_BAR;
        PG8_STAGE(PG8_SB(1, 0), cB + kstep, voffB); PG8_STAGE(PG8_SA(1, 0), cA + kstep, voffA); PG8_STAGE(PG8_SB(1, 1), cB + hstep + kstep, voffB);
        PG8_WAIT_V(6); PG8_BAR;
    }
    for (;;) {
        const bool has_next = S.next(ui + 1, nxt);
        const char* nA = has_next ? (const char*)g.A + (size_t)nxt.pm * tstep : cA; const char* nB = has_next ? (const char*)g.Bt + (size_t)nxt.pn * tstep : cB;
        for (int t = 0; t < nt; t += 2) {
            const bool last = (t == nt - 2);
            const char* a1 = cA + (size_t)(t + 1) * kstep;
            const char* a2 = last ? nA : cA + (size_t)(t + 2) * kstep; const char* b2 = last ? nB : cB + (size_t)(t + 2) * kstep;
            const char* a3 = a2 + kstep; const char* b3 = b2 + kstep;
            if (last && has_next) S.a_ready(nxt);
            if constexpr (SP2) {
            PG8_LDB(B0, 0, 0); PG8_LDB(B1, 0, 1); PG8_SCHED; PG8_LDA(At, 0, 0); PG8_STAGE(PG8_SA(1, 1), a1 + hstep, voffA);
            PG8_WAIT_V(8); PG8_WAIT_L(0); PG8_BAR; PG8_MMA(0, 0, At, B0); PG8_MMA(0, 1, At, B1); PG8_BAR; PG8_SCHED;
            PG8_LDA(At, 0, 1); PG8_STAGE(PG8_SB(0, 0), b2, voffB); PG8_STAGE(PG8_SB(0, 1), b2 + hstep, voffB); PG8_STAGE(PG8_SA(0, 0), a2, voffA);
            PG8_WAIT_V(8); PG8_WAIT_L(0); PG8_BAR; PG8_MMA(1, 0, At, B0); PG8_MMA(1, 1, At, B1); PG8_BAR; PG8_SCHED;
            PG8_LDB(B0, 1, 0); PG8_LDB(B1, 1, 1); PG8_SCHED; PG8_LDA(At, 1, 0); PG8_STAGE(PG8_SA(0, 1), a2 + hstep, voffA);
            PG8_WAIT_V(8); PG8_WAIT_L(0); PG8_BAR; PG8_MMA(0, 0, At, B0); PG8_MMA(0, 1, At, B1); PG8_BAR; PG8_SCHED;
            PG8_LDA(At, 1, 1); PG8_STAGE(PG8_SB(1, 0), b3, voffB); PG8_STAGE(PG8_SB(1, 1), b3 + hstep, voffB); PG8_STAGE(PG8_SA(1, 0), a3, voffA);
            PG8_WAIT_V(8); PG8_WAIT_L(0); PG8_BAR; PG8_MMA(1, 0, At, B0); PG8_MMA(1, 1, At, B1); PG8_BAR; PG8_SCHED;
            } else {
            PG8_LDB(B0, 0, 0); PG8_SCHED; PG8_LDA(At, 0, 0); PG8_STAGE(PG8_SA(1, 1), a1 + hstep, voffA);
            PG8_WAIT_L(8); PG8_BAR; PG8_WAIT_L(0); PG8_MMA(0, 0, At, B0); PG8_BAR; PG8_SCHED;
            PG8_LDB(B1, 0, 1); PG8_STAGE(PG8_SB(0, 0), b2, voffB);
            PG8_BAR; PG8_WAIT_L(0); PG8_MMA(0, 1, At, B1); PG8_BAR;
            PG8_LDA(At, 0, 1); PG8_STAGE(PG8_SA(0, 0), a2, voffA);
            PG8_BAR; PG8_WAIT_L(0); PG8_MMA(1, 0, At, B0); PG8_BAR; PG8_SCHED;
            PG8_STAGE(PG8_SB(0, 1), b2 + hstep, voffB);
            PG8_WAIT_V(6); PG8_BAR; PG8_MMA(1, 1, At, B1); PG8_BAR;
            PG8_LDB(B0, 1, 0); PG8_SCHED; PG8_LDA(At, 1, 0); PG8_STAGE(PG8_SA(0, 1), a2 + hstep, voffA);
            PG8_WAIT_L(8); PG8_BAR; PG8_WAIT_L(0); PG8_MMA(0, 0, At, B0); PG8_BAR; PG8_SCHED;
            PG8_LDB(B1, 1, 1); PG8_STAGE(PG8_SB(1, 0), b3, voffB);
            PG8_BAR; PG8_WAIT_L(0); PG8_MMA(0, 1, At, B1); PG8_BAR;
            PG8_LDA(At, 1, 1); PG8_STAGE(PG8_SA(1, 0), a3, voffA);
            PG8_BAR; PG8_WAIT_L(0); PG8_MMA(1, 0, At, B0); PG8_BAR; PG8_SCHED;
            PG8_STAGE(PG8_SB(1, 1), b3 + hstep, voffB);
            PG8_WAIT_V(6); PG8_BAR; PG8_MMA(1, 1, At, B1); PG8_BAR;
            }
        }
        if constexpr (ALIGN_EPI) { if (wr == 0) PG8_BAR; }
        if constexpr (!Epi::AFTER_DRAIN) { E(acc, cur, wr, wc, fr, fq); S.done(cur); }
        if (!has_next) break;
#pragma unroll
        for (int a = 0; a < 2; ++a)
#pragma unroll
            for (int b = 0; b < 2; ++b)
#pragma unroll
                for (int m = 0; m < 4; ++m)
#pragma unroll
                    for (int n = 0; n < 2; ++n) acc[a][b][m][n] = (f32x4){0.f, 0.f, 0.f, 0.f};
        cur = nxt; cA = nA; cB = nB; ++ui;
        if constexpr (ALIGN_EPI) { if (wr == 1) PG8_BAR; }
    }
    PG8_WAIT_V(0);
    if constexpr (!ALIGN_EPI) { if (wr == 0) PG8_BAR; }
    PG8_BAR;
    if constexpr (Epi::AFTER_DRAIN) { E.fused(acc, cur, wr, wc, fr, fq, lds, wid, lane); S.done(cur); }
#undef PG8_SA
#undef PG8_SB
#undef PG8_STAGE
#undef PG8_LDA
#undef PG8_LDB
#undef PG8_MMA
#undef PG8_WAIT_V
#undef PG8_WAIT_L
#undef PG8_BAR
#undef PG8_SCHED
}
}
#define LAS __attribute__((address_space(3)))
typedef unsigned short bf16_t;
typedef short bf16x8 __attribute__((ext_vector_type(8)));
typedef short s16x4 __attribute__((ext_vector_type(4)));
typedef float f32x4 __attribute__((ext_vector_type(4)));
typedef float f32x8 __attribute__((ext_vector_type(8)));
typedef float f32x16 __attribute__((ext_vector_type(16)));
typedef unsigned u32x4 __attribute__((ext_vector_type(4)));
typedef unsigned u32x2 __attribute__((ext_vector_type(2)));
using pg8::cvt_pk_bf16;

constexpr int NB = 8, SEQ = 4096, DM = 2048, TOK = NB * SEQ;
constexpr int N0P = 6912, P0LD = 6656, N1 = 6144;
constexpr int C_AQ = 0, C_AK = 1024, C_AV = 2048, C_AG = 3072, C_BQ = 4096, C_BK = 5120, C_BV = 5376, C_BG = 5632;
constexpr float EPS = 1e-6f;
constexpr int NTHR = 512, NWAVES = 8;
constexpr int LDS_BYTES = 159744;
constexpr size_t WS_CTL = 0;
constexpr size_t WS_W0T = 4096;
constexpr size_t WS_WO0T = WS_W0T + (size_t)N0P * DM * 2;
constexpr size_t WS_W1T = WS_WO0T + (size_t)DM * DM * 2;
constexpr size_t WS_WO1T = WS_W1T + (size_t)N1 * DM * 2;
constexpr size_t WS_H = WS_WO1T + (size_t)DM * DM * 2;
constexpr size_t WS_PROJ = WS_H + (size_t)TOK * DM * 2;
constexpr size_t WS_LOG = WS_PROJ + (size_t)TOK * P0LD * 2;
constexpr size_t WS_QKV = WS_LOG + (size_t)TOK * 32 * 4 * 2;
constexpr size_t WS_YCAT = WS_QKV + (size_t)TOK * 3072 * 2;
constexpr size_t WS_PART = WS_YCAT + (size_t)TOK * DM * 2;
constexpr size_t WS_RSTD = WS_PART + (size_t)TOK * 32 * 4;
constexpr size_t WS_VST = WS_RSTD + (size_t)TOK * 4;
constexpr size_t WS_END = WS_VST + (size_t)TOK * 32 * 2 * 4;

#define LDS_WAIT() asm volatile("s_waitcnt lgkmcnt(0)" ::: "memory")
__device__ __forceinline__ float bf2f(bf16_t v) { return __builtin_bit_cast(float, (unsigned)v << 16); }
__device__ __forceinline__ float bflo(unsigned w) { return __builtin_bit_cast(float, w << 16); }
__device__ __forceinline__ float bfhi(unsigned w) { return __builtin_bit_cast(float, w & 0xffff0000u); }
__device__ __forceinline__ bf16_t f2bf(float f) { return (bf16_t)(cvt_pk_bf16(f, 0.f) & 0xffffu); }
__device__ __forceinline__ float silu_f(float x) { return x * __builtin_amdgcn_rcpf(1.f + __expf(-x)); }
__device__ __forceinline__ float wave_sum(float v) {
#pragma unroll
    for (int o = 1; o < 64; o <<= 1) v += __shfl_xor(v, o);
    return v;
}
__device__ __forceinline__ int crow(int r, int hi) { return (r & 3) + 8 * (r >> 2) + 4 * hi; }
__device__ __forceinline__ void unpack8(u32x4 w, float* f) {
    f[0] = bflo(w.x); f[1] = bfhi(w.x); f[2] = bflo(w.y); f[3] = bfhi(w.y); f[4] = bflo(w.z); f[5] = bfhi(w.z); f[6] = bflo(w.w); f[7] = bfhi(w.w);
}
__device__ __forceinline__ u32x4 pack8(const float* f) {
    u32x4 w; w.x = cvt_pk_bf16(f[0], f[1]); w.y = cvt_pk_bf16(f[2], f[3]); w.z = cvt_pk_bf16(f[4], f[5]); w.w = cvt_pk_bf16(f[6], f[7]); return w;
}

namespace pg8 {
struct OneUnit { int pm;
    __device__ __forceinline__ bool next(int i, Unit& u) const { if (i) return false; u.pm = pm; u.pn = 0; return true; }
    __device__ __forceinline__ void a_ready(const Unit&) const {}
    __device__ __forceinline__ void done(const Unit&) const {} };
struct EpiLog {
    static constexpr bool PERM = true, AFTER_DRAIN = false;
    float* LOG;
    __device__ __forceinline__ void operator()(const f32x4 (&acc)[2][2][4][2], const Unit& u, int wr, int wc, int fr, int fq) const {
        const int row0 = u.pm * BM + wr * 64 + fr;
        if (wc == 0) {
#pragma unroll
            for (int ai = 0; ai < 2; ++ai)
#pragma unroll
                for (int m = 0; m < 4; ++m) { float* lp = LOG + (size_t)(row0 + ai * HALF + m * 16) * 32 + 8 * fq;
                    *(f32x4*)lp = acc[ai][0][m][0]; *(f32x4*)(lp + 4) = acc[ai][0][m][1]; }
        }
    }
};
struct Epi0 {
    static constexpr bool PERM = true, AFTER_DRAIN = false;
    bf16_t* P; float* LOG;
    __device__ __forceinline__ void operator()(const f32x4 (&acc)[2][2][4][2], const Unit& u, int wr, int wc, int fr, int fq) const {
        const int row0 = u.pm * BM + wr * 64 + fr;
        if (u.pn < 26) {
            const int col0 = u.pn * BM + wc * 32 + 8 * fq;
#pragma unroll
            for (int ai = 0; ai < 2; ++ai)
#pragma unroll
                for (int m = 0; m < 4; ++m) { bf16_t* rowp = P + (size_t)(row0 + ai * HALF + m * 16) * P0LD + col0;
#pragma unroll
                    for (int bj = 0; bj < 2; ++bj) { const f32x4 v0 = acc[ai][bj][m][0], v1 = acc[ai][bj][m][1];
                        ::u32x4 w; w.x = cvt_pk_bf16(v0[0], v0[1]); w.y = cvt_pk_bf16(v0[2], v0[3]); w.z = cvt_pk_bf16(v1[0], v1[1]); w.w = cvt_pk_bf16(v1[2], v1[3]);
                        *(::u32x4*)(rowp + bj * HALF) = w; } }
        } else if (wc == 0) {
#pragma unroll
            for (int ai = 0; ai < 2; ++ai)
#pragma unroll
                for (int m = 0; m < 4; ++m) { float* lp = LOG + (size_t)(row0 + ai * HALF + m * 16) * 32 + 8 * fq;
                    *(f32x4*)lp = acc[ai][0][m][0]; *(f32x4*)(lp + 4) = acc[ai][0][m][1]; }
        }
    }
};
struct Epi1 {
    static constexpr bool PERM = true, AFTER_DRAIN = false;
    bf16_t* P; const float* RS; float* VST;
    __device__ __forceinline__ void operator()(const f32x4 (&acc)[2][2][4][2], const Unit& u, int wr, int wc, int fr, int fq) const {
        const int row0 = u.pm * BM + wr * 64 + fr; const int col0 = u.pn * BM + wc * 32 + 8 * fq; const bool act = u.pn < 16, vst = u.pn >= 8 && u.pn < 16;
        float rsv[2][4];
#pragma unroll
        for (int ai = 0; ai < 2; ++ai)
#pragma unroll
            for (int m = 0; m < 4; ++m) rsv[ai][m] = RS[row0 + ai * HALF + m * 16];
#pragma unroll
        for (int ai = 0; ai < 2; ++ai)
#pragma unroll
            for (int m = 0; m < 4; ++m) { const int row = row0 + ai * HALF + m * 16; const float rs = rsv[ai][m]; bf16_t* rowp = P + (size_t)row * N1 + col0; float s1 = 0.f, s2 = 0.f;
#pragma unroll
                for (int bj = 0; bj < 2; ++bj) { f32x4 v0 = acc[ai][bj][m][0] * rs, v1 = acc[ai][bj][m][1] * rs;
                    if (act) { f32x2 a = gelu_pk((f32x2){v0[0], v0[1]}), b = gelu_pk((f32x2){v0[2], v0[3]}), c = gelu_pk((f32x2){v1[0], v1[1]}), d = gelu_pk((f32x2){v1[2], v1[3]});
                        v0 = (f32x4){a.x, a.y, b.x, b.y}; v1 = (f32x4){c.x, c.y, d.x, d.y}; }
                    if (vst) { s1 += (v0[0] + v0[1]) + (v0[2] + v0[3]) + (v1[0] + v1[1]) + (v1[2] + v1[3]);
                        s2 += (v0[0] * v0[0] + v0[1] * v0[1]) + (v0[2] * v0[2] + v0[3] * v0[3]) + (v1[0] * v1[0] + v1[1] * v1[1]) + (v1[2] * v1[2] + v1[3] * v1[3]); }
                    ::u32x4 w; w.x = cvt_pk_bf16(v0[0], v0[1]); w.y = cvt_pk_bf16(v0[2], v0[3]); w.z = cvt_pk_bf16(v1[0], v1[1]); w.w = cvt_pk_bf16(v1[2], v1[3]);
                    *(::u32x4*)(rowp + bj * HALF) = w; }
                if (vst) { s1 += __shfl_xor(s1, 16); s1 += __shfl_xor(s1, 32); s2 += __shfl_xor(s2, 16); s2 += __shfl_xor(s2, 32);
                    if (fq == 0) *(f32x2*)(VST + ((size_t)row * 32 + (u.pn - 8) * 4 + wc) * 2) = (f32x2){s1, s2}; } }
    }
};
struct EpiRes0 {
    static constexpr bool PERM = true, AFTER_DRAIN = false;
    const float* X; bf16_t* XB; float* PART;
    __device__ __forceinline__ void operator()(const f32x4 (&acc)[2][2][4][2], const Unit& u, int wr, int wc, int fr, int fq) const {
        const int row0 = u.pm * BM + wr * 64 + fr; const int col0 = u.pn * BM + wc * 32 + 8 * fq;
#pragma unroll
        for (int ai = 0; ai < 2; ++ai) {
            f32x4 xr[4][2][2];
#pragma unroll
            for (int m = 0; m < 4; ++m)
#pragma unroll
                for (int bj = 0; bj < 2; ++bj) { const size_t off = (size_t)(row0 + ai * HALF + m * 16) * DM + col0 + bj * HALF; xr[m][bj][0] = *(const f32x4*)(X + off); xr[m][bj][1] = *(const f32x4*)(X + off + 4); }
#pragma unroll
            for (int m = 0; m < 4; ++m) { const int row = row0 + ai * HALF + m * 16; const size_t off = (size_t)row * DM + col0; float ss = 0.f;
#pragma unroll
                for (int bj = 0; bj < 2; ++bj) { const f32x4 v0 = xr[m][bj][0] + acc[ai][bj][m][0], v1 = xr[m][bj][1] + acc[ai][bj][m][1];
                    ss += (v0[0] * v0[0] + v0[1] * v0[1]) + (v0[2] * v0[2] + v0[3] * v0[3]) + (v1[0] * v1[0] + v1[1] * v1[1]) + (v1[2] * v1[2] + v1[3] * v1[3]);
                    ::u32x4 w; w.x = cvt_pk_bf16(v0[0], v0[1]); w.y = cvt_pk_bf16(v0[2], v0[3]); w.z = cvt_pk_bf16(v1[0], v1[1]); w.w = cvt_pk_bf16(v1[2], v1[3]);
                    *(::u32x4*)(XB + off + bj * HALF) = w; }
                ss += __shfl_xor(ss, 16); ss += __shfl_xor(ss, 32);
                if (fq == 0) PART[(size_t)row * 32 + u.pn * 4 + wc] = ss; } }
    }
};
struct EpiRes1 {
    static constexpr bool PERM = true, AFTER_DRAIN = false;
    const bf16_t* XB; float* O;
    __device__ __forceinline__ void operator()(const f32x4 (&acc)[2][2][4][2], const Unit& u, int wr, int wc, int fr, int fq) const {
        const int row0 = u.pm * BM + wr * 64 + fr; const int col0 = u.pn * BM + wc * 32 + 8 * fq;
        ::u32x4 xbv[2][4][2];
#pragma unroll
        for (int ai = 0; ai < 2; ++ai)
#pragma unroll
            for (int m = 0; m < 4; ++m)
#pragma unroll
                for (int bj = 0; bj < 2; ++bj) xbv[ai][m][bj] = *(const ::u32x4*)(XB + (size_t)(row0 + ai * HALF + m * 16) * DM + col0 + bj * HALF);
#pragma unroll
        for (int ai = 0; ai < 2; ++ai)
#pragma unroll
            for (int m = 0; m < 4; ++m) { const size_t off = (size_t)(row0 + ai * HALF + m * 16) * DM + col0;
#pragma unroll
                for (int bj = 0; bj < 2; ++bj) { const ::u32x4 xb = xbv[ai][m][bj];
                    const f32x4 r0 = {::bflo(xb.x), ::bfhi(xb.x), ::bflo(xb.y), ::bfhi(xb.y)}, r1 = {::bflo(xb.z), ::bfhi(xb.z), ::bflo(xb.w), ::bfhi(xb.w)};
                    *(f32x4*)(O + off + bj * HALF) = r0 + acc[ai][bj][m][0]; *(f32x4*)(O + off + bj * HALF + 4) = r1 + acc[ai][bj][m][1]; } }
    }
};
}
__device__ __forceinline__ void transpose_item(const float* __restrict__ W, int K, int Nsrc, int src_n0, bf16_t* __restrict__ WT, int dst_n0, int k0, LAS float* scr, int lane, const float* __restrict__ kscale = nullptr) {
    { const int n4 = (lane & 7) * 4; f32x4 tv[8];
#pragma unroll
        for (int i = 0; i < 8; ++i) { const int kk = (lane >> 3) + 8 * i;
            tv[i] = (src_n0 >= 0) ? *(const f32x4*)(W + (size_t)(k0 + kk) * Nsrc + src_n0 + n4) * (kscale ? kscale[k0 + kk] : 1.f) : (f32x4){0.f, 0.f, 0.f, 0.f}; }
#pragma unroll
        for (int i = 0; i < 8; ++i) { const int kk = (lane >> 3) + 8 * i; LAS float* d = scr + kk * 33 + n4; d[0] = tv[i].x; d[1] = tv[i].y; d[2] = tv[i].z; d[3] = tv[i].w; } }
    LDS_WAIT(); asm volatile("" ::: "memory");
    const int c = lane & 7;
#pragma unroll
    for (int j = 0; j < 4; ++j) { const int n = (lane >> 3) + 8 * j; const LAS float* s = scr + (8 * c) * 33 + n;
        u32x4 o; o.x = cvt_pk_bf16(s[0 * 33], s[1 * 33]); o.y = cvt_pk_bf16(s[2 * 33], s[3 * 33]); o.z = cvt_pk_bf16(s[4 * 33], s[5 * 33]); o.w = cvt_pk_bf16(s[6 * 33], s[7 * 33]);
        *(u32x4*)(WT + (size_t)(dst_n0 + n) * K + k0 + 8 * c) = o; }
    LDS_WAIT(); asm volatile("" ::: "memory");
}
__device__ __forceinline__ void rms_row(const float* __restrict__ xrow, const float* __restrict__ g, bf16_t* __restrict__ orow, int lane) {
    const f32x4* xr = (const f32x4*)xrow + lane; f32x4 v[8]; float s = 0.f;
#pragma unroll
    for (int j = 0; j < 8; ++j) { v[j] = xr[64 * j]; s += (v[j].x * v[j].x + v[j].y * v[j].y) + (v[j].z * v[j].z + v[j].w * v[j].w); }
    const float r = 1.0f / sqrtf(wave_sum(s) * (1.f / DM) + EPS);
    const f32x4* gr = (const f32x4*)g + lane; u32x2* o8 = (u32x2*)orow + lane;
#pragma unroll
    for (int j = 0; j < 8; ++j) { const f32x4 gg = gr[64 * j]; u32x2 w; w.x = cvt_pk_bf16(v[j].x * r * gg.x, v[j].y * r * gg.y); w.y = cvt_pk_bf16(v[j].z * r * gg.z, v[j].w * r * gg.w); o8[64 * j] = w; }
}
__device__ __forceinline__ void rms_row2(const float* __restrict__ xa, const float* __restrict__ xb, const float* __restrict__ g, bf16_t* __restrict__ oa, bf16_t* __restrict__ ob, int lane) {
    const f32x4* xra = (const f32x4*)xa + lane; const f32x4* xrb = (const f32x4*)xb + lane; f32x4 va[8], vb[8]; float sa = 0.f, sb = 0.f;
#pragma unroll
    for (int j = 0; j < 8; ++j) { va[j] = xra[64 * j]; vb[j] = xrb[64 * j]; }
#pragma unroll
    for (int j = 0; j < 8; ++j) { sa += (va[j].x * va[j].x + va[j].y * va[j].y) + (va[j].z * va[j].z + va[j].w * va[j].w); sb += (vb[j].x * vb[j].x + vb[j].y * vb[j].y) + (vb[j].z * vb[j].z + vb[j].w * vb[j].w); }
    const float ra = 1.0f / sqrtf(wave_sum(sa) * (1.f / DM) + EPS), rb = 1.0f / sqrtf(wave_sum(sb) * (1.f / DM) + EPS);
    const f32x4* gr = (const f32x4*)g + lane; u32x2* o8a = (u32x2*)oa + lane; u32x2* o8b = (u32x2*)ob + lane;
#pragma unroll
    for (int j = 0; j < 8; ++j) { const f32x4 gg = gr[64 * j]; u32x2 w;
        w.x = cvt_pk_bf16(va[j].x * ra * gg.x, va[j].y * ra * gg.y); w.y = cvt_pk_bf16(va[j].z * ra * gg.z, va[j].w * ra * gg.w); o8a[64 * j] = w;
        w.x = cvt_pk_bf16(vb[j].x * rb * gg.x, vb[j].y * rb * gg.y); w.y = cvt_pk_bf16(vb[j].z * rb * gg.z, vb[j].w * rb * gg.w); o8b[64 * j] = w; }
}
struct P0Args { const float* x; const float* g0; const float* g1; const float* w_in0; const float* w_out0; const float* w_in1; const float* w_out1; bf16_t* W0T; bf16_t* WO0T; bf16_t* W1T; bf16_t* WO1T; bf16_t* H; };
__device__ __forceinline__ void p0_prologue(const P0Args& a, LAS unsigned char* lds, int gw, int NGW, int wave, int lane) {
    LAS float* scr = (LAS float*)(lds + wave * 16384);
    constexpr int I0 = 32 * (N0P / 32), IO = 32 * (DM / 32), I1 = 32 * (N1 / 32);
    constexpr int NITEMS = I0 + IO + I1 + IO;
    for (int it = gw; it < NITEMS; it += NGW) {
        int r = it;
        if (r < I0) { const int nblk = N0P / 32, kb = r / nblk, nb = r % nblk, d0 = 32 * nb;
            const int src = d0 < 4096 ? d0 : (d0 < 6656 ? d0 + 32 : (d0 == 6656 ? 4096 : -1));
            transpose_item(a.w_in0, DM, 6688, src, a.W0T, d0, 64 * kb, scr, lane); continue; }
        r -= I0;
        if (r < IO) { const int nblk = DM / 32, kb = r / nblk, nb = r % nblk; transpose_item(a.w_out0, DM, DM, 32 * nb, a.WO0T, 32 * nb, 64 * kb, scr, lane); continue; }
        r -= IO;
        if (r < I1) { const int nblk = N1 / 32, kb = r / nblk, nb = r % nblk; transpose_item(a.w_in1, DM, N1, 32 * nb, a.W1T, 32 * nb, 64 * kb, scr, lane, a.g1); continue; }
        r -= I1;
        { const int nblk = DM / 32, kb = r / nblk, nb = r % nblk; transpose_item(a.w_out1, DM, DM, 32 * nb, a.WO1T, 32 * nb, 64 * kb, scr, lane); }
    }
    for (int m = gw; m < TOK; m += 2 * NGW) rms_row2(a.x + (size_t)m * DM, a.x + (size_t)(m + NGW) * DM, a.g0, a.H + (size_t)m * DM, a.H + (size_t)(m + NGW) * DM, lane);
}

__device__ __forceinline__ void p2_conv_item(const bf16_t* __restrict__ P, const float* __restrict__ cw, bf16_t* __restrict__ QKV, int item, int lane) {
    const int run = item / 6, slice = item % 6, t0 = run * 16, b = t0 / SEQ, l0 = t0 % SEQ, ch0 = slice * 512 + lane * 8;
    float w[5][8];
#pragma unroll
    for (int j = 0; j < 5; ++j) { const f32x4 a = *(const f32x4*)(cw + j * 3072 + ch0), c = *(const f32x4*)(cw + j * 3072 + ch0 + 4);
        w[j][0] = a.x; w[j][1] = a.y; w[j][2] = a.z; w[j][3] = a.w; w[j][4] = c.x; w[j][5] = c.y; w[j][6] = c.z; w[j][7] = c.w; }
    u32x4 rows[20];
#pragma unroll
    for (int r = 0; r < 20; ++r) { const int l = l0 - 2 + r, lc = l < 0 ? 0 : (l >= SEQ ? SEQ - 1 : l);
        rows[r] = *(const u32x4*)(P + (size_t)(b * SEQ + lc) * P0LD + ch0);
        if (l != lc) rows[r] = (u32x4){0u, 0u, 0u, 0u}; }
    float win[5][8];
#pragma unroll
    for (int j = 0; j < 5; ++j)
#pragma unroll
        for (int e = 0; e < 8; ++e) win[j][e] = 0.f;
#pragma unroll
    for (int r = 0; r < 20; ++r) {
#pragma unroll
        for (int j = 0; j < 4; ++j)
#pragma unroll
            for (int e = 0; e < 8; ++e) win[j][e] = win[j + 1][e];
        unpack8(rows[r], win[4]);
        if (r >= 4) {
            float y[8]; float ss = 0.f;
#pragma unroll
            for (int e = 0; e < 8; ++e) { float acc = 0.f;
#pragma unroll
                for (int j = 0; j < 5; ++j) acc = fmaf(w[j][e], win[j][e], acc);
                y[e] = silu_f(acc); ss = fmaf(y[e], y[e], ss); }
            if (slice < 4) {
                ss += __shfl_xor(ss, 1); ss += __shfl_xor(ss, 2); ss += __shfl_xor(ss, 4); ss += __shfl_xor(ss, 8);
                const float rn = 1.0f / sqrtf(ss + EPS);
#pragma unroll
                for (int e = 0; e < 8; ++e) y[e] *= rn;
            }
            *(u32x4*)(QKV + (size_t)(t0 + r - 4) * 3072 + ch0) = pack8(y);
        }
    }
}

template <int NT>
__device__ __forceinline__ void p2_rope_tokens(bf16_t* __restrict__ P, const float* __restrict__ qn_g, const float* __restrict__ kn_g, int t0, int tstride, int lane) {
    const int half = lane >> 5, i = lane & 31;
    const float inv = exp2f(-(float)i * (13.287712379549449f / 32.f));
    const int e1 = half * 64 + i, e2 = e1 + 32;
    const float gq1 = qn_g[e1], gq2 = qn_g[e2], gk1 = kn_g[e1], gk2 = kn_g[e2];
    float x1[NT][10], x2[NT][10];
#pragma unroll
    for (int k = 0; k < NT; ++k) { const bf16_t* row = P + (size_t)(t0 + k * tstride) * P0LD;
#pragma unroll
        for (int hh = 0; hh < 10; ++hh) { const bf16_t* hp = row + (hh < 8 ? C_BQ + hh * 128 : C_BK + (hh - 8) * 128); x1[k][hh] = bf2f(hp[e1]); x2[k][hh] = bf2f(hp[e2]); } }
#pragma unroll
    for (int k = 0; k < NT; ++k) { const int t = t0 + k * tstride, l = t % SEQ; bf16_t* row = P + (size_t)t * P0LD;
        const float pos = half ? (float)(l % 64) : (float)(l / 64);
        float rev = pos * inv * 0.15915494309189535f; rev -= floorf(rev);
        const float sn = __builtin_amdgcn_sinf(rev), cs = __builtin_amdgcn_cosf(rev);
#pragma unroll
        for (int hh = 0; hh < 10; ++hh) {
            bf16_t* hp = row + (hh < 8 ? C_BQ + hh * 128 : C_BK + (hh - 8) * 128);
            const float ss = wave_sum(x1[k][hh] * x1[k][hh] + x2[k][hh] * x2[k][hh]);
            const float rn = 1.0f / sqrtf(ss * (1.f / 128.f) + EPS);
            const float y1 = x1[k][hh] * rn * (hh < 8 ? gq1 : gk1), y2 = x2[k][hh] * rn * (hh < 8 ? gq2 : gk2);
            hp[e1] = f2bf(y1 * cs - y2 * sn); hp[e2] = f2bf(y2 * cs + y1 * sn);
        } }
}

template <int NT>
__device__ __forceinline__ void p4_tokens(const bf16_t* __restrict__ OF, const bf16_t* __restrict__ OB, const bf16_t* __restrict__ P, const float* __restrict__ og, bf16_t* __restrict__ Y, int t0, int lane) {
    u32x4 ra[NT][2], rb[NT][2], rg[NT][2];
#pragma unroll
    for (int k = 0; k < NT; ++k)
#pragma unroll
        for (int i = 0; i < 2; ++i) { const int col0 = i * 512 + lane * 8; const size_t t = (size_t)(t0 + k);
            ra[k][i] = *(const u32x4*)(OF + t * 1024 + col0); rb[k][i] = *(const u32x4*)(OB + t * 1024 + col0); rg[k][i] = *(const u32x4*)(P + t * P0LD + C_AG + col0); }
#pragma unroll
    for (int k = 0; k < NT; ++k)
#pragma unroll
        for (int i = 0; i < 2; ++i) { const int col0 = i * 512 + lane * 8; float a[8], b[8], g[8], y[8];
            unpack8(ra[k][i], a); unpack8(rb[k][i], b); unpack8(rg[k][i], g);
            float ss = 0.f;
#pragma unroll
            for (int e = 0; e < 8; ++e) { a[e] += b[e]; ss = fmaf(a[e], a[e], ss); }
            ss += __shfl_xor(ss, 1); ss += __shfl_xor(ss, 2); ss += __shfl_xor(ss, 4); ss += __shfl_xor(ss, 8);
            const float rn = 1.0f / sqrtf(ss * (1.f / 128.f) + EPS);
            const int e0 = col0 & 127;
#pragma unroll
            for (int e = 0; e < 8; ++e) y[e] = a[e] * rn * og[e0 + e] * silu_f(g[e]);
            *(u32x4*)(Y + (size_t)(t0 + k) * DM + col0) = pack8(y); }
}
namespace att {
constexpr int D = 128, NW = 8, QBLK = 32, KVBLK = 64;
constexpr float SCALE = 0.088388347648318440f;
constexpr float THR = 8.f;
constexpr int SDEPTH = 2;
constexpr int LDQ = P0LD, LDK = P0LD;
constexpr size_t SHM_V = KVBLK * D * 2, SHM_K = KVBLK * D * 2, SHM_ATTN = 2 * SHM_V + 2 * SHM_K + NW * 64 * 4;
#define KSWZ(row, colB) ((row) * 256 + ((colB) ^ (((row) & 7) << 4)))
#define SBAR() __builtin_amdgcn_sched_barrier(0)
__device__ __forceinline__ unsigned cvtpk(float lo, float hi) { unsigned r; asm volatile("v_cvt_pk_bf16_f32 %0, %1, %2" : "=v"(r) : "v"(lo), "v"(hi)); return r; }
__device__ __forceinline__ void partialSM(f32x16& p0, f32x16& p1, float& m_reg, float& mn, float& alpha) {
  constexpr float C = SCALE * 1.4426950408889634f;
  float pmax = p0[0]; for (int r = 1; r < 16; ++r) pmax = fmaxf(pmax, p0[r]); for (int r = 0; r < 16; ++r) pmax = fmaxf(pmax, p1[r]);
  { auto rr = __builtin_amdgcn_permlane32_swap(__float_as_uint(pmax), __float_as_uint(pmax), false, false);
    pmax = fmaxf(__uint_as_float(rr[0]), __uint_as_float(rr[1])); }
  if (__builtin_expect(__all(pmax - m_reg <= THR / SCALE), 1)) { mn = m_reg; alpha = 1.f; }
  else { mn = fmaxf(m_reg, pmax); alpha = __builtin_amdgcn_exp2f((m_reg - mn) * C); m_reg = mn; }
  float mnC = -mn * C;
  for (int r = 0; r < 16; ++r) p0[r] = fmaf(p0[r], C, mnC); for (int r = 0; r < 16; ++r) p1[r] = fmaf(p1[r], C, mnC);
  for (int r = 0; r < 16; ++r) p0[r] = __builtin_amdgcn_exp2f(p0[r]);
}
__device__ __forceinline__ void finishSM(f32x16& p0, f32x16& p1, float alpha, float& l_reg, bf16x8& pa0, bf16x8& pa1, bf16x8& pa2, bf16x8& pa3) {
  for (int r = 0; r < 16; ++r) p1[r] = __builtin_amdgcn_exp2f(p1[r]);
  float ps = 0; for (int r = 0; r < 16; ++r) ps += p0[r]; for (int r = 0; r < 16; ++r) ps += p1[r];
  { auto rr = __builtin_amdgcn_permlane32_swap(__float_as_uint(ps), __float_as_uint(ps), false, false);
    ps = __uint_as_float(rr[0]) + __uint_as_float(rr[1]); }
  l_reg = l_reg * alpha + ps;
#define PK4(P, BASE, OUT) do { unsigned a0 = cvtpk(P[BASE + 0], P[BASE + 1]), a1 = cvtpk(P[BASE + 2], P[BASE + 3]);   \
    unsigned b0 = cvtpk(P[BASE + 4], P[BASE + 5]), b1 = cvtpk(P[BASE + 6], P[BASE + 7]);                              \
    auto r0 = __builtin_amdgcn_permlane32_swap(a0, b0, false, false); auto r1 = __builtin_amdgcn_permlane32_swap(a1, b1, false, false); \
    u32x4 w = {r0[0], r1[0], r0[1], r1[1]}; OUT = *reinterpret_cast<bf16x8*>(&w); } while (0)
  PK4(p0, 0, pa0); PK4(p0, 8, pa1); PK4(p1, 0, pa2); PK4(p1, 8, pa3);
#undef PK4
}
__device__ __forceinline__ void qkt(f32x16& p0, f32x16& p1, const bf16_t* Ks, const bf16x8* qr, int r32, int hi) {
  p0 = f32x16{}; p1 = f32x16{};
  for (int d0 = 0; d0 < 8; ++d0) { int cb = (d0 * 16 + hi * 8) * 2;
    bf16x8 b0 = *reinterpret_cast<const bf16x8*>((const char*)Ks + KSWZ(r32, cb));
    bf16x8 b1 = *reinterpret_cast<const bf16x8*>((const char*)Ks + KSWZ(32 + r32, cb));
    p0 = __builtin_amdgcn_mfma_f32_32x32x16_bf16(b0, qr[d0], p0, 0, 0, 0);
    p1 = __builtin_amdgcn_mfma_f32_32x32x16_bf16(b1, qr[d0], p1, 0, 0, 0); }
}
__device__ __forceinline__ int v_st(int k, int c) { const int kk = (k & ~0xC) | ((k & 4) << 1) | ((k & 8) >> 1); return ((kk >> 3) * 4 + (c >> 5)) * 512 + ((kk & 7) * 32 + (c & 31)) * 2; }
__device__ __forceinline__ int v_rd_base(int lane) { return ((lane & 3) << 3) | (((lane >> 2) & 3) << 6) | (((lane >> 4) & 1) << 5) | (((lane >> 5) & 1) << 8); }
constexpr int v_rd_off(int d0, int ks, int half) { return d0 * 512 + ks * 4096 + half * 2048; }
template <int OFF> __device__ __forceinline__ s16x4 tr_read(int vb) {
  s16x4 r; asm volatile("ds_read_b64_tr_b16 %0, %1 offset:%2" : "=&v"(r) : "v"(vb), "i"(OFF) : "memory"); return r;
}
template <int D0> __device__ __forceinline__ void pv_one(f32x16& od, int vb, bf16x8 pa0, bf16x8 pa1, bf16x8 pa2, bf16x8 pa3) {
  const s16x4 l0 = tr_read<v_rd_off(D0, 0, 0)>(vb), h0 = tr_read<v_rd_off(D0, 0, 1)>(vb), l1 = tr_read<v_rd_off(D0, 1, 0)>(vb), h1 = tr_read<v_rd_off(D0, 1, 1)>(vb);
  const s16x4 l2 = tr_read<v_rd_off(D0, 2, 0)>(vb), h2 = tr_read<v_rd_off(D0, 2, 1)>(vb), l3 = tr_read<v_rd_off(D0, 3, 0)>(vb), h3 = tr_read<v_rd_off(D0, 3, 1)>(vb);
  asm volatile("s_waitcnt lgkmcnt(0)" ::: "memory"); SBAR();
#define PK(L, H) (bf16x8){L[0], L[1], L[2], L[3], H[0], H[1], H[2], H[3]}
  od = __builtin_amdgcn_mfma_f32_32x32x16_bf16(pa0, PK(l0, h0), od, 0, 0, 0);
  od = __builtin_amdgcn_mfma_f32_32x32x16_bf16(pa1, PK(l1, h1), od, 0, 0, 0);
  od = __builtin_amdgcn_mfma_f32_32x32x16_bf16(pa2, PK(l2, h2), od, 0, 0, 0);
  od = __builtin_amdgcn_mfma_f32_32x32x16_bf16(pa3, PK(l3, h3), od, 0, 0, 0);
#undef PK
}
__device__ __forceinline__ void pv_d0(f32x16* o, int vb, bf16x8 pa0, bf16x8 pa1, bf16x8 pa2, bf16x8 pa3) {
  pv_one<0>(o[0], vb, pa0, pa1, pa2, pa3); pv_one<1>(o[1], vb, pa0, pa1, pa2, pa3); pv_one<2>(o[2], vb, pa0, pa1, pa2, pa3); pv_one<3>(o[3], vb, pa0, pa1, pa2, pa3);
}
__device__ __forceinline__ void attn_dense_body(const bf16_t* __restrict__ Qb, const bf16_t* __restrict__ Kh, const bf16_t* __restrict__ Vh,
                                                const bf16_t* __restrict__ Gb, bf16_t* __restrict__ Yb, int seq, char* lds) {
  int tid = threadIdx.x; asm volatile("" : "+v"(tid));
  const int wid = tid >> 6, lane = tid & 63, r32 = lane & 31, hi = lane >> 5;
  bf16_t* V_lds = (bf16_t*)lds; bf16_t* K_lds = (bf16_t*)(lds + 2 * SHM_V);
  float* ws = (float*)(lds + 2 * SHM_V + 2 * SHM_K) + wid * 64; float* li_l = ws; float* al_l = ws + 32;
  float m_reg = -1e30f, l_reg = 0; f32x16 o[4] = {}; bf16x8 qr[8];
  const bf16_t* Qw = Qb + (long)(wid * QBLK + r32) * LDQ + hi * 8;
#pragma unroll
  for (int d0 = 0; d0 < 8; ++d0) qr[d0] = *reinterpret_cast<const bf16x8*>(Qw + d0 * 16);
  const int sr = tid >> 4, sc = (tid & 15) * 8, vst0 = v_st(sr, sc), vst1 = v_st(32 + sr, sc);
  const int vb0 = (int)(uintptr_t)V_lds + v_rd_base(lane);
  struct { bf16x8 vs0, vs1, ks0, ks1; } sr_[SDEPTH];
  const unsigned voff0 = (unsigned)((sr * LDK + sc) * 2), voff1 = voff0 + (unsigned)(32 * LDK * 2);
#define SLOAD(i, k0) do { const char* vb_ = (const char*)Vh + (size_t)(k0) * (LDK * 2); const char* kb_ = (const char*)Kh + (size_t)(k0) * (LDK * 2); \
    sr_[i].vs0 = *reinterpret_cast<const bf16x8*>(vb_ + voff0); sr_[i].vs1 = *reinterpret_cast<const bf16x8*>(vb_ + voff1); \
    sr_[i].ks0 = *reinterpret_cast<const bf16x8*>(kb_ + voff0); sr_[i].ks1 = *reinterpret_cast<const bf16x8*>(kb_ + voff1); } while (0)
#define SWRITE(b, i) do { *(bf16x8*)((char*)V_lds + (b) * SHM_V + vst0) = sr_[i].vs0;          \
    *(bf16x8*)((char*)V_lds + (b) * SHM_V + vst1) = sr_[i].vs1; int kc = sc * 2;               \
    *(bf16x8*)((char*)K_lds + (b) * SHM_K + KSWZ(sr, kc)) = sr_[i].ks0;                       \
    *(bf16x8*)((char*)K_lds + (b) * SHM_K + KSWZ(32 + sr, kc)) = sr_[i].ks1; } while (0)
#define SWAIT() do { if constexpr (SDEPTH == 2) asm volatile("s_waitcnt vmcnt(4)" ::: "memory"); else asm volatile("s_waitcnt vmcnt(0)" ::: "memory"); } while (0)
#define RESC(a) do { if (__any((a) < 1.f)) { if (hi == 0) al_l[r32] = (a); asm volatile("s_waitcnt lgkmcnt(0)" ::: "memory"); \
    for (int d = 0; d < 4; ++d) for (int r = 0; r < 16; ++r) o[d][r] *= al_l[crow(r, hi)]; } } while (0)
  f32x16 pA0, pA1, pB0, pB1; float mnA, mnB, alA, alB; bf16x8 pa0, pa1, pa2, pa3; const int NT = seq / KVBLK;
  constexpr int SE = 0, SO = SDEPTH - 1;
  SLOAD(SE, 0); asm volatile("s_waitcnt vmcnt(0)" ::: "memory"); SWRITE(0, SE); __syncthreads();
  qkt(pA0, pA1, K_lds, qr, r32, hi); partialSM(pA0, pA1, m_reg, mnA, alA);
  SLOAD(SO, KVBLK); if constexpr (SDEPTH == 2) { if (2 < NT) SLOAD(SE, 2 * KVBLK); }
  SWAIT(); SWRITE(1, SO); __syncthreads();
  for (int j = 1; j + 1 < NT; j += 2) {
    SBAR(); qkt(pB0, pB1, (bf16_t*)((char*)K_lds + SHM_K), qr, r32, hi);
    finishSM(pA0, pA1, alA, l_reg, pa0, pa1, pa2, pa3); SBAR();
    SLOAD(SO, (j + SDEPTH) * KVBLK); SBAR();
    pv_d0(o, vb0, pa0, pa1, pa2, pa3); partialSM(pB0, pB1, m_reg, mnB, alB);
    __syncthreads(); SWAIT(); SWRITE(0, SE);
    RESC(alB); __syncthreads();
    SBAR(); qkt(pA0, pA1, K_lds, qr, r32, hi);
    finishSM(pB0, pB1, alB, l_reg, pa0, pa1, pa2, pa3); SBAR();
    if (SDEPTH == 1 || j + 3 < NT) SLOAD(SE, (j + 1 + SDEPTH) * KVBLK); SBAR();
    pv_d0(o, vb0 + (int)SHM_V, pa0, pa1, pa2, pa3); partialSM(pA0, pA1, m_reg, mnA, alA);
    __syncthreads(); SWAIT(); SWRITE(1, SO);
    RESC(alA); __syncthreads();
  }
  SBAR(); qkt(pB0, pB1, (bf16_t*)((char*)K_lds + SHM_K), qr, r32, hi);
  finishSM(pA0, pA1, alA, l_reg, pa0, pa1, pa2, pa3); SBAR();
  pv_d0(o, vb0, pa0, pa1, pa2, pa3); partialSM(pB0, pB1, m_reg, mnB, alB);
  __syncthreads(); RESC(alB);
  finishSM(pB0, pB1, alB, l_reg, pa0, pa1, pa2, pa3); SBAR();
  pv_d0(o, vb0 + (int)SHM_V, pa0, pa1, pa2, pa3);
  if (hi == 0) li_l[r32] = l_reg; asm volatile("s_waitcnt lgkmcnt(0)" ::: "memory");
  float rli[16];
#pragma unroll
  for (int r = 0; r < 16; ++r) rli[r] = __builtin_amdgcn_rcpf(li_l[crow(r, hi)]);
  const bf16_t* Gw = Gb + (long)(wid * QBLK) * LDQ; bf16_t* Yw = Yb + (long)(wid * QBLK) * DM;
  u32x4 graw[8];
#pragma unroll
  for (int it = 0; it < 8; ++it) { const int idx = it * 64 + lane, row = idx >> 4, c8 = (idx & 15) * 8; graw[it] = *(const u32x4*)((const char*)Gw + (unsigned)((row * LDQ + c8) * 2)); }
  __syncthreads();
  { bf16_t* Ol = (bf16_t*)(lds + wid * 8192);
#pragma unroll
    for (int r = 0; r < 16; ++r) { const int orow = crow(r, hi);
#pragma unroll
      for (int d0 = 0; d0 < 4; ++d0) Ol[orow * 128 + d0 * 32 + r32] = f2bf(o[d0][r] * rli[r]); }
    asm volatile("s_waitcnt lgkmcnt(0)" ::: "memory");
#pragma unroll
    for (int it = 0; it < 8; ++it) { const int idx = it * 64 + lane, row = idx >> 4, c8 = (idx & 15) * 8; float ov[8], gv[8];
      unpack8(*(const u32x4*)(Ol + row * 128 + c8), ov); unpack8(graw[it], gv);
#pragma unroll
      for (int e = 0; e < 8; ++e) ov[e] *= silu_f(gv[e]);
      *(u32x4*)((char*)Yw + (unsigned)((row * DM + c8) * 2)) = pack8(ov); } }
  __syncthreads();
#undef SLOAD
#undef SWRITE
#undef SWAIT
#undef RESC
}
}
#ifndef DN_STAGE
#define DN_STAGE 7
#endif
namespace dn {
constexpr int KC_OFF = 0, QC_OFF = 17408, KT_OFF = 34816, VT_OFF = 53248, T1_OFF = VT_OFF + 18432, T2_OFF = T1_OFF + 9216;
constexpr int VN_OFF = VT_OFF, VNS_OFF = VT_OFF + 18432;
constexpr int MT_OFF = 90112, YF_OFF = MT_OFF + 16640, AT_OFF = YF_OFF + 4224, ST_OFF = AT_OFF + 9216, MISC_OFF = ST_OFF + 34816;
static_assert(MISC_OFF + 2048 <= LDS_BYTES - 64, "deltanet LDS map");
constexpr float SCALE = 0.088388347648318440f;
struct Args { const bf16_t* QKV; const float* LOG; const float* a_log; const float* dt_bias; bf16_t* OF; bf16_t* OB; };
__device__ __forceinline__ bf16x8 ldf(const LAS unsigned char* base, int row, int strideB, int kb) { return *(const LAS bf16x8*)(base + row * strideB + kb); }
#define DN_MFMA(a, b, c) __builtin_amdgcn_mfma_f32_32x32x16_bf16(a, b, c, 0, 0, 0)
__device__ __forceinline__ void unit(const Args& a, int un, LAS unsigned char* lds) {
    int tid = threadIdx.x; asm volatile("" : "+v"(tid));
    const int w = __builtin_amdgcn_readfirstlane(tid >> 6), lane = tid & 63, r32 = lane & 31, hi = lane >> 5;
    const int b = un >> 4, h = (un >> 1) & 7, dir = un & 1, wr = w >> 2, wc = w & 3;
    const float Aexp = expf(a.a_log[dir * 8 + h]), dtb = a.dt_bias[dir * 8 + h];
    bf16_t* __restrict__ O = dir ? a.OB : a.OF;
    LAS float* MT = (LAS float*)(lds + MT_OFF); LAS float* YF = (LAS float*)(lds + YF_OFF);
    LAS float* gc = (LAS float*)(lds + MISC_OFF); LAS float* beta = gc + 64; LAS float* eg = gc + 128; LAS float* ekl = gc + 192; LAS float* scal = gc + 256;
    __syncthreads();
    for (int i = tid; i < 34816 / 16; i += NTHR) *(LAS u32x4*)(lds + ST_OFF + i * 16) = (u32x4){0u, 0u, 0u, 0u};
    f32x16 accS[2];
#pragma unroll
    for (int r = 0; r < 16; ++r) { accS[0][r] = 0.f; accS[1][r] = 0.f; }
    u32x4 pq[2], pk[2], pv[2]; float pa = 0.f, pb = 0.f;
#define DN_LOADC(n) do { _Pragma("unroll") for (int i_ = 0; i_ < 2; ++i_) { const int idx_ = tid + NTHR * i_, c_ = idx_ & 63, d8_ = (idx_ >> 6) * 8, p_ = 64 * (n) + c_, l_ = dir ? SEQ - 1 - p_ : p_; \
        const unsigned bo_ = ((unsigned)(b * SEQ + l_) * 3072u + (unsigned)(h * 128 + d8_)) * 2u; const char* s_ = (const char*)a.QKV; \
        pq[i_] = *(const u32x4*)(s_ + bo_); pk[i_] = *(const u32x4*)(s_ + (bo_ + 2048u)); pv[i_] = *(const u32x4*)(s_ + (bo_ + 4096u)); } \
        if (w == 0) { const int p_ = 64 * (n) + lane, l_ = dir ? SEQ - 1 - p_ : p_; const unsigned lo_ = ((unsigned)(b * SEQ + l_) * 32u + (unsigned)(dir * 8 + h)) * 4u; \
            const char* l2_ = (const char*)a.LOG + (size_t)TOK * 32 * 4; pa = *(const float*)((const char*)a.LOG + lo_) + *(const float*)(l2_ + lo_); pb = *(const float*)((const char*)a.LOG + (lo_ + 64u)) + *(const float*)(l2_ + (lo_ + 64u)); } } while (0)
    DN_LOADC(0);
    for (int n = 0; n < 64; ++n) {
#pragma unroll
        for (int i = 0; i < 2; ++i) { const int idx = tid + NTHR * i, c = idx & 63, d8 = (idx >> 6) * 8;
            *(LAS u32x4*)(lds + KC_OFF + c * 272 + d8 * 2) = pk[i]; *(LAS u32x4*)(lds + QC_OFF + c * 272 + d8 * 2) = pq[i];
#pragma unroll
            for (int j = 0; j < 8; ++j) { const unsigned kw = pk[i][j >> 1], vw = pv[i][j >> 1];
                *(LAS bf16_t*)(lds + KT_OFF + (d8 + j) * 144 + c * 2) = (bf16_t)((j & 1) ? (kw >> 16) : (kw & 0xffffu));
                *(LAS bf16_t*)(lds + VT_OFF + (d8 + j) * 144 + c * 2) = (bf16_t)((j & 1) ? (vw >> 16) : (vw & 0xffffu)); } }
        if (w == 0) {
#ifdef DN_SLOWGATES
            const float x = pa + dtb; const float sp = x > 20.f ? x : log1pf(expf(x));
#else
            const float x = pa + dtb; const float ex = __expf(x); const float sp = x > 15.f ? x : (ex < 1e-4f ? ex * (1.f - 0.5f * ex) : __logf(1.f + ex));
#endif
            float g = -Aexp * sp;
#pragma unroll
            for (int o = 1; o < 64; o <<= 1) { const float y = __shfl_up(g, o); if (lane >= o) g += y; }
            const float glast = __shfl(g, 63);
#ifdef DN_SLOWGATES
            gc[lane] = g; beta[lane] = 1.f / (1.f + expf(-pb)); eg[lane] = expf(g); ekl[lane] = expf(glast - g);
            if (lane == 0) scal[0] = expf(glast);
#else
            gc[lane] = g; beta[lane] = __builtin_amdgcn_rcpf(1.f + __expf(-pb)); eg[lane] = __expf(g); ekl[lane] = __expf(glast - g);
            if (lane == 0) scal[0] = __expf(glast);
#endif
        }
        __syncthreads();
#ifdef DN_DUP_SOLVE
        for (int rep2 = 0; rep2 < 2; ++rep2) {
#endif
        {
            const int q4 = w & 3, mi = q4 >> 1, nj = q4 & 1;
            f32x16 acc;
#pragma unroll
            for (int r = 0; r < 16; ++r) acc[r] = 0.f;
            const LAS unsigned char* Ab = lds + (w < 4 ? KC_OFF : QC_OFF);
#pragma unroll
            for (int ks = 0; ks < 8; ++ks) { const int kb = (ks * 16 + hi * 8) * 2;
                acc = DN_MFMA(ldf(Ab, 32 * mi + r32, 272, kb), ldf(lds + KC_OFF, 32 * nj + r32, 272, kb), acc); }
            const int j = 32 * nj + r32; const float gcj = gc[j];
            if (w < 4) {
#pragma unroll
                for (int r = 0; r < 16; ++r) { const int i = 32 * mi + crow(r, hi); const float dec = __expf(gc[i] - gcj);
                    MT[i * 65 + j] = (i > j) ? beta[i] * acc[r] * dec : 0.f; }
            } else {
#pragma unroll
                for (int r = 0; r < 16; ++r) { const int i = 32 * mi + crow(r, hi); const float dec = __expf(gc[i] - gcj);
                    *(LAS bf16_t*)(lds + AT_OFF + i * 144 + j * 2) = f2bf((i >= j) ? acc[r] * SCALE * dec : 0.f); }
            }
        }
        __syncthreads();
#ifdef DN_L0X3
        for (int rep3 = 0; rep3 < 3; ++rep3)
#endif
        if (w == 0) {
            const int base = (lane >> 4) * 16, c = lane & 15; float x[16];
#pragma unroll
            for (int i = 0; i < 16; ++i) { float acc = (i == c) ? 1.f : 0.f;
#pragma unroll
                for (int j = 0; j < i; ++j) acc = fmaf(-MT[(base + i) * 65 + base + j], x[j], acc);
                x[i] = acc;
#ifndef DN_E1
                asm volatile("" ::: "memory");
#endif
            }
            LDS_WAIT(); asm volatile("" ::: "memory");
#pragma unroll
            for (int i = 0; i < 16; ++i) MT[(base + i) * 65 + base + c] = x[i];
        }
        __syncthreads();
        {
            const int p = tid >> 8, i = (tid >> 4) & 15, j = tid & 15, R0 = 32 * p + 16, C0 = 32 * p; float y = 0.f;
#pragma unroll
            for (int k = 0; k < 16; ++k) y = fmaf(MT[(R0 + i) * 65 + C0 + k], MT[(C0 + k) * 65 + C0 + j], y);
            YF[(p * 16 + i) * 17 + j] = y;
            __syncthreads();
            float t = 0.f;
#pragma unroll
            for (int k = 0; k < 16; ++k) t = fmaf(MT[(R0 + i) * 65 + R0 + k], YF[(p * 16 + k) * 17 + j], t);
            MT[(R0 + i) * 65 + C0 + j] = -t;
        }
        __syncthreads();
        {
            const int j = tid & 31, i0 = tid >> 5; float y0 = 0.f, y1 = 0.f;
#ifdef DN_E2
#pragma unroll
#else
#pragma unroll 8
#endif
            for (int k = 0; k < 32; ++k) { const float tk = MT[k * 65 + j]; y0 = fmaf(MT[(32 + i0) * 65 + k], tk, y0); y1 = fmaf(MT[(48 + i0) * 65 + k], tk, y1); }
            YF[i0 * 33 + j] = y0; YF[(16 + i0) * 33 + j] = y1;
            __syncthreads();
            float t0 = 0.f, t1 = 0.f;
#ifdef DN_E2
#pragma unroll
#else
#pragma unroll 8
#endif
            for (int k = 0; k < 32; ++k) { const float yk = YF[k * 33 + j]; t0 = fmaf(MT[(32 + i0) * 65 + 32 + k], yk, t0); t1 = fmaf(MT[(48 + i0) * 65 + 32 + k], yk, t1); }
            MT[(32 + i0) * 65 + j] = -t0; MT[(48 + i0) * 65 + j] = -t1;
            { const float bj = beta[j], ej = eg[j];
              *(LAS bf16_t*)(lds + T1_OFF + (32 + i0) * 144 + j * 2) = f2bf(-t0 * bj); *(LAS bf16_t*)(lds + T2_OFF + (32 + i0) * 144 + j * 2) = f2bf(t0 * bj * ej);
              *(LAS bf16_t*)(lds + T1_OFF + (48 + i0) * 144 + j * 2) = f2bf(-t1 * bj); *(LAS bf16_t*)(lds + T2_OFF + (48 + i0) * 144 + j * 2) = f2bf(t1 * bj * ej); }
#pragma unroll 1
            for (int q = 0; q < 6; ++q) { const int idx = tid + NTHR * q; int i, jj;
                if (idx < 2048) { i = idx >> 6; jj = idx & 63; } else { const int r2 = idx - 2048; i = 32 + (r2 >> 5); jj = 32 + (r2 & 31); }
                const float tv = MT[i * 65 + jj] * beta[jj];
                *(LAS bf16_t*)(lds + T1_OFF + i * 144 + jj * 2) = f2bf(tv); *(LAS bf16_t*)(lds + T2_OFF + i * 144 + jj * 2) = f2bf(-tv * eg[jj]); }
        }
        __syncthreads();
#ifdef DN_DUP_SOLVE
        }
#endif
        f32x16 accU, accW;
#pragma unroll
        for (int r = 0; r < 16; ++r) { accU[r] = 0.f; accW[r] = 0.f; }
#pragma unroll
        for (int ks = 0; ks < 4; ++ks) { const int kb = (ks * 16 + hi * 8) * 2;
            accU = DN_MFMA(ldf(lds + T1_OFF, 32 * wr + r32, 144, kb), ldf(lds + VT_OFF, 32 * wc + r32, 144, kb), accU);
            accW = DN_MFMA(ldf(lds + T2_OFF, 32 * wr + r32, 144, kb), ldf(lds + KT_OFF, 32 * wc + r32, 144, kb), accW); }
#pragma unroll
        for (int r = 0; r < 16; ++r) *(LAS bf16_t*)(lds + KC_OFF + (32 * wr + crow(r, hi)) * 272 + (32 * wc + r32) * 2) = f2bf(accW[r]);
        __syncthreads();
#ifdef DN_PF_EARLY
        if (n + 1 < 64) DN_LOADC(n + 1);
#endif
        f32x16 accQ;
#pragma unroll
        for (int r = 0; r < 16; ++r) accQ[r] = 0.f;
#if DN_STAGE >= 5
#pragma unroll 2
        for (int ks = 0; ks < 8; ++ks) { const int kb = (ks * 16 + hi * 8) * 2;
            const bf16x8 bs = ldf(lds + ST_OFF, 32 * wc + r32, 272, kb);
            accU = DN_MFMA(ldf(lds + KC_OFF, 32 * wr + r32, 272, kb), bs, accU);
            accQ = DN_MFMA(ldf(lds + QC_OFF, 32 * wr + r32, 272, kb), bs, accQ); }
#pragma unroll
        for (int rg = 0; rg < 4; ++rg) { const int c0 = 32 * wr + 8 * rg + 4 * hi, e = 32 * wc + r32;
            const f32x4 sc = *(const LAS f32x4*)(ekl + c0);
            u32x2 w1, w2; w1.x = cvt_pk_bf16(accU[4 * rg], accU[4 * rg + 1]); w1.y = cvt_pk_bf16(accU[4 * rg + 2], accU[4 * rg + 3]);
            w2.x = cvt_pk_bf16(accU[4 * rg] * sc.x, accU[4 * rg + 1] * sc.y); w2.y = cvt_pk_bf16(accU[4 * rg + 2] * sc.z, accU[4 * rg + 3] * sc.w);
            *(LAS u32x2*)(lds + VN_OFF + e * 144 + c0 * 2) = w1; *(LAS u32x2*)(lds + VNS_OFF + e * 144 + c0 * 2) = w2; }
#else
        accQ = accU;
#endif
        __syncthreads();
#ifndef DN_PF_EARLY
        if (n + 1 < 64) DN_LOADC(n + 1);
#endif
#if DN_STAGE >= 6
#pragma unroll
        for (int r = 0; r < 16; ++r) accQ[r] *= SCALE * eg[32 * wr + crow(r, hi)];
#pragma unroll
        for (int ks = 0; ks < 4; ++ks) { const int kb = (ks * 16 + hi * 8) * 2;
            accQ = DN_MFMA(ldf(lds + AT_OFF, 32 * wr + r32, 144, kb), ldf(lds + VN_OFF, 32 * wc + r32, 144, kb), accQ); }
#endif
#pragma unroll
        for (int r = 0; r < 16; ++r) { const int c = 32 * wr + crow(r, hi);
            *(LAS bf16_t*)(lds + MT_OFF + c * 256 + (32 * wc + r32) * 2) = f2bf(accQ[r]); }
#if DN_STAGE >= 7
        {
            const float egl = scal[0];
#pragma unroll
            for (int r = 0; r < 16; ++r) { accS[0][r] *= egl; accS[1][r] *= egl; }
#pragma unroll
            for (int ks = 0; ks < 4; ++ks) { const int kb = (ks * 16 + hi * 8) * 2;
                const bf16x8 bsn = ldf(lds + VNS_OFF, 32 * wc + r32, 144, kb);
                accS[0] = DN_MFMA(ldf(lds + KT_OFF, 64 * wr + r32, 144, kb), bsn, accS[0]);
                accS[1] = DN_MFMA(ldf(lds + KT_OFF, 64 * wr + 32 + r32, 144, kb), bsn, accS[1]); }
#pragma unroll
            for (int mb = 0; mb < 2; ++mb)
#pragma unroll
                for (int rg = 0; rg < 4; ++rg) { const int d0 = 64 * wr + 32 * mb + 8 * rg + 4 * hi, e = 32 * wc + r32;
                    u32x2 w1; w1.x = cvt_pk_bf16(accS[mb][4 * rg], accS[mb][4 * rg + 1]); w1.y = cvt_pk_bf16(accS[mb][4 * rg + 2], accS[mb][4 * rg + 3]);
                    *(LAS u32x2*)(lds + ST_OFF + e * 272 + d0 * 2) = w1; }
        }
#endif
        __syncthreads();
#pragma unroll
        for (int i = 0; i < 2; ++i) { const int idx = tid + NTHR * i, c = idx >> 4, e8 = (idx & 15) * 8, p = 64 * n + c, l = dir ? SEQ - 1 - p : p;
            const unsigned oo = ((unsigned)(b * SEQ + l) * 1024u + (unsigned)(h * 128 + e8)) * 2u;
            *(u32x4*)((char*)O + oo) = *(const LAS u32x4*)(lds + MT_OFF + c * 256 + e8 * 2); }
    }
#undef DN_LOADC
}
}
namespace gm {
constexpr int WS_OFF = 0, VT_OFF = 34816, ST_OFF = 69632, SL_OFF = 70656, LN_OFF = 138240;
static_assert(LN_OFF + 16384 <= LDS_BYTES - 64, "gmlp LDS map");
struct Args { const bf16_t* P1; const float* ln_g; const float* ln_b; const float* ws; const float* bs; bf16_t* Z; const float* VST; };
__device__ __forceinline__ void unit(const Args& a, int cu, LAS unsigned char* lds) {
    int tid = threadIdx.x; asm volatile("" : "+v"(tid));
    const int w = __builtin_amdgcn_readfirstlane(tid >> 6), lane = tid & 63, r32 = lane & 31, hi = lane >> 5, wr = w >> 2, wc = w & 3;
    const int t0 = cu * 128;
    LAS float* mean = (LAS float*)(lds + ST_OFF); LAS float* rstd = mean + 128; LAS float* SL = (LAS float*)(lds + SL_OFF);
    LAS float* LG = (LAS float*)(lds + LN_OFF); LAS float* LB = LG + 2048;
    f32x4 pw[8]; u32x4 pvv[4], pu[4], pg[4];
#define GM_LOAD_WV(g_) do { _Pragma("unroll") for (int i_ = 0; i_ < 8; ++i_) { const int idx_ = tid + NTHR * i_; pw[i_] = *(const f32x4*)(a.ws + (size_t)(g_) * 16384 + idx_ * 4); } \
        _Pragma("unroll") for (int i_ = 0; i_ < 4; ++i_) { const int idx_ = tid + NTHR * i_, s_ = idx_ & 127, c8_ = (idx_ >> 7) * 8; \
            pvv[i_] = *(const u32x4*)((const char*)a.P1 + (unsigned)(((t0 + s_) * N1 + 2048 + (g_) * 128 + c8_) * 2)); } } while (0)
#define GM_LOAD_UG(g_) do { _Pragma("unroll") for (int i_ = 0; i_ < 4; ++i_) { const int idx_ = tid + NTHR * i_, t_ = idx_ >> 4, c8_ = (idx_ & 15) * 8; \
            const char* pr_ = (const char*)a.P1 + (unsigned)(((t0 + t_) * N1 + (g_) * 128 + c8_) * 2); pu[i_] = *(const u32x4*)pr_; pg[i_] = *(const u32x4*)(pr_ + 8192); } } while (0)
    __syncthreads();
    GM_LOAD_WV(0);
    for (int i = tid; i < 512; i += NTHR) { *(LAS f32x4*)(LG + i * 4) = *(const f32x4*)(a.ln_g + i * 4); *(LAS f32x4*)(LB + i * 4) = *(const f32x4*)(a.ln_b + i * 4); }
    { typedef float f32x2v __attribute__((ext_vector_type(2))); f32x2v pr[16];
#pragma unroll
      for (int q = 0; q < 16; ++q) pr[q] = (lane < 32) ? *(const f32x2v*)(a.VST + ((size_t)(t0 + w * 16 + q) * 32 + lane) * 2) : (f32x2v){0.f, 0.f};
#pragma unroll
      for (int q = 0; q < 16; ++q) { const float S1 = wave_sum(pr[q].x), S2 = wave_sum(pr[q].y); const float mu = S1 * (1.f / 2048.f);
          const float var = fmaxf(S2 * (1.f / 2048.f) - mu * mu, 0.f); if (lane == 0) { mean[w * 16 + q] = mu; rstd[w * 16 + q] = 1.0f / sqrtf(var + EPS); } } }
    __syncthreads();
    for (int g = 0; g < 16; ++g) {
#ifndef GM_UG_LATE
        GM_LOAD_UG(g);
#endif
#pragma unroll
        for (int i = 0; i < 8; ++i) { const int idx = tid + NTHR * i, t = idx >> 5, s4 = (idx & 31) * 4;
            u32x2 o; o.x = cvt_pk_bf16(pw[i].x, pw[i].y); o.y = cvt_pk_bf16(pw[i].z, pw[i].w); *(LAS u32x2*)(lds + WS_OFF + t * 272 + s4 * 2) = o; }
#pragma unroll
        for (int i = 0; i < 4; ++i) { const int idx = tid + NTHR * i, s = idx & 127, c8 = (idx >> 7) * 8; float x[8];
            unpack8(pvv[i], x);
            const float mu = mean[s], rs = rstd[s];
            const f32x4 g0 = *(const LAS f32x4*)(LG + g * 128 + c8), g1 = *(const LAS f32x4*)(LG + g * 128 + c8 + 4), b0 = *(const LAS f32x4*)(LB + g * 128 + c8), b1 = *(const LAS f32x4*)(LB + g * 128 + c8 + 4);
            const float gg[8] = {g0.x, g0.y, g0.z, g0.w, g1.x, g1.y, g1.z, g1.w}, bb[8] = {b0.x, b0.y, b0.z, b0.w, b1.x, b1.y, b1.z, b1.w};
#pragma unroll
            for (int j = 0; j < 8; ++j) *(LAS bf16_t*)(lds + VT_OFF + (c8 + j) * 272 + s * 2) = f2bf((x[j] - mu) * rs * gg[j] + bb[j]); }
        __syncthreads();
        if (g + 1 < 16) GM_LOAD_WV(g + 1);
#ifdef GM_UG_LATE
        GM_LOAD_UG(g);
#endif
        f32x16 acc[2];
#pragma unroll
        for (int r = 0; r < 16; ++r) { acc[0][r] = 0.f; acc[1][r] = 0.f; }
#pragma unroll
        for (int ks = 0; ks < 8; ++ks) { const int kb = (ks * 16 + hi * 8) * 2;
            const bf16x8 bv = *(const LAS bf16x8*)(lds + VT_OFF + (32 * wc + r32) * 272 + kb);
            acc[0] = __builtin_amdgcn_mfma_f32_32x32x16_bf16(*(const LAS bf16x8*)(lds + WS_OFF + (64 * wr + r32) * 272 + kb), bv, acc[0], 0, 0, 0);
            acc[1] = __builtin_amdgcn_mfma_f32_32x32x16_bf16(*(const LAS bf16x8*)(lds + WS_OFF + (64 * wr + 32 + r32) * 272 + kb), bv, acc[1], 0, 0, 0); }
#pragma unroll
        for (int mb = 0; mb < 2; ++mb) { const float* bsp = a.bs + g * 128 + 64 * wr + 32 * mb + 4 * hi;
#pragma unroll
            for (int r = 0; r < 16; ++r) { const int t = 64 * wr + 32 * mb + crow(r, hi);
                SL[t * 132 + 32 * wc + r32] = acc[mb][r] + bsp[(r & 3) + 8 * (r >> 2)]; } }
        __syncthreads();
#pragma unroll
        for (int i = 0; i < 4; ++i) { const int idx = tid + NTHR * i, t = idx >> 4, c8 = (idx & 15) * 8, col = g * 128 + c8; float uu[8], gt[8];
            unpack8(pu[i], uu); unpack8(pg[i], gt);
            const f32x4 s0 = *(const LAS f32x4*)(SL + t * 132 + c8), s1 = *(const LAS f32x4*)(SL + t * 132 + c8 + 4);
            const float sv[8] = {s0.x, s0.y, s0.z, s0.w, s1.x, s1.y, s1.z, s1.w};
#pragma unroll
            for (int e = 0; e < 8; ++e) uu[e] = uu[e] * sv[e] * silu_f(gt[e]);
            *(u32x4*)((char*)a.Z + (unsigned)(((t0 + t) * DM + col) * 2)) = pack8(uu); }
    }
#undef GM_LOAD_WV
#undef GM_LOAD_UG
}
}

struct KArgs { const float* in[17]; float* out; unsigned char* ws; int ph_lo, ph_hi; };
#ifndef PROBE_END
#define PROBE_END 10
#endif
#ifndef DUMP_OFF
#define DUMP_OFF 0
#define DUMP_N 0
#endif
#ifndef DUP_PHASE
#define DUP_PHASE -1
#endif
#ifndef DUP_N
#define DUP_N 2
#endif
#define REPS(k) for (int rep_ = 0; rep_ < ((DUP_PHASE == (k)) ? DUP_N : 1); ++rep_)
#define REPSYNC(k) do { if (DUP_PHASE == (k) && rep_ + 1 < DUP_N) cg::this_grid().sync(); } while (0)
#ifndef PG_ALIGN59
#define PG_ALIGN59 true
#endif
constexpr int NPHASES = 10;
__global__ void __launch_bounds__(NTHR, 2) fwd_megakernel(KArgs A) {
    __builtin_assume(__builtin_amdgcn_workitem_id_y() == 0); __builtin_assume(__builtin_amdgcn_workitem_id_z() == 0);
    extern __shared__ __attribute__((aligned(16))) unsigned char lds_raw[];
    LAS unsigned char* lds = (LAS unsigned char*)lds_raw;
    const int tid = threadIdx.x, lane = tid & 63, wave = __builtin_amdgcn_readfirstlane(tid >> 6);
    const int G = gridDim.x, bx = blockIdx.x, gw = bx * NWAVES + wave, NGW = G * NWAVES;
    unsigned char* ws = A.ws;
    const float* x = A.in[0];
    bf16_t* W0T = (bf16_t*)(ws + WS_W0T); bf16_t* WO0T = (bf16_t*)(ws + WS_WO0T); bf16_t* W1T = (bf16_t*)(ws + WS_W1T); bf16_t* WO1T = (bf16_t*)(ws + WS_WO1T);
    bf16_t* H = (bf16_t*)(ws + WS_H); bf16_t* PROJ = (bf16_t*)(ws + WS_PROJ); float* LOG = (float*)(ws + WS_LOG); bf16_t* QKV = (bf16_t*)(ws + WS_QKV); bf16_t* YCAT = (bf16_t*)(ws + WS_YCAT);
    bf16_t* OF = H; bf16_t* OB = H + (size_t)TOK * 1024; float* PART = (float*)(ws + WS_PART); float* RSTD = (float*)(ws + WS_RSTD);
    const int lo = A.ph_lo, hi = A.ph_hi;
#ifndef PHMASK
#define PHMASK 0x3ff
#endif
#define IN(k) (((PHMASK >> (k)) & 1) && lo <= (k) && (k) < hi)
#define SEAM(k) do { if (IN(k) && IN((k) + 1)) { cg::this_grid().sync(); } } while (0)
    if (IN(0)) REPS(0) { P0Args p{x, A.in[1], A.in[10], A.in[2], A.in[9], A.in[11], A.in[16], W0T, WO0T, W1T, WO1T, H}; p0_prologue(p, lds, gw, NGW, wave, lane); __syncthreads(); REPSYNC(0); }
    SEAM(0);
    if (IN(1)) REPS(1) { { pg8::Gemm g{H, W0T, TOK, P0LD, DM, DM}; pg8::StaticOrder S; S.init(TOK, P0LD, G, bx); pg8::Epi0 E{PROJ, LOG};
            pg8::gemm_phase<pg8::Epi0, pg8::StaticOrder, true, true>(lds, g, S, E); }
        for (int hu = bx; hu < 2 * (TOK / 256); hu += G) { const int kh = hu & 1;
            pg8::Gemm g{H + kh * (DM / 2), W0T + (size_t)P0LD * DM + kh * (DM / 2), TOK, 256, DM / 2, DM}; pg8::OneUnit S{hu >> 1}; pg8::EpiLog E{LOG + (size_t)kh * TOK * 32};
            pg8::gemm_phase<pg8::EpiLog, pg8::OneUnit, true, true>(lds, g, S, E); }
        REPSYNC(1); }
    SEAM(1);
    if (IN(2)) {
        REPS(2) { for (int it = gw; it < (TOK / 16) * 6; it += NGW) p2_conv_item(PROJ, A.in[3], QKV, it, lane); REPSYNC(2); }
        for (int t = gw; t < TOK; t += 2 * NGW) p2_rope_tokens<2>(PROJ, A.in[7], A.in[8], t, NGW, lane);
    }
    SEAM(2);
    if (IN(3)) REPS(3) {
        int* ctr = (int*)(ws + WS_CTL) + 64 * rep_; LAS int* slot = (LAS int*)(lds + LDS_BYTES - 16);
        int* dn_done = (int*)(ws + WS_CTL) + 512 + 64 * rep_; int* p4ctr = (int*)(ws + WS_CTL) + 768 + 64 * rep_;
#define FETCH4(item) do { __syncthreads(); if (tid == 0) *slot = atomicAdd(p4ctr, 1); __syncthreads(); item = __builtin_amdgcn_readfirstlane(*slot); } while (0)
        dn::Args da{QKV, LOG, A.in[4], A.in[5], OF, OB};
#define FETCH(item) do { __syncthreads(); if (tid == 0) *slot = atomicAdd(ctr, 1); __syncthreads(); item = __builtin_amdgcn_readfirstlane(*slot); } while (0)
        int item;
#if DUP_PHASE == 31
        for (int r31 = 0; r31 < DUP_N - 1; ++r31) { int* ctr0 = ctr; ctr = (int*)(ws + WS_CTL) + 128 + 64 * r31; FETCH(item); while (item < 128) { dn::unit(da, item, lds); FETCH(item); } ctr = ctr0; cg::this_grid().sync(); }
#endif
#if DUP_PHASE == 32
        { int* ctr0 = ctr; ctr = (int*)(ws + WS_CTL) + 128; FETCH(item); item += 128;
          while (item < 128 + 1024) { const int ai = item - 128, qb = ai & 15, gq = (ai >> 4) & 3, kvh = (ai >> 6) & 1, b = ai >> 7, h = kvh * 4 + gq;
            const size_t r0 = (size_t)(b * SEQ + qb * 256);
            att::attn_dense_body(PROJ + r0 * P0LD + C_BQ + h * 128, PROJ + (size_t)(b * SEQ) * P0LD + C_BK + kvh * 128, PROJ + (size_t)(b * SEQ) * P0LD + C_BV + kvh * 128,
                                 PROJ + r0 * P0LD + C_BG + h * 128, YCAT + r0 * DM + 1024 + h * 128, SEQ, (char*)lds_raw);
            FETCH(item); item += 128; }
          ctr = ctr0; cg::this_grid().sync(); }
#endif
        FETCH(item);
#ifndef SKIP_DN
        while (item < 128) { dn::unit(da, item, lds);
            asm volatile("s_waitcnt vmcnt(0)" ::: "memory");
            __syncthreads(); if (tid == 0) { __threadfence(); atomicAdd(dn_done, 1); }
            FETCH(item); }
#endif
#ifndef SKIP_ATT
        while (item < 128 + 1024) { const int ai = item - 128, qb = ai & 15, gq = (ai >> 4) & 3, kvh = (ai >> 6) & 1, b = ai >> 7, h = kvh * 4 + gq;
            const size_t r0 = (size_t)(b * SEQ + qb * 256);
            att::attn_dense_body(PROJ + r0 * P0LD + C_BQ + h * 128, PROJ + (size_t)(b * SEQ) * P0LD + C_BK + kvh * 128, PROJ + (size_t)(b * SEQ) * P0LD + C_BV + kvh * 128,
                                 PROJ + r0 * P0LD + C_BG + h * 128, YCAT + r0 * DM + 1024 + h * 128, SEQ, (char*)lds_raw);
            FETCH(item); }
#endif
        if (tid == 0) { while (__hip_atomic_load(dn_done, __ATOMIC_RELAXED, __HIP_MEMORY_SCOPE_AGENT) < 128) __builtin_amdgcn_s_sleep(16);
            __threadfence(); }
        __syncthreads();
        for (;;) { int c4; FETCH4(c4); if (c4 >= TOK / 128) break;
            for (int q = 0; q < 16; q += 4) p4_tokens<4>(OF, OB, PROJ, A.in[6], YCAT, c4 * 128 + wave * 16 + q, lane); }
        REPSYNC(3);
    }
    SEAM(3);
    if (IN(5)) REPS(5) { pg8::Gemm g{YCAT, WO0T, TOK, DM, DM, DM}; pg8::StaticOrder S; S.init(TOK, DM, G, bx); pg8::EpiRes0 E{x, H, PART};
        pg8::gemm_phase<pg8::EpiRes0, pg8::StaticOrder, PG_ALIGN59, true>(lds, g, S, E); REPSYNC(5); }
    SEAM(5);
    if (IN(6)) REPS(6) { for (int r = bx * NTHR + tid; r < TOK; r += G * NTHR) { const f32x4* pp = (const f32x4*)(PART + (size_t)r * 32); float ss = 0.f;
#pragma unroll
            for (int j = 0; j < 8; ++j) { const f32x4 v = pp[j]; ss += (v.x + v.y) + (v.z + v.w); }
            RSTD[r] = 1.0f / sqrtf(ss * (1.f / DM) + EPS); } REPSYNC(6); }
    SEAM(6);
    if (IN(7)) REPS(7) { pg8::Gemm g{H, W1T, TOK, N1, DM, DM}; pg8::StaticOrder S; S.init(TOK, N1, G, bx); pg8::Epi1 E{PROJ, RSTD, (float*)(ws + WS_VST)};
        pg8::gemm_phase<pg8::Epi1, pg8::StaticOrder, true, true>(lds, g, S, E); REPSYNC(7); }
    SEAM(7);
    if (IN(8)) REPS(8) { gm::Args ga{PROJ, A.in[12], A.in[13], A.in[14], A.in[15], YCAT, (const float*)(ws + WS_VST)};
        for (int cu = bx; cu < TOK / 128; cu += G) gm::unit(ga, cu, lds); REPSYNC(8); }
    SEAM(8);
    if (IN(9)) { pg8::Gemm g{YCAT, WO1T, TOK, DM, DM, DM}; pg8::StaticOrder S; S.init(TOK, DM, G, bx); pg8::EpiRes1 E{H, A.out};
        pg8::gemm_phase<pg8::EpiRes1, pg8::StaticOrder, PG_ALIGN59, true>(lds, g, S, E); }
#if PROBE_END < 10
    if (lo <= 10 && 10 < hi) { const bf16_t* src = (const bf16_t*)(ws + (size_t)DUMP_OFF); const size_t n = (size_t)DUMP_N, NO = (size_t)TOK * DM;
        for (size_t i = (size_t)bx * NTHR + tid; i < NO; i += (size_t)G * NTHR) { float acc = 0.f; for (size_t k = i; k < n; k += NO) { float v = bf2f(src[k]); if (!(fabsf(v) < 1e30f)) v = 7777.f; acc += v; } A.out[i] = acc; } }
#endif
}

extern "C" void kernel_launch(void* const* d_in, const int* in_sizes, int n_in, void* d_out, int out_size, void* d_ws, size_t ws_size, hipStream_t stream) {
    static int grid = 0;
    if (grid == 0) {
        if (n_in != 17 || in_sizes[0] != TOK * DM || out_size != TOK * DM || ws_size < WS_END) { fprintf(stderr, "kernel_launch: shape/workspace mismatch (n_in %d, ws %zu < %zu)\n", n_in, ws_size, (size_t)WS_END); grid = -1; return; }
        int dev = 0, cus = 0, per_cu = 0;
        (void)hipGetDevice(&dev); (void)hipDeviceGetAttribute(&cus, hipDeviceAttributeMultiprocessorCount, dev);
        if (hipFuncSetAttribute((const void*)fwd_megakernel, hipFuncAttributeMaxDynamicSharedMemorySize, LDS_BYTES) != hipSuccess) { fprintf(stderr, "hipFuncSetAttribute failed\n"); grid = -1; return; }
        if (hipOccupancyMaxActiveBlocksPerMultiprocessor(&per_cu, (const void*)fwd_megakernel, NTHR, LDS_BYTES) != hipSuccess || per_cu < 1) per_cu = 1;
        grid = cus * per_cu;
        fprintf(stderr, "kernel_launch: grid %d (%d CUs x %d)\n", grid, cus, per_cu);
    }
    if (grid < 0) return;
    (void)hipMemsetAsync((char*)d_ws + WS_CTL, 0, 4096, stream);
    KArgs a{};
    for (int i = 0; i < 17; ++i) a.in[i] = (const float*)d_in[i];
    a.out = (float*)d_out; a.ws = (unsigned char*)d_ws;
#if MK_LAUNCHES == 1
    a.ph_lo = 0; a.ph_hi = NPHASES;
    void* args[] = {&a};
    hipError_t e = hipLaunchCooperativeKernel((void*)fwd_megakernel, dim3(grid), dim3(NTHR), args, LDS_BYTES, stream);
    if (e != hipSuccess) fprintf(stderr, "cooperative launch failed: %s (grid %d)\n", hipGetErrorString(e), grid);
#else
    for (int p = 0; p < PROBE_END; ++p) { a.ph_lo = p; a.ph_hi = p + 1; hipLaunchKernelGGL(fwd_megakernel, dim3(grid), dim3(NTHR), LDS_BYTES, stream, a); }
#if PROBE_END < 10
    a.ph_lo = 10; a.ph_hi = 11; hipLaunchKernelGGL(fwd_megakernel, dim3(grid), dim3(NTHR), LDS_BYTES, stream, a);
#endif
#endif
}
```

```cpp
#include <hip/hip_runtime.h>
#include <hip/hip_cooperative_groups.h>
#include <cstdio>
#include <cstdint>
namespace cg = cooperative_groups;
#ifndef MK_LAUNCHES
#define MK_LAUNCHES 1
#define DUP_PHASE -1
#endif
namespace pg8 {
#define PG8_LAS __attribute__((address_space(3)))
typedef unsigned short bf16_t;
typedef short bf16x8 __attribute__((ext_vector_type(8)));
typedef float f32x4 __attribute__((ext_vector_type(4)));
typedef unsigned u32x4 __attribute__((ext_vector_type(4)));
constexpr int BM = 256, BK = 64, HALF = 128, HTB = HALF * BK * 2  , STAGE_BYTES = 8 * HTB, NXCD = 8, WGM = 4;

__host__ __device__ __forceinline__ int lds_byte(int r, int c) { const int st = (r >> 4) * 2 + (c >> 5), rr = r & 15, cc = c & 31, ob = rr * 64 + cc * 2; return st * 1024 + (ob ^ (((ob >> 9) & 1) << 5)); }
__host__ __device__ __forceinline__ void stage_rc(int b, int& R, int& C) { const int st = b / 1024, sb = b % 1024, swz = sb ^ (((sb >> 9) & 1) << 5); R = (st >> 1) * 16 + swz / 64; C = (st & 1) * 32 + (swz % 64) / 2; }
__host__ __device__ __forceinline__ int perm32(int rho) { const int n = rho >> 4, i = rho & 15; return 8 * (i >> 2) + 4 * n + (i & 3); }

struct Unit { int pm, pn; };
struct Gemm { const bf16_t* A; const bf16_t* Bt; int M, N, K, ld; };

struct StaticOrder {
    int nM, nN, nwg, G, c;
    __host__ __device__ void init(int M, int N, int G_, int c_) { nM = M / BM; nN = N / BM; nwg = nM * nN; G = G_; c = c_; }
    __host__ __device__ bool next(int i, Unit& u) const {
        const long L = (long)i * G + c; if (L >= nwg) return false;
        int wgid = (int)L; { const int q = nwg / NXCD, r = nwg % NXCD, xcd = wgid % NXCD, off = wgid / NXCD; wgid = (xcd < r ? xcd * (q + 1) : r * (q + 1) + (xcd - r) * q) + off; }
        const int nig = WGM * nN, gid = wgid / nig, fm = gid * WGM, gsz = (nM - fm) < WGM ? (nM - fm) : WGM;
        u.pm = fm + ((wgid % nig) % gsz); u.pn = (wgid % nig) / gsz; return true;
    }
    __device__ __forceinline__ void a_ready(const Unit&) const {}
    __device__ __forceinline__ void done(const Unit&) const {}
};

typedef float f32x2c_t __attribute__((ext_vector_type(2))); typedef __bf16 bf16x2c_t __attribute__((ext_vector_type(2)));
__device__ __forceinline__ unsigned cvt_pk_bf16(float lo, float hi) { f32x2c_t v = {lo, hi}; bf16x2c_t b = __builtin_convertvector(v, bf16x2c_t); return __builtin_bit_cast(unsigned, b); }
typedef float f32x2 __attribute__((ext_vector_type(2)));
__device__ __forceinline__ f32x2 gelu_pk(f32x2 v) {
    const f32x2 av = __builtin_elementwise_abs(v), d = av * 0.2316418882f + 1.0f;
    f32x2 t; t.x = __builtin_amdgcn_rcpf(d.x); t.y = __builtin_amdgcn_rcpf(d.y);
    f32x2 q = t * 0.5307027145f + (-0.7265760135f); q = q * t + 0.7107068705f; q = q * t + (-0.142248368f); q = q * t + 0.127414796f; q = q * t;
    const f32x2 s = (v * v) * (-0.72134752044f);
    f32x2 e; e.x = __builtin_amdgcn_exp2f(s.x); e.y = __builtin_amdgcn_exp2f(s.y);
    const f32x2 m = v * (q * e), r = v - m;
    f32x2 o; o.x = v.x < 0.f ? m.x : r.x; o.y = v.y < 0.f ? m.y : r.y; return o;
}

template <class Epi, class Sched, bool ALIGN_EPI = false, bool SP2 = false>
__device__ __forceinline__ void gemm_phase(PG8_LAS unsigned char* lds, const Gemm g, const Sched& S, const Epi& E) {
    const int tid = threadIdx.x, wid = __builtin_amdgcn_readfirstlane(tid >> 6), lane = tid & 63, wr = wid >> 2, wc = wid & 3, fr = lane & 15, fq = lane >> 4;
    const int K = g.ld, nt = g.K / BK;
    unsigned voffA[2], voffB[2];
#pragma unroll
    for (int i = 0; i < 2; ++i) { int R, C; stage_rc(tid * 16 + i * 8192, R, C); const int Rb = Epi::PERM ? ((R & ~31) + perm32(R & 31)) : R;
        voffA[i] = (unsigned)(R * K + C) * 2u; voffB[i] = (unsigned)(Rb * K + C) * 2u; }
    const size_t kstep = (size_t)(BK * 2);
    const size_t hstep = (size_t)HALF * K * 2;
    const size_t tstep = 2 * hstep;
    const unsigned ldsw = (unsigned)wid * 1024u;
    const int aoff = lds_byte(wr * 64 + fr, fq * 8), boff = lds_byte(wc * 32 + fr, fq * 8);
#define PG8_SA(b, h) (((b) * 2 + (h)) * HTB)
#define PG8_SB(b, h) ((4 + (b) * 2 + (h)) * HTB)
#define PG8_STAGE(bufoff, gbase, voff) do { _Pragma("unroll") for (int _i = 0; _i < 2; ++_i) \
        __builtin_amdgcn_global_load_lds((const unsigned*)((const char*)(gbase) + (voff)[_i]), (PG8_LAS unsigned*)(lds + (bufoff) + ldsw + _i * 8192), 16, 0, 0); } while (0)
#define PG8_LDA(dst, b, h) do { _Pragma("unroll") for (int m = 0; m < 4; ++m) _Pragma("unroll") for (int k = 0; k < 2; ++k) dst[m][k] = *(const PG8_LAS bf16x8*)(lds + PG8_SA(b, h) + aoff + m * 2048 + k * 1024); } while (0)
#define PG8_LDB(dst, b, h) do { _Pragma("unroll") for (int n = 0; n < 2; ++n) _Pragma("unroll") for (int k = 0; k < 2; ++k) dst[n][k] = *(const PG8_LAS bf16x8*)(lds + PG8_SB(b, h) + boff + n * 2048 + k * 1024); } while (0)
#define PG8_MMA(ai, bj, At, Bt) do { __builtin_amdgcn_s_setprio(1); _Pragma("unroll") for (int m = 0; m < 4; ++m) _Pragma("unroll") for (int n = 0; n < 2; ++n) _Pragma("unroll") for (int k = 0; k < 2; ++k) \
        acc[ai][bj][m][n] = __builtin_amdgcn_mfma_f32_16x16x32_bf16(Bt[n][k], At[m][k], acc[ai][bj][m][n], 0, 0, 0); __builtin_amdgcn_s_setprio(0); } while (0)
#define PG8_WAIT_V(n) asm volatile("s_waitcnt vmcnt(" #n ")" ::: "memory")
#define PG8_WAIT_L(n) asm volatile("s_waitcnt lgkmcnt(" #n ")" ::: "memory")
#define PG8_BAR __builtin_amdgcn_s_barrier()
#define PG8_SCHED __builtin_amdgcn_sched_barrier(0)
    Unit cur, nxt; int ui = 0;
    if (!S.next(0, cur)) return;
    f32x4 acc[2][2][4][2];
#pragma unroll
    for (int a = 0; a < 2; ++a)
#pragma unroll
        for (int b = 0; b < 2; ++b)
#pragma unroll
            for (int m = 0; m < 4; ++m)
#pragma unroll
                for (int n = 0; n < 2; ++n) acc[a][b][m][n] = (f32x4){0.f, 0.f, 0.f, 0.f};
    bf16x8 At[4][2], B0[2][2], B1[2][2];
    const char* cA = (const char*)g.A + (size_t)cur.pm * tstep; const char* cB = (const char*)g.Bt + (size_t)cur.pn * tstep;
    S.a_ready(cur);
    if constexpr (SP2) {
        PG8_STAGE(PG8_SB(0, 0), cB, voffB); PG8_STAGE(PG8_SB(0, 1), cB + hstep, voffB); PG8_STAGE(PG8_SA(0, 0), cA, voffA); PG8_STAGE(PG8_SA(0, 1), cA + hstep, voffA);
        if (wr == 1) PG8_BAR;
        PG8_WAIT_V(2); PG8_BAR;
        PG8_STAGE(PG8_SB(1, 0), cB + kstep, voffB); PG8_STAGE(PG8_SA(1, 0), cA + kstep, voffA); PG8_STAGE(PG8_SB(1, 1), cB + hstep + kstep, voffB);
        PG8_WAIT_V(6); PG8_BAR;
    } else {
        PG8_STAGE(PG8_SB(0, 0), cB, voffB); PG8_STAGE(PG8_SA(0, 0), cA, voffA); PG8_STAGE(PG8_SB(0, 1), cB + hstep, voffB); PG8_STAGE(PG8_SA(0, 1), cA + hstep, voffA);
        if (wr == 1) PG8_BAR;
        PG8_WAIT_V(4); PG8_BAR;
        PG8_STAGE(PG8_SB(1, 0), cB + kstep, voffB); PG8_STAGE(PG8_SA(1, 0), cA + kstep, voffA); PG8_STAGE(PG8_SB(1, 1), cB + hstep + kstep, voffB);
        PG8_WAIT_V(6); PG8_BAR;
    }
    for (;;) {
        const bool has_next = S.next(ui + 1, nxt);
        const char* nA = has_next ? (const char*)g.A + (size_t)nxt.pm * tstep : cA; const char* nB = has_next ? (const char*)g.Bt + (size_t)nxt.pn * tstep : cB;
        for (int t = 0; t < nt; t += 2) {
            const bool last = (t == nt - 2);
            const char* a1 = cA + (size_t)(t + 1) * kstep;
            const char* a2 = last ? nA : cA + (size_t)(t + 2) * kstep; const char* b2 = last ? nB : cB + (size_t)(t + 2) * kstep;
            const char* a3 = a2 + kstep; const char* b3 = b2 + kstep;
            if (last && has_next) S.a_ready(nxt);
            if constexpr (SP2) {
            PG8_LDB(B0, 0, 0); PG8_LDB(B1, 0, 1); PG8_SCHED; PG8_LDA(At, 0, 0); PG8_STAGE(PG8_SA(1, 1), a1 + hstep, voffA);
            PG8_WAIT_V(8); PG8_WAIT_L(0); PG8_BAR; PG8_MMA(0, 0, At, B0); PG8_MMA(0, 1, At, B1); PG8_BAR; PG8_SCHED;
            PG8_LDA(At, 0, 1); PG8_STAGE(PG8_SB(0, 0), b2, voffB); PG8_STAGE(PG8_SB(0, 1), b2 + hstep, voffB); PG8_STAGE(PG8_SA(0, 0), a2, voffA);
            PG8_WAIT_V(8); PG8_WAIT_L(0); PG8_BAR; PG8_MMA(1, 0, At, B0); PG8_MMA(1, 1, At, B1); PG8_BAR; PG8_SCHED;
            PG8_LDB(B0, 1, 0); PG8_LDB(B1, 1, 1); PG8_SCHED; PG8_LDA(At, 1, 0); PG8_STAGE(PG8_SA(0, 1), a2 + hstep, voffA);
            PG8_WAIT_V(8); PG8_WAIT_L(0); PG8_BAR; PG8_MMA(0, 0, At, B0); PG8_MMA(0, 1, At, B1); PG8_BAR; PG8_SCHED;
            PG8_LDA(At, 1, 1); PG8_STAGE(PG8_SB(1, 0), b3, voffB); PG8_STAGE(PG8_SB(1, 1), b3 + hstep, voffB); PG8_STAGE(PG8_SA(1, 0), a3, voffA);
            PG8_WAIT_V(8); PG8_WAIT_L(0); PG8_BAR; PG8_MMA(1, 0, At, B0); PG8_MMA(1, 1, At, B1); PG8_BAR; PG8_SCHED;
            } else {
            PG8_LDB(B0, 0, 0); PG8_SCHED; PG8_LDA(At, 0, 0); PG8_STAGE(PG8_SA(1, 1), a1 + hstep, voffA);
            PG8_WAIT_L(8); PG8_BAR; PG8_WAIT_L(0); PG8_MMA(0, 0, At, B0); PG8_BAR; PG8_SCHED;
            PG8_LDB(B1, 0, 1); PG8_STAGE(PG8_SB(0, 0), b2, voffB);
            PG8_BAR; PG8_WAIT_L(0); PG8_MMA(0, 1, At, B1); PG8_BAR;
            PG8_LDA(At, 0, 1); PG8_STAGE(PG8_SA(0, 0), a2, voffA);
            PG8_BAR; PG8_WAIT_L(0); PG8_MMA(1, 0, At, B0); PG8_BAR; PG8_SCHED;
            PG8_STAGE(PG8_SB(0, 1), b2 + hstep, voffB);
            PG8_WAIT_V(6); PG8_BAR; PG8_MMA(1, 1, At, B1); PG8_BAR;
            PG8_LDB(B0, 1, 0); PG8_SCHED; PG8_LDA(At, 1, 0); PG8_STAGE(PG8_SA(0, 1), a2 + hstep, voffA);
            PG8_WAIT_L(8); PG8_BAR; PG8_WAIT_L(0); PG8_MMA(0, 0, At, B0); PG8_BAR; PG8_SCHED;
            PG8_LDB(B1, 1, 1); PG8_STAGE(PG8_SB(1, 0), b3, voffB);
            PG8_BAR; PG8_WAIT_L(0); PG8_MMA(0, 1, At, B1); PG8_BAR;
            PG8_LDA(At, 1, 1); PG8_STAGE(PG8_SA(1, 0), a3, voffA);
            PG8_BAR; PG8_WAIT_L(0); PG8_MMA(1, 0, At, B0); PG8_BAR; PG8_SCHED;
            PG8_STAGE(PG8_SB(1, 1), b3 + hstep, voffB);
            PG8_WAIT_V(6); PG8_BAR; PG8_MMA(1, 1, At, B1); PG8_BAR;
            }
        }
        if constexpr (ALIGN_EPI) { if (wr == 0) PG8_BAR; }
        if constexpr (!Epi::AFTER_DRAIN) { E(acc, cur, wr, wc, fr, fq); S.done(cur); }
        if (!has_next) break;
#pragma unroll
        for (int a = 0; a < 2; ++a)
#pragma unroll
            for (int b = 0; b < 2; ++b)
#pragma unroll
                for (int m = 0; m < 4; ++m)
#pragma unroll
                    for (int n = 0; n < 2; ++n) acc[a][b][m][n] = (f32x4){0.f, 0.f, 0.f, 0.f};
        cur = nxt; cA = nA; cB = nB; ++ui;
        if constexpr (ALIGN_EPI) { if (wr == 1) PG8_BAR; }
    }
    PG8_WAIT_V(0);
    if constexpr (!ALIGN_EPI) { if (wr == 0) PG8_BAR; }
    PG8_BAR;
    if constexpr (Epi::AFTER_DRAIN) { E.fused(acc, cur, wr, wc, fr, fq, lds, wid, lane); S.done(cur); }
#undef PG8_SA
#undef PG8_SB
#undef PG8_STAGE
#undef PG8_LDA
#undef PG8_LDB
#undef PG8_MMA
#undef PG8_WAIT_V
#undef PG8_WAIT_L
#undef PG8_BAR
#undef PG8_SCHED
}
}
#define LAS __attribute__((address_space(3)))
typedef unsigned short bf16_t;
typedef short bf16x8 __attribute__((ext_vector_type(8)));
typedef short s16x4 __attribute__((ext_vector_type(4)));
typedef float f32x4 __attribute__((ext_vector_type(4)));
typedef float f32x8 __attribute__((ext_vector_type(8)));
typedef float f32x16 __attribute__((ext_vector_type(16)));
typedef unsigned u32x4 __attribute__((ext_vector_type(4)));
typedef unsigned u32x2 __attribute__((ext_vector_type(2)));
using pg8::cvt_pk_bf16;

constexpr int NB = 8, SEQ = 4096, DM = 2048, TOK = NB * SEQ;
constexpr int N0P = 6912, P0LD = 6656, N1 = 6144;
constexpr int C_AQ = 0, C_AK = 1024, C_AV = 2048, C_AG = 3072, C_BQ = 4096, C_BK = 5120, C_BV = 5376, C_BG = 5632;
constexpr float EPS = 1e-6f;
constexpr int NTHR = 512, NWAVES = 8;
constexpr int LDS_BYTES = 159744;
constexpr size_t WS_CTL = 0;
constexpr size_t WS_W0T = 4096;
constexpr size_t WS_WO0T = WS_W0T + (size_t)N0P * DM * 2;
constexpr size_t WS_W1T = WS_WO0T + (size_t)DM * DM * 2;
constexpr size_t WS_WO1T = WS_W1T + (size_t)N1 * DM * 2;
constexpr size_t WS_H = WS_WO1T + (size_t)DM * DM * 2;
constexpr size_t WS_PROJ = WS_H + (size_t)TOK * DM * 2;
constexpr size_t WS_LOG = WS_PROJ + (size_t)TOK * P0LD * 2;
constexpr size_t WS_QKV = WS_LOG + (size_t)TOK * 32 * 4 * 2;
constexpr size_t WS_YCAT = WS_QKV + (size_t)TOK * 3072 * 2;
constexpr size_t WS_PART = WS_YCAT + (size_t)TOK * DM * 2;
constexpr size_t WS_RSTD = WS_PART + (size_t)TOK * 32 * 4;
constexpr size_t WS_VST = WS_RSTD + (size_t)TOK * 4;
constexpr size_t WS_END = WS_VST + (size_t)TOK * 32 * 2 * 4;

#define LDS_WAIT() asm volatile("s_waitcnt lgkmcnt(0)" ::: "memory")
__device__ __forceinline__ float bf2f(bf16_t v) { return __builtin_bit_cast(float, (unsigned)v << 16); }
__device__ __forceinline__ float bflo(unsigned w) { return __builtin_bit_cast(float, w << 16); }
__device__ __forceinline__ float bfhi(unsigned w) { return __builtin_bit_cast(float, w & 0xffff0000u); }
__device__ __forceinline__ bf16_t f2bf(float f) { return (bf16_t)(cvt_pk_bf16(f, 0.f) & 0xffffu); }
__device__ __forceinline__ float silu_f(float x) { return x * __builtin_amdgcn_rcpf(1.f + __expf(-x)); }
__device__ __forceinline__ float wave_sum(float v) {
#pragma unroll
    for (int o = 1; o < 64; o <<= 1) v += __shfl_xor(v, o);
    return v;
}
__device__ __forceinline__ int crow(int r, int hi) { return (r & 3) + 8 * (r >> 2) + 4 * hi; }
__device__ __forceinline__ void unpack8(u32x4 w, float* f) {
    f[0] = bflo(w.x); f[1] = bfhi(w.x); f[2] = bflo(w.y); f[3] = bfhi(w.y); f[4] = bflo(w.z); f[5] = bfhi(w.z); f[6] = bflo(w.w); f[7] = bfhi(w.w);
}
__device__ __forceinline__ u32x4 pack8(const float* f) {
    u32x4 w; w.x = cvt_pk_bf16(f[0], f[1]); w.y = cvt_pk_bf16(f[2], f[3]); w.z = cvt_pk_bf16(f[4], f[5]); w.w = cvt_pk_bf16(f[6], f[7]); return w;
}

namespace pg8 {
struct OneUnit { int pm;
    __device__ __forceinline__ bool next(int i, Unit& u) const { if (i) return false; u.pm = pm; u.pn = 0; return true; }
    __device__ __forceinline__ void a_ready(const Unit&) const {}
    __device__ __forceinline__ void done(const Unit&) const {} };
struct EpiLog {
    static constexpr bool PERM = true, AFTER_DRAIN = false;
    float* LOG;
    __device__ __forceinline__ void operator()(const f32x4 (&acc)[2][2][4][2], const Unit& u, int wr, int wc, int fr, int fq) const {
        const int row0 = u.pm * BM + wr * 64 + fr;
        if (wc == 0) {
#pragma unroll
            for (int ai = 0; ai < 2; ++ai)
#pragma unroll
                for (int m = 0; m < 4; ++m) { float* lp = LOG + (size_t)(row0 + ai * HALF + m * 16) * 32 + 8 * fq;
                    *(f32x4*)lp = acc[ai][0][m][0]; *(f32x4*)(lp + 4) = acc[ai][0][m][1]; }
        }
    }
};
struct Epi0 {
    static constexpr bool PERM = true, AFTER_DRAIN = false;
    bf16_t* P; float* LOG;
    __device__ __forceinline__ void operator()(const f32x4 (&acc)[2][2][4][2], const Unit& u, int wr, int wc, int fr, int fq) const {
        const int row0 = u.pm * BM + wr * 64 + fr;
        if (u.pn < 26) {
            const int col0 = u.pn * BM + wc * 32 + 8 * fq;
#pragma unroll
            for (int ai = 0; ai < 2; ++ai)
#pragma unroll
                for (int m = 0; m < 4; ++m) { bf16_t* rowp = P + (size_t)(row0 + ai * HALF + m * 16) * P0LD + col0;
#pragma unroll
                    for (int bj = 0; bj < 2; ++bj) { const f32x4 v0 = acc[ai][bj][m][0], v1 = acc[ai][bj][m][1];
                        ::u32x4 w; w.x = cvt_pk_bf16(v0[0], v0[1]); w.y = cvt_pk_bf16(v0[2], v0[3]); w.z = cvt_pk_bf16(v1[0], v1[1]); w.w = cvt_pk_bf16(v1[2], v1[3]);
                        *(::u32x4*)(rowp + bj * HALF) = w; } }
        } else if (wc == 0) {
#pragma unroll
            for (int ai = 0; ai < 2; ++ai)
#pragma unroll
                for (int m = 0; m < 4; ++m) { float* lp = LOG + (size_t)(row0 + ai * HALF + m * 16) * 32 + 8 * fq;
                    *(f32x4*)lp = acc[ai][0][m][0]; *(f32x4*)(lp + 4) = acc[ai][0][m][1]; }
        }
    }
};
struct Epi1 {
    static constexpr bool PERM = true, AFTER_DRAIN = false;
    bf16_t* P; const float* RS; float* VST;
    __device__ __forceinline__ void operator()(const f32x4 (&acc)[2][2][4][2], const Unit& u, int wr, int wc, int fr, int fq) const {
        const int row0 = u.pm * BM + wr * 64 + fr; const int col0 = u.pn * BM + wc * 32 + 8 * fq; const bool act = u.pn < 16, vst = u.pn >= 8 && u.pn < 16;
        float rsv[2][4];
#pragma unroll
        for (int ai = 0; ai < 2; ++ai)
#pragma unroll
            for (int m = 0; m < 4; ++m) rsv[ai][m] = RS[row0 + ai * HALF + m * 16];
#pragma unroll
        for (int ai = 0; ai < 2; ++ai)
#pragma unroll
            for (int m = 0; m < 4; ++m) { const int row = row0 + ai * HALF + m * 16; const float rs = rsv[ai][m]; bf16_t* rowp = P + (size_t)row * N1 + col0; float s1 = 0.f, s2 = 0.f;
#pragma unroll
                for (int bj = 0; bj < 2; ++bj) { f32x4 v0 = acc[ai][bj][m][0] * rs, v1 = acc[ai][bj][m][1] * rs;
                    if (act) { f32x2 a = gelu_pk((f32x2){v0[0], v0[1]}), b = gelu_pk((f32x2){v0[2], v0[3]}), c = gelu_pk((f32x2){v1[0], v1[1]}), d = gelu_pk((f32x2){v1[2], v1[3]});
                        v0 = (f32x4){a.x, a.y, b.x, b.y}; v1 = (f32x4){c.x, c.y, d.x, d.y}; }
                    if (vst) { s1 += (v0[0] + v0[1]) + (v0[2] + v0[3]) + (v1[0] + v1[1]) + (v1[2] + v1[3]);
                        s2 += (v0[0] * v0[0] + v0[1] * v0[1]) + (v0[2] * v0[2] + v0[3] * v0[3]) + (v1[0] * v1[0] + v1[1] * v1[1]) + (v1[2] * v1[2] + v1[3] * v1[3]); }
                    ::u32x4 w; w.x = cvt_pk_bf16(v0[0], v0[1]); w.y = cvt_pk_bf16(v0[2], v0[3]); w.z = cvt_pk_bf16(v1[0], v1[1]); w.w = cvt_pk_bf16(v1[2], v1[3]);
                    *(::u32x4*)(rowp + bj * HALF) = w; }
                if (vst) { s1 += __shfl_xor(s1, 16); s1 += __shfl_xor(s1, 32); s2 += __shfl_xor(s2, 16); s2 += __shfl_xor(s2, 32);
                    if (fq == 0) *(f32x2*)(VST + ((size_t)row * 32 + (u.pn - 8) * 4 + wc) * 2) = (f32x2){s1, s2}; } }
    }
};
struct EpiRes0 {
    static constexpr bool PERM = true, AFTER_DRAIN = false;
    const float* X; bf16_t* XB; float* PART;
    __device__ __forceinline__ void operator()(const f32x4 (&acc)[2][2][4][2], const Unit& u, int wr, int wc, int fr, int fq) const {
        const int row0 = u.pm * BM + wr * 64 + fr; const int col0 = u.pn * BM + wc * 32 + 8 * fq;
#pragma unroll
        for (int ai = 0; ai < 2; ++ai) {
            f32x4 xr[4][2][2];
#pragma unroll
            for (int m = 0; m < 4; ++m)
#pragma unroll
                for (int bj = 0; bj < 2; ++bj) { const size_t off = (size_t)(row0 + ai * HALF + m * 16) * DM + col0 + bj * HALF; xr[m][bj][0] = *(const f32x4*)(X + off); xr[m][bj][1] = *(const f32x4*)(X + off + 4); }
#pragma unroll
            for (int m = 0; m < 4; ++m) { const int row = row0 + ai * HALF + m * 16; const size_t off = (size_t)row * DM + col0; float ss = 0.f;
#pragma unroll
                for (int bj = 0; bj < 2; ++bj) { const f32x4 v0 = xr[m][bj][0] + acc[ai][bj][m][0], v1 = xr[m][bj][1] + acc[ai][bj][m][1];
                    ss += (v0[0] * v0[0] + v0[1] * v0[1]) + (v0[2] * v0[2] + v0[3] * v0[3]) + (v1[0] * v1[0] + v1[1] * v1[1]) + (v1[2] * v1[2] + v1[3] * v1[3]);
                    ::u32x4 w; w.x = cvt_pk_bf16(v0[0], v0[1]); w.y = cvt_pk_bf16(v0[2], v0[3]); w.z = cvt_pk_bf16(v1[0], v1[1]); w.w = cvt_pk_bf16(v1[2], v1[3]);
                    *(::u32x4*)(XB + off + bj * HALF) = w; }
                ss += __shfl_xor(ss, 16); ss += __shfl_xor(ss, 32);
                if (fq == 0) PART[(size_t)row * 32 + u.pn * 4 + wc] = ss; } }
    }
};
struct EpiRes1 {
    static constexpr bool PERM = true, AFTER_DRAIN = false;
    const bf16_t* XB; float* O;
    __device__ __forceinline__ void operator()(const f32x4 (&acc)[2][2][4][2], const Unit& u, int wr, int wc, int fr, int fq) const {
        const int row0 = u.pm * BM + wr * 64 + fr; const int col0 = u.pn * BM + wc * 32 + 8 * fq;
        ::u32x4 xbv[2][4][2];
#pragma unroll
        for (int ai = 0; ai < 2; ++ai)
#pragma unroll
            for (int m = 0; m < 4; ++m)
#pragma unroll
                for (int bj = 0; bj < 2; ++bj) xbv[ai][m][bj] = *(const ::u32x4*)(XB + (size_t)(row0 + ai * HALF + m * 16) * DM + col0 + bj * HALF);
#pragma unroll
        for (int ai = 0; ai < 2; ++ai)
#pragma unroll
            for (int m = 0; m < 4; ++m) { const size_t off = (size_t)(row0 + ai * HALF + m * 16) * DM + col0;
#pragma unroll
                for (int bj = 0; bj < 2; ++bj) { const ::u32x4 xb = xbv[ai][m][bj];
                    const f32x4 r0 = {::bflo(xb.x), ::bfhi(xb.x), ::bflo(xb.y), ::bfhi(xb.y)}, r1 = {::bflo(xb.z), ::bfhi(xb.z), ::bflo(xb.w), ::bfhi(xb.w)};
                    *(f32x4*)(O + off + bj * HALF) = r0 + acc[ai][bj][m][0]; *(f32x4*)(O + off + bj * HALF + 4) = r1 + acc[ai][bj][m][1]; } }
    }
};
}
__device__ __forceinline__ void transpose_item(const float* __restrict__ W, int K, int Nsrc, int src_n0, bf16_t* __restrict__ WT, int dst_n0, int k0, LAS float* scr, int lane, const float* __restrict__ kscale = nullptr) {
    { const int n4 = (lane & 7) * 4; f32x4 tv[8];
#pragma unroll
        for (int i = 0; i < 8; ++i) { const int kk = (lane >> 3) + 8 * i;
            tv[i] = (src_n0 >= 0) ? *(const f32x4*)(W + (size_t)(k0 + kk) * Nsrc + src_n0 + n4) * (kscale ? kscale[k0 + kk] : 1.f) : (f32x4){0.f, 0.f, 0.f, 0.f}; }
#pragma unroll
        for (int i = 0; i < 8; ++i) { const int kk = (lane >> 3) + 8 * i; LAS float* d = scr + kk * 33 + n4; d[0] = tv[i].x; d[1] = tv[i].y; d[2] = tv[i].z; d[3] = tv[i].w; } }
    LDS_WAIT(); asm volatile("" ::: "memory");
    const int c = lane & 7;
#pragma unroll
    for (int j = 0; j < 4; ++j) { const int n = (lane >> 3) + 8 * j; const LAS float* s = scr + (8 * c) * 33 + n;
        u32x4 o; o.x = cvt_pk_bf16(s[0 * 33], s[1 * 33]); o.y = cvt_pk_bf16(s[2 * 33], s[3 * 33]); o.z = cvt_pk_bf16(s[4 * 33], s[5 * 33]); o.w = cvt_pk_bf16(s[6 * 33], s[7 * 33]);
        *(u32x4*)(WT + (size_t)(dst_n0 + n) * K + k0 + 8 * c) = o; }
    LDS_WAIT(); asm volatile("" ::: "memory");
}
__device__ __forceinline__ void rms_row(const float* __restrict__ xrow, const float* __restrict__ g, bf16_t* __restrict__ orow, int lane) {
    const f32x4* xr = (const f32x4*)xrow + lane; f32x4 v[8]; float s = 0.f;
#pragma unroll
    for (int j = 0; j < 8; ++j) { v[j] = xr[64 * j]; s += (v[j].x * v[j].x + v[j].y * v[j].y) + (v[j].z * v[j].z + v[j].w * v[j].w); }
    const float r = 1.0f / sqrtf(wave_sum(s) * (1.f / DM) + EPS);
    const f32x4* gr = (const f32x4*)g + lane; u32x2* o8 = (u32x2*)orow + lane;
#pragma unroll
    for (int j = 0; j < 8; ++j) { const f32x4 gg = gr[64 * j]; u32x2 w; w.x = cvt_pk_bf16(v[j].x * r * gg.x, v[j].y * r * gg.y); w.y = cvt_pk_bf16(v[j].z * r * gg.z, v[j].w * r * gg.w); o8[64 * j] = w; }
}
__device__ __forceinline__ void rms_row2(const float* __restrict__ xa, const float* __restrict__ xb, const float* __restrict__ g, bf16_t* __restrict__ oa, bf16_t* __restrict__ ob, int lane) {
    const f32x4* xra = (const f32x4*)xa + lane; const f32x4* xrb = (const f32x4*)xb + lane; f32x4 va[8], vb[8]; float sa = 0.f, sb = 0.f;
#pragma unroll
    for (int j = 0; j < 8; ++j) { va[j] = xra[64 * j]; vb[j] = xrb[64 * j]; }
#pragma unroll
    for (int j = 0; j < 8; ++j) { sa += (va[j].x * va[j].x + va[j].y * va[j].y) + (va[j].z * va[j].z + va[j].w * va[j].w); sb += (vb[j].x * vb[j].x + vb[j].y * vb[j].y) + (vb[j].z * vb[j].z + vb[j].w * vb[j].w); }
    const float ra = 1.0f / sqrtf(wave_sum(sa) * (1.f / DM) + EPS), rb = 1.0f / sqrtf(wave_sum(sb) * (1.f / DM) + EPS);
    const f32x4* gr = (const f32x4*)g + lane; u32x2* o8a = (u32x2*)oa + lane; u32x2* o8b = (u32x2*)ob + lane;
#pragma unroll
    for (int j = 0; j < 8; ++j) { const f32x4 gg = gr[64 * j]; u32x2 w;
        w.x = cvt_pk_bf16(va[j].x * ra * gg.x, va[j].y * ra * gg.y); w.y = cvt_pk_bf16(va[j].z * ra * gg.z, va[j].w * ra * gg.w); o8a[64 * j] = w;
        w.x = cvt_pk_bf16(vb[j].x * rb * gg.x, vb[j].y * rb * gg.y); w.y = cvt_pk_bf16(vb[j].z * rb * gg.z, vb[j].w * rb * gg.w); o8b[64 * j] = w; }
}
struct P0Args { const float* x; const float* g0; const float* g1; const float* w_in0; const float* w_out0; const float* w_in1; const float* w_out1; bf16_t* W0T; bf16_t* WO0T; bf16_t* W1T; bf16_t* WO1T; bf16_t* H; };
__device__ __forceinline__ void p0_prologue(const P0Args& a, LAS unsigned char* lds, int gw, int NGW, int wave, int lane) {
    LAS float* scr = (LAS float*)(lds + wave * 16384);
    constexpr int I0 = 32 * (N0P / 32), IO = 32 * (DM / 32), I1 = 32 * (N1 / 32);
    constexpr int NITEMS = I0 + IO + I1 + IO;
    for (int it = gw; it < NITEMS; it += NGW) {
        int r = it;
        if (r < I0) { const int nblk = N0P / 32, kb = r / nblk, nb = r % nblk, d0 = 32 * nb;
            const int src = d0 < 4096 ? d0 : (d0 < 6656 ? d0 + 32 : (d0 == 6656 ? 4096 : -1));
            transpose_item(a.w_in0, DM, 6688, src, a.W0T, d0, 64 * kb, scr, lane); continue; }
        r -= I0;
        if (r < IO) { const int nblk = DM / 32, kb = r / nblk, nb = r % nblk; transpose_item(a.w_out0, DM, DM, 32 * nb, a.WO0T, 32 * nb, 64 * kb, scr, lane); continue; }
        r -= IO;
        if (r < I1) { const int nblk = N1 / 32, kb = r / nblk, nb = r % nblk; transpose_item(a.w_in1, DM, N1, 32 * nb, a.W1T, 32 * nb, 64 * kb, scr, lane, a.g1); continue; }
        r -= I1;
        { const int nblk = DM / 32, kb = r / nblk, nb = r % nblk; transpose_item(a.w_out1, DM, DM, 32 * nb, a.WO1T, 32 * nb, 64 * kb, scr, lane); }
    }
    for (int m = gw; m < TOK; m += 2 * NGW) rms_row2(a.x + (size_t)m * DM, a.x + (size_t)(m + NGW) * DM, a.g0, a.H + (size_t)m * DM, a.H + (size_t)(m + NGW) * DM, lane);
}

__device__ __forceinline__ void p2_conv_item(const bf16_t* __restrict__ P, const float* __restrict__ cw, bf16_t* __restrict__ QKV, int item, int lane) {
    const int run = item / 6, slice = item % 6, t0 = run * 16, b = t0 / SEQ, l0 = t0 % SEQ, ch0 = slice * 512 + lane * 8;
    float w[5][8];
#pragma unroll
    for (int j = 0; j < 5; ++j) { const f32x4 a = *(const f32x4*)(cw + j * 3072 + ch0), c = *(const f32x4*)(cw + j * 3072 + ch0 + 4);
        w[j][0] = a.x; w[j][1] = a.y; w[j][2] = a.z; w[j][3] = a.w; w[j][4] = c.x; w[j][5] = c.y; w[j][6] = c.z; w[j][7] = c.w; }
    u32x4 rows[20];
#pragma unroll
    for (int r = 0; r < 20; ++r) { const int l = l0 - 2 + r, lc = l < 0 ? 0 : (l >= SEQ ? SEQ - 1 : l);
        rows[r] = *(const u32x4*)(P + (size_t)(b * SEQ + lc) * P0LD + ch0);
        if (l != lc) rows[r] = (u32x4){0u, 0u, 0u, 0u}; }
    float win[5][8];
#pragma unroll
    for (int j = 0; j < 5; ++j)
#pragma unroll
        for (int e = 0; e < 8; ++e) win[j][e] = 0.f;
#pragma unroll
    for (int r = 0; r < 20; ++r) {
#pragma unroll
        for (int j = 0; j < 4; ++j)
#pragma unroll
            for (int e = 0; e < 8; ++e) win[j][e] = win[j + 1][e];
        unpack8(rows[r], win[4]);
        if (r >= 4) {
            float y[8]; float ss = 0.f;
#pragma unroll
            for (int e = 0; e < 8; ++e) { float acc = 0.f;
#pragma unroll
                for (int j = 0; j < 5; ++j) acc = fmaf(w[j][e], win[j][e], acc);
                y[e] = silu_f(acc); ss = fmaf(y[e], y[e], ss); }
            if (slice < 4) {
                ss += __shfl_xor(ss, 1); ss += __shfl_xor(ss, 2); ss += __shfl_xor(ss, 4); ss += __shfl_xor(ss, 8);
                const float rn = 1.0f / sqrtf(ss + EPS);
#pragma unroll
                for (int e = 0; e < 8; ++e) y[e] *= rn;
            }
            *(u32x4*)(QKV + (size_t)(t0 + r - 4) * 3072 + ch0) = pack8(y);
        }
    }
}

template <int NT>
__device__ __forceinline__ void p2_rope_tokens(bf16_t* __restrict__ P, const float* __restrict__ qn_g, const float* __restrict__ kn_g, int t0, int tstride, int lane) {
    const int half = lane >> 5, i = lane & 31;
    const float inv = exp2f(-(float)i * (13.287712379549449f / 32.f));
    const int e1 = half * 64 + i, e2 = e1 + 32;
    const float gq1 = qn_g[e1], gq2 = qn_g[e2], gk1 = kn_g[e1], gk2 = kn_g[e2];
    float x1[NT][10], x2[NT][10];
#pragma unroll
    for (int k = 0; k < NT; ++k) { const bf16_t* row = P + (size_t)(t0 + k * tstride) * P0LD;
#pragma unroll
        for (int hh = 0; hh < 10; ++hh) { const bf16_t* hp = row + (hh < 8 ? C_BQ + hh * 128 : C_BK + (hh - 8) * 128); x1[k][hh] = bf2f(hp[e1]); x2[k][hh] = bf2f(hp[e2]); } }
#pragma unroll
    for (int k = 0; k < NT; ++k) { const int t = t0 + k * tstride, l = t % SEQ; bf16_t* row = P + (size_t)t * P0LD;
        const float pos = half ? (float)(l % 64) : (float)(l / 64);
        float rev = pos * inv * 0.15915494309189535f; rev -= floorf(rev);
        const float sn = __builtin_amdgcn_sinf(rev), cs = __builtin_amdgcn_cosf(rev);
#pragma unroll
        for (int hh = 0; hh < 10; ++hh) {
            bf16_t* hp = row + (hh < 8 ? C_BQ + hh * 128 : C_BK + (hh - 8) * 128);
            const float ss = wave_sum(x1[k][hh] * x1[k][hh] + x2[k][hh] * x2[k][hh]);
            const float rn = 1.0f / sqrtf(ss * (1.f / 128.f) + EPS);
            const float y1 = x1[k][hh] * rn * (hh < 8 ? gq1 : gk1), y2 = x2[k][hh] * rn * (hh < 8 ? gq2 : gk2);
            hp[e1] = f2bf(y1 * cs - y2 * sn); hp[e2] = f2bf(y2 * cs + y1 * sn);
        } }
}

template <int NT>
__device__ __forceinline__ void p4_tokens(const bf16_t* __restrict__ OF, const bf16_t* __restrict__ OB, const bf16_t* __restrict__ P, const float* __restrict__ og, bf16_t* __restrict__ Y, int t0, int lane) {
    u32x4 ra[NT][2], rb[NT][2], rg[NT][2];
#pragma unroll
    for (int k = 0; k < NT; ++k)
#pragma unroll
        for (int i = 0; i < 2; ++i) { const int col0 = i * 512 + lane * 8; const size_t t = (size_t)(t0 + k);
            ra[k][i] = *(const u32x4*)(OF + t * 1024 + col0); rb[k][i] = *(const u32x4*)(OB + t * 1024 + col0); rg[k][i] = *(const u32x4*)(P + t * P0LD + C_AG + col0); }
#pragma unroll
    for (int k = 0; k < NT; ++k)
#pragma unroll
        for (int i = 0; i < 2; ++i) { const int col0 = i * 512 + lane * 8; float a[8], b[8], g[8], y[8];
            unpack8(ra[k][i], a); unpack8(rb[k][i], b); unpack8(rg[k][i], g);
            float ss = 0.f;
#pragma unroll
            for (int e = 0; e < 8; ++e) { a[e] += b[e]; ss = fmaf(a[e], a[e], ss); }
            ss += __shfl_xor(ss, 1); ss += __shfl_xor(ss, 2); ss += __shfl_xor(ss, 4); ss += __shfl_xor(ss, 8);
            const float rn = 1.0f / sqrtf(ss * (1.f / 128.f) + EPS);
            const int e0 = col0 & 127;
#pragma unroll
            for (int e = 0; e < 8; ++e) y[e] = a[e] * rn * og[e0 + e] * silu_f(g[e]);
            *(u32x4*)(Y + (size_t)(t0 + k) * DM + col0) = pack8(y); }
}
namespace att {
constexpr int D = 128, NW = 8, QBLK = 32, KVBLK = 64;
constexpr float SCALE = 0.088388347648318440f;
constexpr float THR = 8.f;
constexpr int SDEPTH = 2;
constexpr int LDQ = P0LD, LDK = P0LD;
constexpr size_t SHM_V = KVBLK * D * 2, SHM_K = KVBLK * D * 2, SHM_ATTN = 2 * SHM_V + 2 * SHM_K + NW * 64 * 4;
#define KSWZ(row, colB) ((row) * 256 + ((colB) ^ (((row) & 7) << 4)))
#define SBAR() __builtin_amdgcn_sched_barrier(0)
__device__ __forceinline__ unsigned cvtpk(float lo, float hi) { unsigned r; asm volatile("v_cvt_pk_bf16_f32 %0, %1, %2" : "=v"(r) : "v"(lo), "v"(hi)); return r; }
__device__ __forceinline__ void partialSM(f32x16& p0, f32x16& p1, float& m_reg, float& mn, float& alpha) {
  constexpr float C = SCALE * 1.4426950408889634f;
  float pmax = p0[0]; for (int r = 1; r < 16; ++r) pmax = fmaxf(pmax, p0[r]); for (int r = 0; r < 16; ++r) pmax = fmaxf(pmax, p1[r]);
  { auto rr = __builtin_amdgcn_permlane32_swap(__float_as_uint(pmax), __float_as_uint(pmax), false, false);
    pmax = fmaxf(__uint_as_float(rr[0]), __uint_as_float(rr[1])); }
  if (__builtin_expect(__all(pmax - m_reg <= THR / SCALE), 1)) { mn = m_reg; alpha = 1.f; }
  else { mn = fmaxf(m_reg, pmax); alpha = __builtin_amdgcn_exp2f((m_reg - mn) * C); m_reg = mn; }
  float mnC = -mn * C;
  for (int r = 0; r < 16; ++r) p0[r] = fmaf(p0[r], C, mnC); for (int r = 0; r < 16; ++r) p1[r] = fmaf(p1[r], C, mnC);
  for (int r = 0; r < 16; ++r) p0[r] = __builtin_amdgcn_exp2f(p0[r]);
}
__device__ __forceinline__ void finishSM(f32x16& p0, f32x16& p1, float alpha, float& l_reg, bf16x8& pa0, bf16x8& pa1, bf16x8& pa2, bf16x8& pa3) {
  for (int r = 0; r < 16; ++r) p1[r] = __builtin_amdgcn_exp2f(p1[r]);
  float ps = 0; for (int r = 0; r < 16; ++r) ps += p0[r]; for (int r = 0; r < 16; ++r) ps += p1[r];
  { auto rr = __builtin_amdgcn_permlane32_swap(__float_as_uint(ps), __float_as_uint(ps), false, false);
    ps = __uint_as_float(rr[0]) + __uint_as_float(rr[1]); }
  l_reg = l_reg * alpha + ps;
#define PK4(P, BASE, OUT) do { unsigned a0 = cvtpk(P[BASE + 0], P[BASE + 1]), a1 = cvtpk(P[BASE + 2], P[BASE + 3]);   \
    unsigned b0 = cvtpk(P[BASE + 4], P[BASE + 5]), b1 = cvtpk(P[BASE + 6], P[BASE + 7]);                              \
    auto r0 = __builtin_amdgcn_permlane32_swap(a0, b0, false, false); auto r1 = __builtin_amdgcn_permlane32_swap(a1, b1, false, false); \
    u32x4 w = {r0[0], r1[0], r0[1], r1[1]}; OUT = *reinterpret_cast<bf16x8*>(&w); } while (0)
  PK4(p0, 0, pa0); PK4(p0, 8, pa1); PK4(p1, 0, pa2); PK4(p1, 8, pa3);
#undef PK4
}
__device__ __forceinline__ void qkt(f32x16& p0, f32x16& p1, const bf16_t* Ks, const bf16x8* qr, int r32, int hi) {
  p0 = f32x16{}; p1 = f32x16{};
  for (int d0 = 0; d0 < 8; ++d0) { int cb = (d0 * 16 + hi * 8) * 2;
    bf16x8 b0 = *reinterpret_cast<const bf16x8*>((const char*)Ks + KSWZ(r32, cb));
    bf16x8 b1 = *reinterpret_cast<const bf16x8*>((const char*)Ks + KSWZ(32 + r32, cb));
    p0 = __builtin_amdgcn_mfma_f32_32x32x16_bf16(b0, qr[d0], p0, 0, 0, 0);
    p1 = __builtin_amdgcn_mfma_f32_32x32x16_bf16(b1, qr[d0], p1, 0, 0, 0); }
}
__device__ __forceinline__ int v_st(int k, int c) { const int kk = (k & ~0xC) | ((k & 4) << 1) | ((k & 8) >> 1); return ((kk >> 3) * 4 + (c >> 5)) * 512 + ((kk & 7) * 32 + (c & 31)) * 2; }
__device__ __forceinline__ int v_rd_base(int lane) { return ((lane & 3) << 3) | (((lane >> 2) & 3) << 6) | (((lane >> 4) & 1) << 5) | (((lane >> 5) & 1) << 8); }
constexpr int v_rd_off(int d0, int ks, int half) { return d0 * 512 + ks * 4096 + half * 2048; }
template <int OFF> __device__ __forceinline__ s16x4 tr_read(int vb) {
  s16x4 r; asm volatile("ds_read_b64_tr_b16 %0, %1 offset:%2" : "=&v"(r) : "v"(vb), "i"(OFF) : "memory"); return r;
}
template <int D0> __device__ __forceinline__ void pv_one(f32x16& od, int vb, bf16x8 pa0, bf16x8 pa1, bf16x8 pa2, bf16x8 pa3) {
  const s16x4 l0 = tr_read<v_rd_off(D0, 0, 0)>(vb), h0 = tr_read<v_rd_off(D0, 0, 1)>(vb), l1 = tr_read<v_rd_off(D0, 1, 0)>(vb), h1 = tr_read<v_rd_off(D0, 1, 1)>(vb);
  const s16x4 l2 = tr_read<v_rd_off(D0, 2, 0)>(vb), h2 = tr_read<v_rd_off(D0, 2, 1)>(vb), l3 = tr_read<v_rd_off(D0, 3, 0)>(vb), h3 = tr_read<v_rd_off(D0, 3, 1)>(vb);
  asm volatile("s_waitcnt lgkmcnt(0)" ::: "memory"); SBAR();
#define PK(L, H) (bf16x8){L[0], L[1], L[2], L[3], H[0], H[1], H[2], H[3]}
  od = __builtin_amdgcn_mfma_f32_32x32x16_bf16(pa0, PK(l0, h0), od, 0, 0, 0);
  od = __builtin_amdgcn_mfma_f32_32x32x16_bf16(pa1, PK(l1, h1), od, 0, 0, 0);
  od = __builtin_amdgcn_mfma_f32_32x32x16_bf16(pa2, PK(l2, h2), od, 0, 0, 0);
  od = __builtin_amdgcn_mfma_f32_32x32x16_bf16(pa3, PK(l3, h3), od, 0, 0, 0);
#undef PK
}
__device__ __forceinline__ void pv_d0(f32x16* o, int vb, bf16x8 pa0, bf16x8 pa1, bf16x8 pa2, bf16x8 pa3) {
  pv_one<0>(o[0], vb, pa0, pa1, pa2, pa3); pv_one<1>(o[1], vb, pa0, pa1, pa2, pa3); pv_one<2>(o[2], vb, pa0, pa1, pa2, pa3); pv_one<3>(o[3], vb, pa0, pa1, pa2, pa3);
}
__device__ __forceinline__ void attn_dense_body(const bf16_t* __restrict__ Qb, const bf16_t* __restrict__ Kh, const bf16_t* __restrict__ Vh,
                                                const bf16_t* __restrict__ Gb, bf16_t* __restrict__ Yb, int seq, char* lds) {
  int tid = threadIdx.x; asm volatile("" : "+v"(tid));
  const int wid = tid >> 6, lane = tid & 63, r32 = lane & 31, hi = lane >> 5;
  bf16_t* V_lds = (bf16_t*)lds; bf16_t* K_lds = (bf16_t*)(lds + 2 * SHM_V);
  float* ws = (float*)(lds + 2 * SHM_V + 2 * SHM_K) + wid * 64; float* li_l = ws; float* al_l = ws + 32;
  float m_reg = -1e30f, l_reg = 0; f32x16 o[4] = {}; bf16x8 qr[8];
  const bf16_t* Qw = Qb + (long)(wid * QBLK + r32) * LDQ + hi * 8;
#pragma unroll
  for (int d0 = 0; d0 < 8; ++d0) qr[d0] = *reinterpret_cast<const bf16x8*>(Qw + d0 * 16);
  const int sr = tid >> 4, sc = (tid & 15) * 8, vst0 = v_st(sr, sc), vst1 = v_st(32 + sr, sc);
  const int vb0 = (int)(uintptr_t)V_lds + v_rd_base(lane);
  struct { bf16x8 vs0, vs1, ks0, ks1; } sr_[SDEPTH];
  const unsigned voff0 = (unsigned)((sr * LDK + sc) * 2), voff1 = voff0 + (unsigned)(32 * LDK * 2);
#define SLOAD(i, k0) do { const char* vb_ = (const char*)Vh + (size_t)(k0) * (LDK * 2); const char* kb_ = (const char*)Kh + (size_t)(k0) * (LDK * 2); \
    sr_[i].vs0 = *reinterpret_cast<const bf16x8*>(vb_ + voff0); sr_[i].vs1 = *reinterpret_cast<const bf16x8*>(vb_ + voff1); \
    sr_[i].ks0 = *reinterpret_cast<const bf16x8*>(kb_ + voff0); sr_[i].ks1 = *reinterpret_cast<const bf16x8*>(kb_ + voff1); } while (0)
#define SWRITE(b, i) do { *(bf16x8*)((char*)V_lds + (b) * SHM_V + vst0) = sr_[i].vs0;          \
    *(bf16x8*)((char*)V_lds + (b) * SHM_V + vst1) = sr_[i].vs1; int kc = sc * 2;               \
    *(bf16x8*)((char*)K_lds + (b) * SHM_K + KSWZ(sr, kc)) = sr_[i].ks0;                       \
    *(bf16x8*)((char*)K_lds + (b) * SHM_K + KSWZ(32 + sr, kc)) = sr_[i].ks1; } while (0)
#define SWAIT() do { if constexpr (SDEPTH == 2) asm volatile("s_waitcnt vmcnt(4)" ::: "memory"); else asm volatile("s_waitcnt vmcnt(0)" ::: "memory"); } while (0)
#define RESC(a) do { if (__any((a) < 1.f)) { if (hi == 0) al_l[r32] = (a); asm volatile("s_waitcnt lgkmcnt(0)" ::: "memory"); \
    for (int d = 0; d < 4; ++d) for (int r = 0; r < 16; ++r) o[d][r] *= al_l[crow(r, hi)]; } } while (0)
  f32x16 pA0, pA1, pB0, pB1; float mnA, mnB, alA, alB; bf16x8 pa0, pa1, pa2, pa3; const int NT = seq / KVBLK;
  constexpr int SE = 0, SO = SDEPTH - 1;
  SLOAD(SE, 0); asm volatile("s_waitcnt vmcnt(0)" ::: "memory"); SWRITE(0, SE); __syncthreads();
  qkt(pA0, pA1, K_lds, qr, r32, hi); partialSM(pA0, pA1, m_reg, mnA, alA);
  SLOAD(SO, KVBLK); if constexpr (SDEPTH == 2) { if (2 < NT) SLOAD(SE, 2 * KVBLK); }
  SWAIT(); SWRITE(1, SO); __syncthreads();
  for (int j = 1; j + 1 < NT; j += 2) {
    SBAR(); qkt(pB0, pB1, (bf16_t*)((char*)K_lds + SHM_K), qr, r32, hi);
    finishSM(pA0, pA1, alA, l_reg, pa0, pa1, pa2, pa3); SBAR();
    SLOAD(SO, (j + SDEPTH) * KVBLK); SBAR();
    pv_d0(o, vb0, pa0, pa1, pa2, pa3); partialSM(pB0, pB1, m_reg, mnB, alB);
    __syncthreads(); SWAIT(); SWRITE(0, SE);
    RESC(alB); __syncthreads();
    SBAR(); qkt(pA0, pA1, K_lds, qr, r32, hi);
    finishSM(pB0, pB1, alB, l_reg, pa0, pa1, pa2, pa3); SBAR();
    if (SDEPTH == 1 || j + 3 < NT) SLOAD(SE, (j + 1 + SDEPTH) * KVBLK); SBAR();
    pv_d0(o, vb0 + (int)SHM_V, pa0, pa1, pa2, pa3); partialSM(pA0, pA1, m_reg, mnA, alA);
    __syncthreads(); SWAIT(); SWRITE(1, SO);
    RESC(alA); __syncthreads();
  }
  SBAR(); qkt(pB0, pB1, (bf16_t*)((char*)K_lds + SHM_K), qr, r32, hi);
  finishSM(pA0, pA1, alA, l_reg, pa0, pa1, pa2, pa3); SBAR();
  pv_d0(o, vb0, pa0, pa1, pa2, pa3); partialSM(pB0, pB1, m_reg, mnB, alB);
  __syncthreads(); RESC(alB);
  finishSM(pB0, pB1, alB, l_reg, pa0, pa1, pa2, pa3); SBAR();
  pv_d0(o, vb0 + (int)SHM_V, pa0, pa1, pa2, pa3);
  if (hi == 0) li_l[r32] = l_reg; asm volatile("s_waitcnt lgkmcnt(0)" ::: "memory");
  float rli[16];
#pragma unroll
  for (int r = 0; r < 16; ++r) rli[r] = __builtin_amdgcn_rcpf(li_l[crow(r, hi)]);
  const bf16_t* Gw = Gb + (long)(wid * QBLK) * LDQ; bf16_t* Yw = Yb + (long)(wid * QBLK) * DM;
  u32x4 graw[8];
#pragma unroll
  for (int it = 0; it < 8; ++it) { const int idx = it * 64 + lane, row = idx >> 4, c8 = (idx & 15) * 8; graw[it] = *(const u32x4*)((const char*)Gw + (unsigned)((row * LDQ + c8) * 2)); }
  __syncthreads();
  { bf16_t* Ol = (bf16_t*)(lds + wid * 8192);
#pragma unroll
    for (int r = 0; r < 16; ++r) { const int orow = crow(r, hi);
#pragma unroll
      for (int d0 = 0; d0 < 4; ++d0) Ol[orow * 128 + d0 * 32 + r32] = f2bf(o[d0][r] * rli[r]); }
    asm volatile("s_waitcnt lgkmcnt(0)" ::: "memory");
#pragma unroll
    for (int it = 0; it < 8; ++it) { const int idx = it * 64 + lane, row = idx >> 4, c8 = (idx & 15) * 8; float ov[8], gv[8];
      unpack8(*(const u32x4*)(Ol + row * 128 + c8), ov); unpack8(graw[it], gv);
#pragma unroll
      for (int e = 0; e < 8; ++e) ov[e] *= silu_f(gv[e]);
      *(u32x4*)((char*)Yw + (unsigned)((row * DM + c8) * 2)) = pack8(ov); } }
  __syncthreads();
#undef SLOAD
#undef SWRITE
#undef SWAIT
#undef RESC
}
}
#ifndef DN_STAGE
#define DN_STAGE 7
#endif
namespace dn {
constexpr int KC_OFF = 0, QC_OFF = 17408, KT_OFF = 34816, VT_OFF = 53248, T1_OFF = VT_OFF + 18432, T2_OFF = T1_OFF + 9216;
constexpr int VN_OFF = VT_OFF, VNS_OFF = VT_OFF + 18432;
constexpr int MT_OFF = 90112, YF_OFF = MT_OFF + 16640, AT_OFF = YF_OFF + 4224, ST_OFF = AT_OFF + 9216, MISC_OFF = ST_OFF + 34816;
static_assert(MISC_OFF + 2048 <= LDS_BYTES - 64, "deltanet LDS map");
constexpr float SCALE = 0.088388347648318440f;
struct Args { const bf16_t* QKV; const float* LOG; const float* a_log; const float* dt_bias; bf16_t* OF; bf16_t* OB; };
__device__ __forceinline__ bf16x8 ldf(const LAS unsigned char* base, int row, int strideB, int kb) { return *(const LAS bf16x8*)(base + row * strideB + kb); }
#define DN_MFMA(a, b, c) __builtin_amdgcn_mfma_f32_32x32x16_bf16(a, b, c, 0, 0, 0)
__device__ __forceinline__ void unit(const Args& a, int un, LAS unsigned char* lds) {
    int tid = threadIdx.x; asm volatile("" : "+v"(tid));
    const int w = __builtin_amdgcn_readfirstlane(tid >> 6), lane = tid & 63, r32 = lane & 31, hi = lane >> 5;
    const int b = un >> 4, h = (un >> 1) & 7, dir = un & 1, wr = w >> 2, wc = w & 3;
    const float Aexp = expf(a.a_log[dir * 8 + h]), dtb = a.dt_bias[dir * 8 + h];
    bf16_t* __restrict__ O = dir ? a.OB : a.OF;
    LAS float* MT = (LAS float*)(lds + MT_OFF); LAS float* YF = (LAS float*)(lds + YF_OFF);
    LAS float* gc = (LAS float*)(lds + MISC_OFF); LAS float* beta = gc + 64; LAS float* eg = gc + 128; LAS float* ekl = gc + 192; LAS float* scal = gc + 256;
    __syncthreads();
    for (int i = tid; i < 34816 / 16; i += NTHR) *(LAS u32x4*)(lds + ST_OFF + i * 16) = (u32x4){0u, 0u, 0u, 0u};
    f32x16 accS[2];
#pragma unroll
    for (int r = 0; r < 16; ++r) { accS[0][r] = 0.f; accS[1][r] = 0.f; }
    u32x4 pq[2], pk[2], pv[2]; float pa = 0.f, pb = 0.f;
#define DN_LOADC(n) do { _Pragma("unroll") for (int i_ = 0; i_ < 2; ++i_) { const int idx_ = tid + NTHR * i_, c_ = idx_ & 63, d8_ = (idx_ >> 6) * 8, p_ = 64 * (n) + c_, l_ = dir ? SEQ - 1 - p_ : p_; \
        const unsigned bo_ = ((unsigned)(b * SEQ + l_) * 3072u + (unsigned)(h * 128 + d8_)) * 2u; const char* s_ = (const char*)a.QKV; \
        pq[i_] = *(const u32x4*)(s_ + bo_); pk[i_] = *(const u32x4*)(s_ + (bo_ + 2048u)); pv[i_] = *(const u32x4*)(s_ + (bo_ + 4096u)); } \
        if (w == 0) { const int p_ = 64 * (n) + lane, l_ = dir ? SEQ - 1 - p_ : p_; const unsigned lo_ = ((unsigned)(b * SEQ + l_) * 32u + (unsigned)(dir * 8 + h)) * 4u; \
            const char* l2_ = (const char*)a.LOG + (size_t)TOK * 32 * 4; pa = *(const float*)((const char*)a.LOG + lo_) + *(const float*)(l2_ + lo_); pb = *(const float*)((const char*)a.LOG + (lo_ + 64u)) + *(const float*)(l2_ + (lo_ + 64u)); } } while (0)
    DN_LOADC(0);
    for (int n = 0; n < 64; ++n) {
#pragma unroll
        for (int i = 0; i < 2; ++i) { const int idx = tid + NTHR * i, c = idx & 63, d8 = (idx >> 6) * 8;
            *(LAS u32x4*)(lds + KC_OFF + c * 272 + d8 * 2) = pk[i]; *(LAS u32x4*)(lds + QC_OFF + c * 272 + d8 * 2) = pq[i];
#pragma unroll
            for (int j = 0; j < 8; ++j) { const unsigned kw = pk[i][j >> 1], vw = pv[i][j >> 1];
                *(LAS bf16_t*)(lds + KT_OFF + (d8 + j) * 144 + c * 2) = (bf16_t)((j & 1) ? (kw >> 16) : (kw & 0xffffu));
                *(LAS bf16_t*)(lds + VT_OFF + (d8 + j) * 144 + c * 2) = (bf16_t)((j & 1) ? (vw >> 16) : (vw & 0xffffu)); } }
        if (w == 0) {
#ifdef DN_SLOWGATES
            const float x = pa + dtb; const float sp = x > 20.f ? x : log1pf(expf(x));
#else
            const float x = pa + dtb; const float ex = __expf(x); const float sp = x > 15.f ? x : (ex < 1e-4f ? ex * (1.f - 0.5f * ex) : __logf(1.f + ex));
#endif
            float g = -Aexp * sp;
#pragma unroll
            for (int o = 1; o < 64; o <<= 1) { const float y = __shfl_up(g, o); if (lane >= o) g += y; }
            const float glast = __shfl(g, 63);
#ifdef DN_SLOWGATES
            gc[lane] = g; beta[lane] = 1.f / (1.f + expf(-pb)); eg[lane] = expf(g); ekl[lane] = expf(glast - g);
            if (lane == 0) scal[0] = expf(glast);
#else
            gc[lane] = g; beta[lane] = __builtin_amdgcn_rcpf(1.f + __expf(-pb)); eg[lane] = __expf(g); ekl[lane] = __expf(glast - g);
            if (lane == 0) scal[0] = __expf(glast);
#endif
        }
        __syncthreads();
#ifdef DN_DUP_SOLVE
        for (int rep2 = 0; rep2 < 2; ++rep2) {
#endif
        {
            const int q4 = w & 3, mi = q4 >> 1, nj = q4 & 1;
            f32x16 acc;
#pragma unroll
            for (int r = 0; r < 16; ++r) acc[r] = 0.f;
            const LAS unsigned char* Ab = lds + (w < 4 ? KC_OFF : QC_OFF);
#pragma unroll
            for (int ks = 0; ks < 8; ++ks) { const int kb = (ks * 16 + hi * 8) * 2;
                acc = DN_MFMA(ldf(Ab, 32 * mi + r32, 272, kb), ldf(lds + KC_OFF, 32 * nj + r32, 272, kb), acc); }
            const int j = 32 * nj + r32; const float gcj = gc[j];
            if (w < 4) {
#pragma unroll
                for (int r = 0; r < 16; ++r) { const int i = 32 * mi + crow(r, hi); const float dec = __expf(gc[i] - gcj);
                    MT[i * 65 + j] = (i > j) ? beta[i] * acc[r] * dec : 0.f; }
            } else {
#pragma unroll
                for (int r = 0; r < 16; ++r) { const int i = 32 * mi + crow(r, hi); const float dec = __expf(gc[i] - gcj);
                    *(LAS bf16_t*)(lds + AT_OFF + i * 144 + j * 2) = f2bf((i >= j) ? acc[r] * SCALE * dec : 0.f); }
            }
        }
        __syncthreads();
#ifdef DN_L0X3
        for (int rep3 = 0; rep3 < 3; ++rep3)
#endif
        if (w == 0) {
            const int base = (lane >> 4) * 16, c = lane & 15; float x[16];
#pragma unroll
            for (int i = 0; i < 16; ++i) { float acc = (i == c) ? 1.f : 0.f;
#pragma unroll
                for (int j = 0; j < i; ++j) acc = fmaf(-MT[(base + i) * 65 + base + j], x[j], acc);
                x[i] = acc;
#ifndef DN_E1
                asm volatile("" ::: "memory");
#endif
            }
            LDS_WAIT(); asm volatile("" ::: "memory");
#pragma unroll
            for (int i = 0; i < 16; ++i) MT[(base + i) * 65 + base + c] = x[i];
        }
        __syncthreads();
        {
            const int p = tid >> 8, i = (tid >> 4) & 15, j = tid & 15, R0 = 32 * p + 16, C0 = 32 * p; float y = 0.f;
#pragma unroll
            for (int k = 0; k < 16; ++k) y = fmaf(MT[(R0 + i) * 65 + C0 + k], MT[(C0 + k) * 65 + C0 + j], y);
            YF[(p * 16 + i) * 17 + j] = y;
            __syncthreads();
            float t = 0.f;
#pragma unroll
            for (int k = 0; k < 16; ++k) t = fmaf(MT[(R0 + i) * 65 + R0 + k], YF[(p * 16 + k) * 17 + j], t);
            MT[(R0 + i) * 65 + C0 + j] = -t;
        }
        __syncthreads();
        {
            const int j = tid & 31, i0 = tid >> 5; float y0 = 0.f, y1 = 0.f;
#ifdef DN_E2
#pragma unroll
#else
#pragma unroll 8
#endif
            for (int k = 0; k < 32; ++k) { const float tk = MT[k * 65 + j]; y0 = fmaf(MT[(32 + i0) * 65 + k], tk, y0); y1 = fmaf(MT[(48 + i0) * 65 + k], tk, y1); }
            YF[i0 * 33 + j] = y0; YF[(16 + i0) * 33 + j] = y1;
            __syncthreads();
            float t0 = 0.f, t1 = 0.f;
#ifdef DN_E2
#pragma unroll
#else
#pragma unroll 8
#endif
            for (int k = 0; k < 32; ++k) { const float yk = YF[k * 33 + j]; t0 = fmaf(MT[(32 + i0) * 65 + 32 + k], yk, t0); t1 = fmaf(MT[(48 + i0) * 65 + 32 + k], yk, t1); }
            MT[(32 + i0) * 65 + j] = -t0; MT[(48 + i0) * 65 + j] = -t1;
            { const float bj = beta[j], ej = eg[j];
              *(LAS bf16_t*)(lds + T1_OFF + (32 + i0) * 144 + j * 2) = f2bf(-t0 * bj); *(LAS bf16_t*)(lds + T2_OFF + (32 + i0) * 144 + j * 2) = f2bf(t0 * bj * ej);
              *(LAS bf16_t*)(lds + T1_OFF + (48 + i0) * 144 + j * 2) = f2bf(-t1 * bj); *(LAS bf16_t*)(lds + T2_OFF + (48 + i0) * 144 + j * 2) = f2bf(t1 * bj * ej); }
#pragma unroll 1
            for (int q = 0; q < 6; ++q) { const int idx = tid + NTHR * q; int i, jj;
                if (idx < 2048) { i = idx >> 6; jj = idx & 63; } else { const int r2 = idx - 2048; i = 32 + (r2 >> 5); jj = 32 + (r2 & 31); }
                const float tv = MT[i * 65 + jj] * beta[jj];
                *(LAS bf16_t*)(lds + T1_OFF + i * 144 + jj * 2) = f2bf(tv); *(LAS bf16_t*)(lds + T2_OFF + i * 144 + jj * 2) = f2bf(-tv * eg[jj]); }
        }
        __syncthreads();
#ifdef DN_DUP_SOLVE
        }
#endif
        f32x16 accU, accW;
#pragma unroll
        for (int r = 0; r < 16; ++r) { accU[r] = 0.f; accW[r] = 0.f; }
#pragma unroll
        for (int ks = 0; ks < 4; ++ks) { const int kb = (ks * 16 + hi * 8) * 2;
            accU = DN_MFMA(ldf(lds + T1_OFF, 32 * wr + r32, 144, kb), ldf(lds + VT_OFF, 32 * wc + r32, 144, kb), accU);
            accW = DN_MFMA(ldf(lds + T2_OFF, 32 * wr + r32, 144, kb), ldf(lds + KT_OFF, 32 * wc + r32, 144, kb), accW); }
#pragma unroll
        for (int r = 0; r < 16; ++r) *(LAS bf16_t*)(lds + KC_OFF + (32 * wr + crow(r, hi)) * 272 + (32 * wc + r32) * 2) = f2bf(accW[r]);
        __syncthreads();
#ifdef DN_PF_EARLY
        if (n + 1 < 64) DN_LOADC(n + 1);
#endif
        f32x16 accQ;
#pragma unroll
        for (int r = 0; r < 16; ++r) accQ[r] = 0.f;
#if DN_STAGE >= 5
#pragma unroll 2
        for (int ks = 0; ks < 8; ++ks) { const int kb = (ks * 16 + hi * 8) * 2;
            const bf16x8 bs = ldf(lds + ST_OFF, 32 * wc + r32, 272, kb);
            accU = DN_MFMA(ldf(lds + KC_OFF, 32 * wr + r32, 272, kb), bs, accU);
            accQ = DN_MFMA(ldf(lds + QC_OFF, 32 * wr + r32, 272, kb), bs, accQ); }
#pragma unroll
        for (int rg = 0; rg < 4; ++rg) { const int c0 = 32 * wr + 8 * rg + 4 * hi, e = 32 * wc + r32;
            const f32x4 sc = *(const LAS f32x4*)(ekl + c0);
            u32x2 w1, w2; w1.x = cvt_pk_bf16(accU[4 * rg], accU[4 * rg + 1]); w1.y = cvt_pk_bf16(accU[4 * rg + 2], accU[4 * rg + 3]);
            w2.x = cvt_pk_bf16(accU[4 * rg] * sc.x, accU[4 * rg + 1] * sc.y); w2.y = cvt_pk_bf16(accU[4 * rg + 2] * sc.z, accU[4 * rg + 3] * sc.w);
            *(LAS u32x2*)(lds + VN_OFF + e * 144 + c0 * 2) = w1; *(LAS u32x2*)(lds + VNS_OFF + e * 144 + c0 * 2) = w2; }
#else
        accQ = accU;
#endif
        __syncthreads();
#ifndef DN_PF_EARLY
        if (n + 1 < 64) DN_LOADC(n + 1);
#endif
#if DN_STAGE >= 6
#pragma unroll
        for (int r = 0; r < 16; ++r) accQ[r] *= SCALE * eg[32 * wr + crow(r, hi)];
#pragma unroll
        for (int ks = 0; ks < 4; ++ks) { const int kb = (ks * 16 + hi * 8) * 2;
            accQ = DN_MFMA(ldf(lds + AT_OFF, 32 * wr + r32, 144, kb), ldf(lds + VN_OFF, 32 * wc + r32, 144, kb), accQ); }
#endif
#pragma unroll
        for (int r = 0; r < 16; ++r) { const int c = 32 * wr + crow(r, hi);
            *(LAS bf16_t*)(lds + MT_OFF + c * 256 + (32 * wc + r32) * 2) = f2bf(accQ[r]); }
#if DN_STAGE >= 7
        {
            const float egl = scal[0];
#pragma unroll
            for (int r = 0; r < 16; ++r) { accS[0][r] *= egl; accS[1][r] *= egl; }
#pragma unroll
            for (int ks = 0; ks < 4; ++ks) { const int kb = (ks * 16 + hi * 8) * 2;
                const bf16x8 bsn = ldf(lds + VNS_OFF, 32 * wc + r32, 144, kb);
                accS[0] = DN_MFMA(ldf(lds + KT_OFF, 64 * wr + r32, 144, kb), bsn, accS[0]);
                accS[1] = DN_MFMA(ldf(lds + KT_OFF, 64 * wr + 32 + r32, 144, kb), bsn, accS[1]); }
#pragma unroll
            for (int mb = 0; mb < 2; ++mb)
#pragma unroll
                for (int rg = 0; rg < 4; ++rg) { const int d0 = 64 * wr + 32 * mb + 8 * rg + 4 * hi, e = 32 * wc + r32;
                    u32x2 w1; w1.x = cvt_pk_bf16(accS[mb][4 * rg], accS[mb][4 * rg + 1]); w1.y = cvt_pk_bf16(accS[mb][4 * rg + 2], accS[mb][4 * rg + 3]);
                    *(LAS u32x2*)(lds + ST_OFF + e * 272 + d0 * 2) = w1; }
        }
#endif
        __syncthreads();
#pragma unroll
        for (int i = 0; i < 2; ++i) { const int idx = tid + NTHR * i, c = idx >> 4, e8 = (idx & 15) * 8, p = 64 * n + c, l = dir ? SEQ - 1 - p : p;
            const unsigned oo = ((unsigned)(b * SEQ + l) * 1024u + (unsigned)(h * 128 + e8)) * 2u;
            *(u32x4*)((char*)O + oo) = *(const LAS u32x4*)(lds + MT_OFF + c * 256 + e8 * 2); }
    }
#undef DN_LOADC
}
}
namespace gm {
constexpr int WS_OFF = 0, VT_OFF = 34816, ST_OFF = 69632, SL_OFF = 70656, LN_OFF = 138240;
static_assert(LN_OFF + 16384 <= LDS_BYTES - 64, "gmlp LDS map");
struct Args { const bf16_t* P1; const float* ln_g; const float* ln_b; const float* ws; const float* bs; bf16_t* Z; const float* VST; };
__device__ __forceinline__ void unit(const Args& a, int cu, LAS unsigned char* lds) {
    int tid = threadIdx.x; asm volatile("" : "+v"(tid));
    const int w = __builtin_amdgcn_readfirstlane(tid >> 6), lane = tid & 63, r32 = lane & 31, hi = lane >> 5, wr = w >> 2, wc = w & 3;
    const int t0 = cu * 128;
    LAS float* mean = (LAS float*)(lds + ST_OFF); LAS float* rstd = mean + 128; LAS float* SL = (LAS float*)(lds + SL_OFF);
    LAS float* LG = (LAS float*)(lds + LN_OFF); LAS float* LB = LG + 2048;
    f32x4 pw[8]; u32x4 pvv[4], pu[4], pg[4];
#define GM_LOAD_WV(g_) do { _Pragma("unroll") for (int i_ = 0; i_ < 8; ++i_) { const int idx_ = tid + NTHR * i_; pw[i_] = *(const f32x4*)(a.ws + (size_t)(g_) * 16384 + idx_ * 4); } \
        _Pragma("unroll") for (int i_ = 0; i_ < 4; ++i_) { const int idx_ = tid + NTHR * i_, s_ = idx_ & 127, c8_ = (idx_ >> 7) * 8; \
            pvv[i_] = *(const u32x4*)((const char*)a.P1 + (unsigned)(((t0 + s_) * N1 + 2048 + (g_) * 128 + c8_) * 2)); } } while (0)
#define GM_LOAD_UG(g_) do { _Pragma("unroll") for (int i_ = 0; i_ < 4; ++i_) { const int idx_ = tid + NTHR * i_, t_ = idx_ >> 4, c8_ = (idx_ & 15) * 8; \
            const char* pr_ = (const char*)a.P1 + (unsigned)(((t0 + t_) * N1 + (g_) * 128 + c8_) * 2); pu[i_] = *(const u32x4*)pr_; pg[i_] = *(const u32x4*)(pr_ + 8192); } } while (0)
    __syncthreads();
    GM_LOAD_WV(0);
    for (int i = tid; i < 512; i += NTHR) { *(LAS f32x4*)(LG + i * 4) = *(const f32x4*)(a.ln_g + i * 4); *(LAS f32x4*)(LB + i * 4) = *(const f32x4*)(a.ln_b + i * 4); }
    { typedef float f32x2v __attribute__((ext_vector_type(2))); f32x2v pr[16];
#pragma unroll
      for (int q = 0; q < 16; ++q) pr[q] = (lane < 32) ? *(const f32x2v*)(a.VST + ((size_t)(t0 + w * 16 + q) * 32 + lane) * 2) : (f32x2v){0.f, 0.f};
#pragma unroll
      for (int q = 0; q < 16; ++q) { const float S1 = wave_sum(pr[q].x), S2 = wave_sum(pr[q].y); const float mu = S1 * (1.f / 2048.f);
          const float var = fmaxf(S2 * (1.f / 2048.f) - mu * mu, 0.f); if (lane == 0) { mean[w * 16 + q] = mu; rstd[w * 16 + q] = 1.0f / sqrtf(var + EPS); } } }
    __syncthreads();
    for (int g = 0; g < 16; ++g) {
#ifndef GM_UG_LATE
        GM_LOAD_UG(g);
#endif
#pragma unroll
        for (int i = 0; i < 8; ++i) { const int idx = tid + NTHR * i, t = idx >> 5, s4 = (idx & 31) * 4;
            u32x2 o; o.x = cvt_pk_bf16(pw[i].x, pw[i].y); o.y = cvt_pk_bf16(pw[i].z, pw[i].w); *(LAS u32x2*)(lds + WS_OFF + t * 272 + s4 * 2) = o; }
#pragma unroll
        for (int i = 0; i < 4; ++i) { const int idx = tid + NTHR * i, s = idx & 127, c8 = (idx >> 7) * 8; float x[8];
            unpack8(pvv[i], x);
            const float mu = mean[s], rs = rstd[s];
            const f32x4 g0 = *(const LAS f32x4*)(LG + g * 128 + c8), g1 = *(const LAS f32x4*)(LG + g * 128 + c8 + 4), b0 = *(const LAS f32x4*)(LB + g * 128 + c8), b1 = *(const LAS f32x4*)(LB + g * 128 + c8 + 4);
            const float gg[8] = {g0.x, g0.y, g0.z, g0.w, g1.x, g1.y, g1.z, g1.w}, bb[8] = {b0.x, b0.y, b0.z, b0.w, b1.x, b1.y, b1.z, b1.w};
#pragma unroll
            for (int j = 0; j < 8; ++j) *(LAS bf16_t*)(lds + VT_OFF + (c8 + j) * 272 + s * 2) = f2bf((x[j] - mu) * rs * gg[j] + bb[j]); }
        __syncthreads();
        if (g + 1 < 16) GM_LOAD_WV(g + 1);
#ifdef GM_UG_LATE
        GM_LOAD_UG(g);
#endif
        f32x16 acc[2];
#pragma unroll
        for (int r = 0; r < 16; ++r) { acc[0][r] = 0.f; acc[1][r] = 0.f; }
#pragma unroll
        for (int ks = 0; ks < 8; ++ks) { const int kb = (ks * 16 + hi * 8) * 2;
            const bf16x8 bv = *(const LAS bf16x8*)(lds + VT_OFF + (32 * wc + r32) * 272 + kb);
            acc[0] = __builtin_amdgcn_mfma_f32_32x32x16_bf16(*(const LAS bf16x8*)(lds + WS_OFF + (64 * wr + r32) * 272 + kb), bv, acc[0], 0, 0, 0);
            acc[1] = __builtin_amdgcn_mfma_f32_32x32x16_bf16(*(const LAS bf16x8*)(lds + WS_OFF + (64 * wr + 32 + r32) * 272 + kb), bv, acc[1], 0, 0, 0); }
#pragma unroll
        for (int mb = 0; mb < 2; ++mb) { const float* bsp = a.bs + g * 128 + 64 * wr + 32 * mb + 4 * hi;
#pragma unroll
            for (int r = 0; r < 16; ++r) { const int t = 64 * wr + 32 * mb + crow(r, hi);
                SL[t * 132 + 32 * wc + r32] = acc[mb][r] + bsp[(r & 3) + 8 * (r >> 2)]; } }
        __syncthreads();
#pragma unroll
        for (int i = 0; i < 4; ++i) { const int idx = tid + NTHR * i, t = idx >> 4, c8 = (idx & 15) * 8, col = g * 128 + c8; float uu[8], gt[8];
            unpack8(pu[i], uu); unpack8(pg[i], gt);
            const f32x4 s0 = *(const LAS f32x4*)(SL + t * 132 + c8), s1 = *(const LAS f32x4*)(SL + t * 132 + c8 + 4);
            const float sv[8] = {s0.x, s0.y, s0.z, s0.w, s1.x, s1.y, s1.z, s1.w};
#pragma unroll
            for (int e = 0; e < 8; ++e) uu[e] = uu[e] * sv[e] * silu_f(gt[e]);
            *(u32x4*)((char*)a.Z + (unsigned)(((t0 + t) * DM + col) * 2)) = pack8(uu); }
    }
#undef GM_LOAD_WV
#undef GM_LOAD_UG
}
}

struct KArgs { const float* in[17]; float* out; unsigned char* ws; int ph_lo, ph_hi; };
#ifndef PROBE_END
#define PROBE_END 10
#endif
#ifndef DUMP_OFF
#define DUMP_OFF 0
#define DUMP_N 0
#endif
#ifndef DUP_PHASE
#define DUP_PHASE -1
#endif
#ifndef DUP_N
#define DUP_N 2
#endif
#define REPS(k) for (int rep_ = 0; rep_ < ((DUP_PHASE == (k)) ? DUP_N : 1); ++rep_)
#define REPSYNC(k) do { if (DUP_PHASE == (k) && rep_ + 1 < DUP_N) cg::this_grid().sync(); } while (0)
#ifndef PG_ALIGN59
#define PG_ALIGN59 true
#endif
#ifndef PG_ALIGN17
#define PG_ALIGN17 true
#endif
constexpr int NPHASES = 10;
__global__ void __launch_bounds__(NTHR, 2) fwd_megakernel(KArgs A) {
    __builtin_assume(__builtin_amdgcn_workitem_id_y() == 0); __builtin_assume(__builtin_amdgcn_workitem_id_z() == 0);
    extern __shared__ __attribute__((aligned(16))) unsigned char lds_raw[];
    LAS unsigned char* lds = (LAS unsigned char*)lds_raw;
    const int tid = threadIdx.x, lane = tid & 63, wave = __builtin_amdgcn_readfirstlane(tid >> 6);
    const int G = gridDim.x, bx = blockIdx.x, gw = bx * NWAVES + wave, NGW = G * NWAVES;
    unsigned char* ws = A.ws;
    const float* x = A.in[0];
    bf16_t* W0T = (bf16_t*)(ws + WS_W0T); bf16_t* WO0T = (bf16_t*)(ws + WS_WO0T); bf16_t* W1T = (bf16_t*)(ws + WS_W1T); bf16_t* WO1T = (bf16_t*)(ws + WS_WO1T);
    bf16_t* H = (bf16_t*)(ws + WS_H); bf16_t* PROJ = (bf16_t*)(ws + WS_PROJ); float* LOG = (float*)(ws + WS_LOG); bf16_t* QKV = (bf16_t*)(ws + WS_QKV); bf16_t* YCAT = (bf16_t*)(ws + WS_YCAT);
    bf16_t* OF = H; bf16_t* OB = H + (size_t)TOK * 1024; float* PART = (float*)(ws + WS_PART); float* RSTD = (float*)(ws + WS_RSTD);
    const int lo = A.ph_lo, hi = A.ph_hi;
#ifndef PHMASK
#define PHMASK 0x3ff
#endif
#define IN(k) (((PHMASK >> (k)) & 1) && lo <= (k) && (k) < hi)
#define SEAM(k) do { if (IN(k) && IN((k) + 1)) { cg::this_grid().sync(); } } while (0)
    if (IN(0)) REPS(0) { P0Args p{x, A.in[1], A.in[10], A.in[2], A.in[9], A.in[11], A.in[16], W0T, WO0T, W1T, WO1T, H}; p0_prologue(p, lds, gw, NGW, wave, lane); __syncthreads(); REPSYNC(0); }
    SEAM(0);
    if (IN(1)) REPS(1) { { pg8::Gemm g{H, W0T, TOK, P0LD, DM, DM}; pg8::StaticOrder S; S.init(TOK, P0LD, G, bx); pg8::Epi0 E{PROJ, LOG};
            pg8::gemm_phase<pg8::Epi0, pg8::StaticOrder, PG_ALIGN17, true>(lds, g, S, E); }
        for (int hu = bx; hu < 2 * (TOK / 256); hu += G) { const int kh = hu & 1;
            pg8::Gemm g{H + kh * (DM / 2), W0T + (size_t)P0LD * DM + kh * (DM / 2), TOK, 256, DM / 2, DM}; pg8::OneUnit S{hu >> 1}; pg8::EpiLog E{LOG + (size_t)kh * TOK * 32};
            pg8::gemm_phase<pg8::EpiLog, pg8::OneUnit, true, true>(lds, g, S, E); }
        REPSYNC(1); }
    SEAM(1);
    if (IN(2)) {
        REPS(2) { for (int it = gw; it < (TOK / 16) * 6; it += NGW) p2_conv_item(PROJ, A.in[3], QKV, it, lane); REPSYNC(2); }
        for (int t = gw; t < TOK; t += 2 * NGW) p2_rope_tokens<2>(PROJ, A.in[7], A.in[8], t, NGW, lane);
    }
    SEAM(2);
    if (IN(3)) REPS(3) {
        int* ctr = (int*)(ws + WS_CTL) + 64 * rep_; LAS int* slot = (LAS int*)(lds + LDS_BYTES - 16);
        int* dn_done = (int*)(ws + WS_CTL) + 512 + 64 * rep_; int* p4ctr = (int*)(ws + WS_CTL) + 768 + 64 * rep_;
#define FETCH4(item) do { __syncthreads(); if (tid == 0) *slot = atomicAdd(p4ctr, 1); __syncthreads(); item = __builtin_amdgcn_readfirstlane(*slot); } while (0)
        dn::Args da{QKV, LOG, A.in[4], A.in[5], OF, OB};
#define FETCH(item) do { __syncthreads(); if (tid == 0) *slot = atomicAdd(ctr, 1); __syncthreads(); item = __builtin_amdgcn_readfirstlane(*slot); } while (0)
        int item;
#if DUP_PHASE == 31
        for (int r31 = 0; r31 < DUP_N - 1; ++r31) { int* ctr0 = ctr; ctr = (int*)(ws + WS_CTL) + 128 + 64 * r31; FETCH(item); while (item < 128) { dn::unit(da, item, lds); FETCH(item); } ctr = ctr0; cg::this_grid().sync(); }
#endif
#if DUP_PHASE == 32
        { int* ctr0 = ctr; ctr = (int*)(ws + WS_CTL) + 128; FETCH(item); item += 128;
          while (item < 128 + 1024) { const int ai = item - 128, qb = ai & 15, gq = (ai >> 4) & 3, kvh = (ai >> 6) & 1, b = ai >> 7, h = kvh * 4 + gq;
            const size_t r0 = (size_t)(b * SEQ + qb * 256);
            att::attn_dense_body(PROJ + r0 * P0LD + C_BQ + h * 128, PROJ + (size_t)(b * SEQ) * P0LD + C_BK + kvh * 128, PROJ + (size_t)(b * SEQ) * P0LD + C_BV + kvh * 128,
                                 PROJ + r0 * P0LD + C_BG + h * 128, YCAT + r0 * DM + 1024 + h * 128, SEQ, (char*)lds_raw);
            FETCH(item); item += 128; }
          ctr = ctr0; cg::this_grid().sync(); }
#endif
        FETCH(item);
#ifndef SKIP_DN
        while (item < 128) { dn::unit(da, item, lds);
            asm volatile("s_waitcnt vmcnt(0)" ::: "memory");
            __syncthreads(); if (tid == 0) { __threadfence(); atomicAdd(dn_done, 1); }
            FETCH(item); }
#endif
#ifndef SKIP_ATT
        while (item < 128 + 1024) { const int ai = item - 128, qb = ai & 15, gq = (ai >> 4) & 3, kvh = (ai >> 6) & 1, b = ai >> 7, h = kvh * 4 + gq;
            const size_t r0 = (size_t)(b * SEQ + qb * 256);
            att::attn_dense_body(PROJ + r0 * P0LD + C_BQ + h * 128, PROJ + (size_t)(b * SEQ) * P0LD + C_BK + kvh * 128, PROJ + (size_t)(b * SEQ) * P0LD + C_BV + kvh * 128,
                                 PROJ + r0 * P0LD + C_BG + h * 128, YCAT + r0 * DM + 1024 + h * 128, SEQ, (char*)lds_raw);
            FETCH(item); }
#endif
        if (tid == 0) { while (__hip_atomic_load(dn_done, __ATOMIC_RELAXED, __HIP_MEMORY_SCOPE_AGENT) < 128) __builtin_amdgcn_s_sleep(16);
            __threadfence(); }
        __syncthreads();
        for (;;) { int c4; FETCH4(c4); if (c4 >= TOK / 128) break;
            for (int q = 0; q < 16; q += 4) p4_tokens<4>(OF, OB, PROJ, A.in[6], YCAT, c4 * 128 + wave * 16 + q, lane); }
        REPSYNC(3);
    }
    SEAM(3);
    if (IN(5)) REPS(5) { pg8::Gemm g{YCAT, WO0T, TOK, DM, DM, DM}; pg8::StaticOrder S; S.init(TOK, DM, G, bx); pg8::EpiRes0 E{x, H, PART};
        pg8::gemm_phase<pg8::EpiRes0, pg8::StaticOrder, PG_ALIGN59, true>(lds, g, S, E); REPSYNC(5); }
    SEAM(5);
    if (IN(6)) REPS(6) { for (int r = bx * NTHR + tid; r < TOK; r += G * NTHR) { const f32x4* pp = (const f32x4*)(PART + (size_t)r * 32); float ss = 0.f;
#pragma unroll
            for (int j = 0; j < 8; ++j) { const f32x4 v = pp[j]; ss += (v.x + v.y) + (v.z + v.w); }
            RSTD[r] = 1.0f / sqrtf(ss * (1.f / DM) + EPS); } REPSYNC(6); }
    SEAM(6);
    if (IN(7)) REPS(7) { pg8::Gemm g{H, W1T, TOK, N1, DM, DM}; pg8::StaticOrder S; S.init(TOK, N1, G, bx); pg8::Epi1 E{PROJ, RSTD, (float*)(ws + WS_VST)};
        pg8::gemm_phase<pg8::Epi1, pg8::StaticOrder, PG_ALIGN17, true>(lds, g, S, E); REPSYNC(7); }
    SEAM(7);
    if (IN(8)) REPS(8) { gm::Args ga{PROJ, A.in[12], A.in[13], A.in[14], A.in[15], YCAT, (const float*)(ws + WS_VST)};
        for (int cu = bx; cu < TOK / 128; cu += G) gm::unit(ga, cu, lds); REPSYNC(8); }
    SEAM(8);
    if (IN(9)) { pg8::Gemm g{YCAT, WO1T, TOK, DM, DM, DM}; pg8::StaticOrder S; S.init(TOK, DM, G, bx); pg8::EpiRes1 E{H, A.out};
        pg8::gemm_phase<pg8::EpiRes1, pg8::StaticOrder, PG_ALIGN59, true>(lds, g, S, E); }
#if PROBE_END < 10
    if (lo <= 10 && 10 < hi) { const bf16_t* src = (const bf16_t*)(ws + (size_t)DUMP_OFF); const size_t n = (size_t)DUMP_N, NO = (size_t)TOK * DM;
        for (size_t i = (size_t)bx * NTHR + tid; i < NO; i += (size_t)G * NTHR) { float acc = 0.f; for (size_t k = i; k < n; k += NO) { float v = bf2f(src[k]); if (!(fabsf(v) < 1e30f)) v = 7777.f; acc += v; } A.out[i] = acc; } }
#endif
}

extern "C" void kernel_launch(void* const* d_in, const int* in_sizes, int n_in, void* d_out, int out_size, void* d_ws, size_t ws_size, hipStream_t stream) {
    static int grid = 0;
    if (grid == 0) {
        if (n_in != 17 || in_sizes[0] != TOK * DM || out_size != TOK * DM || ws_size < WS_END) { fprintf(stderr, "kernel_launch: shape/workspace mismatch (n_in %d, ws %zu < %zu)\n", n_in, ws_size, (size_t)WS_END); grid = -1; return; }
        int dev = 0, cus = 0, per_cu = 0;
        (void)hipGetDevice(&dev); (void)hipDeviceGetAttribute(&cus, hipDeviceAttributeMultiprocessorCount, dev);
        if (hipFuncSetAttribute((const void*)fwd_megakernel, hipFuncAttributeMaxDynamicSharedMemorySize, LDS_BYTES) != hipSuccess) { fprintf(stderr, "hipFuncSetAttribute failed\n"); grid = -1; return; }
        if (hipOccupancyMaxActiveBlocksPerMultiprocessor(&per_cu, (const void*)fwd_megakernel, NTHR, LDS_BYTES) != hipSuccess || per_cu < 1) per_cu = 1;
        grid = cus * per_cu;
        fprintf(stderr, "kernel_launch: grid %d (%d CUs x %d)\n", grid, cus, per_cu);
    }
    if (grid < 0) return;
    (void)hipMemsetAsync((char*)d_ws + WS_CTL, 0, 4096, stream);
    KArgs a{};
    for (int i = 0; i < 17; ++i) a.in[i] = (const float*)d_in[i];
    a.out = (float*)d_out; a.ws = (unsigned char*)d_ws;
#if MK_LAUNCHES == 1
    a.ph_lo = 0; a.ph_hi = NPHASES;
    void* args[] = {&a};
    hipError_t e = hipLaunchCooperativeKernel((void*)fwd_megakernel, dim3(grid), dim3(NTHR), args, LDS_BYTES, stream);
    if (e != hipSuccess) fprintf(stderr, "cooperative launch failed: %s (grid %d)\n", hipGetErrorString(e), grid);
#else
    for (int p = 0; p < PROBE_END; ++p) { a.ph_lo = p; a.ph_hi = p + 1; hipLaunchKernelGGL(fwd_megakernel, dim3(grid), dim3(NTHR), LDS_BYTES, stream, a); }
#if PROBE_END < 10
    a.ph_lo = 10; a.ph_hi = 11; hipLaunchKernelGGL(fwd_megakernel, dim3(grid), dim3(NTHR), LDS_BYTES, stream, a);
#endif
#endif
}
```

```cpp
#include <hip/hip_runtime.h>
#include <hip/hip_cooperative_groups.h>
#include <cstdio>
#include <cstdint>
namespace cg = cooperative_groups;
#ifndef MK_LAUNCHES
#define MK_LAUNCHES 1
#define DUP_PHASE -1

#endif
namespace pg8 {
#define PG8_LAS __attribute__((address_space(3)))
typedef unsigned short bf16_t;
typedef short bf16x8 __attribute__((ext_vector_type(8)));
typedef float f32x4 __attribute__((ext_vector_type(4)));
typedef unsigned u32x4 __attribute__((ext_vector_type(4)));
constexpr int BM = 256, BK = 64, HALF = 128, HTB = HALF * BK * 2  , STAGE_BYTES = 8 * HTB, NXCD = 8, WGM = 4;

__host__ __device__ __forceinline__ int lds_byte(int r, int c) { const int st = (r >> 4) * 2 + (c >> 5), rr = r & 15, cc = c & 31, ob = rr * 64 + cc * 2; return st * 1024 + (ob ^ (((ob >> 9) & 1) << 5)); }
__host__ __device__ __forceinline__ void stage_rc(int b, int& R, int& C) { const int st = b / 1024, sb = b % 1024, swz = sb ^ (((sb >> 9) & 1) << 5); R = (st >> 1) * 16 + swz / 64; C = (st & 1) * 32 + (swz % 64) / 2; }
__host__ __device__ __forceinline__ int perm32(int rho) { const int n = rho >> 4, i = rho & 15; return 8 * (i >> 2) + 4 * n + (i & 3); }

struct Unit { int pm, pn; };
struct Gemm { const bf16_t* A; const bf16_t* Bt; int M, N, K, ld; };

struct StaticOrder {
    int nM, nN, nwg, G, c;
    __host__ __device__ void init(int M, int N, int G_, int c_) { nM = M / BM; nN = N / BM; nwg = nM * nN; G = G_; c = c_; }
    __host__ __device__ bool next(int i, Unit& u) const {
        const long L = (long)i * G + c; if (L >= nwg) return false;
        int wgid = (int)L; { const int q = nwg / NXCD, r = nwg % NXCD, xcd = wgid % NXCD, off = wgid / NXCD; wgid = (xcd < r ? xcd * (q + 1) : r * (q + 1) + (xcd - r) * q) + off; }
        const int nig = WGM * nN, gid = wgid / nig, fm = gid * WGM, gsz = (nM - fm) < WGM ? (nM - fm) : WGM;
        u.pm = fm + ((wgid % nig) % gsz); u.pn = (wgid % nig) / gsz; return true;
    }
    __device__ __forceinline__ void a_ready(const Unit&) const {}
    __device__ __forceinline__ void done(const Unit&) const {}
};

typedef float f32x2c_t __attribute__((ext_vector_type(2))); typedef __bf16 bf16x2c_t __attribute__((ext_vector_type(2)));
__device__ __forceinline__ unsigned cvt_pk_bf16(float lo, float hi) { f32x2c_t v = {lo, hi}; bf16x2c_t b = __builtin_convertvector(v, bf16x2c_t); return __builtin_bit_cast(unsigned, b); }
typedef float f32x2 __attribute__((ext_vector_type(2)));
__device__ __forceinline__ f32x2 gelu_pk(f32x2 v) {
    const f32x2 av = __builtin_elementwise_abs(v), d = av * 0.2316418882f + 1.0f;
    f32x2 t; t.x = __builtin_amdgcn_rcpf(d.x); t.y = __builtin_amdgcn_rcpf(d.y);
    f32x2 q = t * 0.5307027145f + (-0.7265760135f); q = q * t + 0.7107068705f; q = q * t + (-0.142248368f); q = q * t + 0.127414796f; q = q * t;
    const f32x2 s = (v * v) * (-0.72134752044f);
    f32x2 e; e.x = __builtin_amdgcn_exp2f(s.x); e.y = __builtin_amdgcn_exp2f(s.y);
    const f32x2 m = v * (q * e), r = v - m;
    f32x2 o; o.x = v.x < 0.f ? m.x : r.x; o.y = v.y < 0.f ? m.y : r.y; return o;
}

template <class Epi, class Sched, bool ALIGN_EPI = false, bool SP2 = false>
__device__ __forceinline__ void gemm_phase(PG8_LAS unsigned char* lds, const Gemm g, const Sched& S, const Epi& E) {
    const int tid = threadIdx.x, wid = __builtin_amdgcn_readfirstlane(tid >> 6), lane = tid & 63, wr = wid >> 2, wc = wid & 3, fr = lane & 15, fq = lane >> 4;
    const int K = g.ld, nt = g.K / BK;
    unsigned voffA[2], voffB[2];
#pragma unroll
    for (int i = 0; i < 2; ++i) { int R, C; stage_rc(tid * 16 + i * 8192, R, C); const int Rb = Epi::PERM ? ((R & ~31) + perm32(R & 31)) : R;
        voffA[i] = (unsigned)(R * K + C) * 2u; voffB[i] = (unsigned)(Rb * K + C) * 2u; }
    const size_t kstep = (size_t)(BK * 2);
    const size_t hstep = (size_t)HALF * K * 2;
    const size_t tstep = 2 * hstep;
    const unsigned ldsw = (unsigned)wid * 1024u;
    const int aoff = lds_byte(wr * 64 + fr, fq * 8), boff = lds_byte(wc * 32 + fr, fq * 8);
#define PG8_SA(b, h) (((b) * 2 + (h)) * HTB)
#define PG8_SB(b, h) ((4 + (b) * 2 + (h)) * HTB)
#define PG8_STAGE(bufoff, gbase, voff) do { _Pragma("unroll") for (int _i = 0; _i < 2; ++_i) \
        __builtin_amdgcn_global_load_lds((const unsigned*)((const char*)(gbase) + (voff)[_i]), (PG8_LAS unsigned*)(lds + (bufoff) + ldsw + _i * 8192), 16, 0, 0); } while (0)
#define PG8_LDA(dst, b, h) do { _Pragma("unroll") for (int m = 0; m < 4; ++m) _Pragma("unroll") for (int k = 0; k < 2; ++k) dst[m][k] = *(const PG8_LAS bf16x8*)(lds + PG8_SA(b, h) + aoff + m * 2048 + k * 1024); } while (0)
#define PG8_LDB(dst, b, h) do { _Pragma("unroll") for (int n = 0; n < 2; ++n) _Pragma("unroll") for (int k = 0; k < 2; ++k) dst[n][k] = *(const PG8_LAS bf16x8*)(lds + PG8_SB(b, h) + boff + n * 2048 + k * 1024); } while (0)
#define PG8_MMA(ai, bj, At, Bt) do { __builtin_amdgcn_s_setprio(1); _Pragma("unroll") for (int m = 0; m < 4; ++m) _Pragma("unroll") for (int n = 0; n < 2; ++n) _Pragma("unroll") for (int k = 0; k < 2; ++k) \
        acc[ai][bj][m][n] = __builtin_amdgcn_mfma_f32_16x16x32_bf16(Bt[n][k], At[m][k], acc[ai][bj][m][n], 0, 0, 0); __builtin_amdgcn_s_setprio(0); } while (0)
#define PG8_WAIT_V(n) asm volatile("s_waitcnt vmcnt(" #n ")" ::: "memory")
#define PG8_WAIT_L(n) asm volatile("s_waitcnt lgkmcnt(" #n ")" ::: "memory")
#define PG8_BAR __builtin_amdgcn_s_barrier()
#define PG8_SCHED __builtin_amdgcn_sched_barrier(0)
    Unit cur, nxt; int ui = 0;
    if (!S.next(0, cur)) return;
    f32x4 acc[2][2][4][2];
#pragma unroll
    for (int a = 0; a < 2; ++a)
#pragma unroll
        for (int b = 0; b < 2; ++b)
#pragma unroll
            for (int m = 0; m < 4; ++m)
#pragma unroll
                for (int n = 0; n < 2; ++n) acc[a][b][m][n] = (f32x4){0.f, 0.f, 0.f, 0.f};
    bf16x8 At[4][2], B0[2][2], B1[2][2];
    const char* cA = (const char*)g.A + (size_t)cur.pm * tstep; const char* cB = (const char*)g.Bt + (size_t)cur.pn * tstep;
    S.a_ready(cur);
    if constexpr (SP2) {
        PG8_STAGE(PG8_SB(0, 0), cB, voffB); PG8_STAGE(PG8_SB(0, 1), cB + hstep, voffB); PG8_STAGE(PG8_SA(0, 0), cA, voffA); PG8_STAGE(PG8_SA(0, 1), cA + hstep, voffA);
        if (wr == 1) PG8_BAR;
        PG8_WAIT_V(2); PG8_BAR;
        PG8_STAGE(PG8_SB(1, 0), cB + kstep, voffB); PG8_STAGE(PG8_SA(1, 0), cA + kstep, voffA); PG8_STAGE(PG8_SB(1, 1), cB + hstep + kstep, voffB);
        PG8_WAIT_V(6); PG8_BAR;
    } else {
        PG8_STAGE(PG8_SB(0, 0), cB, voffB); PG8_STAGE(PG8_SA(0, 0), cA, voffA); PG8_STAGE(PG8_SB(0, 1), cB + hstep, voffB); PG8_STAGE(PG8_SA(0, 1), cA + hstep, voffA);
        if (wr == 1) PG8_BAR;
        PG8_WAIT_V(4); PG8_BAR;
        PG8_STAGE(PG8_SB(1, 0), cB + kstep, voffB); PG8_STAGE(PG8_SA(1, 0), cA + kstep, voffA); PG8_STAGE(PG8_SB(1, 1), cB + hstep + kstep, voffB);
        PG8_WAIT_V(6); PG8_BAR;
    }
    for (;;) {
        const bool has_next = S.next(ui + 1, nxt);
        const char* nA = has_next ? (const char*)g.A + (size_t)nxt.pm * tstep : cA; const char* nB = has_next ? (const char*)g.Bt + (size_t)nxt.pn * tstep : cB;
        for (int t = 0; t < nt; t += 2) {
            const bool last = (t == nt - 2);
            const char* a1 = cA + (size_t)(t + 1) * kstep;
            const char* a2 = last ? nA : cA + (size_t)(t + 2) * kstep; const char* b2 = last ? nB : cB + (size_t)(t + 2) * kstep;
            const char* a3 = a2 + kstep; const char* b3 = b2 + kstep;
            if (last && has_next) S.a_ready(nxt);
            if constexpr (SP2) {
            PG8_LDB(B0, 0, 0); PG8_LDB(B1, 0, 1); PG8_SCHED; PG8_LDA(At, 0, 0); PG8_STAGE(PG8_SA(1, 1), a1 + hstep, voffA);
            PG8_WAIT_V(8); PG8_WAIT_L(0); PG8_BAR; PG8_MMA(0, 0, At, B0); PG8_MMA(0, 1, At, B1); PG8_BAR; PG8_SCHED;
            PG8_LDA(At, 0, 1); PG8_STAGE(PG8_SB(0, 0), b2, voffB); PG8_STAGE(PG8_SB(0, 1), b2 + hstep, voffB); PG8_STAGE(PG8_SA(0, 0), a2, voffA);
            PG8_WAIT_V(8); PG8_WAIT_L(0); PG8_BAR; PG8_MMA(1, 0, At, B0); PG8_MMA(1, 1, At, B1); PG8_BAR; PG8_SCHED;
            PG8_LDB(B0, 1, 0); PG8_LDB(B1, 1, 1); PG8_SCHED; PG8_LDA(At, 1, 0); PG8_STAGE(PG8_SA(0, 1), a2 + hstep, voffA);
            PG8_WAIT_V(8); PG8_WAIT_L(0); PG8_BAR; PG8_MMA(0, 0, At, B0); PG8_MMA(0, 1, At, B1); PG8_BAR; PG8_SCHED;
            PG8_LDA(At, 1, 1); PG8_STAGE(PG8_SB(1, 0), b3, voffB); PG8_STAGE(PG8_SB(1, 1), b3 + hstep, voffB); PG8_STAGE(PG8_SA(1, 0), a3, voffA);
            PG8_WAIT_V(8); PG8_WAIT_L(0); PG8_BAR; PG8_MMA(1, 0, At, B0); PG8_MMA(1, 1, At, B1); PG8_BAR; PG8_SCHED;
            } else {
            PG8_LDB(B0, 0, 0); PG8_SCHED; PG8_LDA(At, 0, 0); PG8_STAGE(PG8_SA(1, 1), a1 + hstep, voffA);
            PG8_WAIT_L(8); PG8_BAR; PG8_WAIT_L(0); PG8_MMA(0, 0, At, B0); PG8_BAR; PG8_SCHED;
            PG8_LDB(B1, 0, 1); PG8_STAGE(PG8_SB(0, 0), b2, voffB);
            PG8_BAR; PG8_WAIT_L(0); PG8_MMA(0, 1, At, B1); PG8_BAR;
            PG8_LDA(At, 0, 1); PG8_STAGE(PG8_SA(0, 0), a2, voffA);
            PG8_BAR; PG8_WAIT_L(0); PG8_MMA(1, 0, At, B0); PG8_BAR; PG8_SCHED;
            PG8_STAGE(PG8_SB(0, 1), b2 + hstep, voffB);
            PG8_WAIT_V(6); PG8_BAR; PG8_MMA(1, 1, At, B1); PG8_BAR;
            PG8_LDB(B0, 1, 0); PG8_SCHED; PG8_LDA(At, 1, 0); PG8_STAGE(PG8_SA(0, 1), a2 + hstep, voffA);
            PG8_WAIT_L(8); PG8_BAR; PG8_WAIT_L(0); PG8_MMA(0, 0, At, B0); PG8_BAR; PG8_SCHED;
            PG8_LDB(B1, 1, 1); PG8_STAGE(PG8_SB(1, 0), b3, voffB);
            PG8_BAR; PG8_WAIT_L(0); PG8_MMA(0, 1, At, B1); PG8_BAR;
            PG8_LDA(At, 1, 1); PG8_STAGE(PG8_SA(1, 0), a3, voffA);
            PG8_BAR; PG8_WAIT_L(0); PG8_MMA(1, 0, At, B0); PG8_BAR; PG8_SCHED;
            PG8_STAGE(PG8_SB(1, 1), b3 + hstep, voffB);
            PG8_WAIT_V(6); PG8_BAR; PG8_MMA(1, 1, At, B1); PG8_BAR;
            }
        }
        if constexpr (ALIGN_EPI) { if (wr == 0) PG8_BAR; }
        if constexpr (!Epi::AFTER_DRAIN) { E(acc, cur, wr, wc, fr, fq); S.done(cur); }
        if (!has_next) break;
#pragma unroll
        for (int a = 0; a < 2; ++a)
#pragma unroll
            for (int b = 0; b < 2; ++b)
#pragma unroll
                for (int m = 0; m < 4; ++m)
#pragma unroll
                    for (int n = 0; n < 2; ++n) acc[a][b][m][n] = (f32x4){0.f, 0.f, 0.f, 0.f};
        cur = nxt; cA = nA; cB = nB; ++ui;
        if constexpr (ALIGN_EPI) { if (wr == 1) PG8_BAR; }
    }
    PG8_WAIT_V(0);
    if constexpr (!ALIGN_EPI) { if (wr == 0) PG8_BAR; }
    PG8_BAR;
    if constexpr (Epi::AFTER_DRAIN) { E.fused(acc, cur, wr, wc, fr, fq, lds, wid, lane); S.done(cur); }
#undef PG8_SA
#undef PG8_SB
#undef PG8_STAGE
#undef PG8_LDA
#undef PG8_LDB
#undef PG8_MMA
#undef PG8_WAIT_V
#undef PG8_WAIT_L
#undef PG8_BAR
#undef PG8_SCHED
}
}
#define LAS __attribute__((address_space(3)))
typedef unsigned short bf16_t;
typedef short bf16x8 __attribute__((ext_vector_type(8)));
typedef short s16x4 __attribute__((ext_vector_type(4)));
typedef float f32x4 __attribute__((ext_vector_type(4)));
typedef float f32x8 __attribute__((ext_vector_type(8)));
typedef float f32x16 __attribute__((ext_vector_type(16)));
typedef unsigned u32x4 __attribute__((ext_vector_type(4)));
typedef unsigned u32x2 __attribute__((ext_vector_type(2)));
using pg8::cvt_pk_bf16;

constexpr int NB = 8, SEQ = 4096, DM = 2048, TOK = NB * SEQ;
constexpr int N0P = 6912, P0LD = 6656, N1 = 6144;
constexpr int C_AQ = 0, C_AK = 1024, C_AV = 2048, C_AG = 3072, C_BQ = 4096, C_BK = 5120, C_BV = 5376, C_BG = 5632;
constexpr float EPS = 1e-6f;
constexpr int NTHR = 512, NWAVES = 8;
constexpr int LDS_BYTES = 159744;
constexpr size_t WS_CTL = 0;
constexpr size_t WS_W0T = 4096;
constexpr size_t WS_WO0T = WS_W0T + (size_t)N0P * DM * 2;
constexpr size_t WS_W1T = WS_WO0T + (size_t)DM * DM * 2;
constexpr size_t WS_WO1T = WS_W1T + (size_t)N1 * DM * 2;
constexpr size_t WS_H = WS_WO1T + (size_t)DM * DM * 2;
constexpr size_t WS_PROJ = WS_H + (size_t)TOK * DM * 2;
constexpr size_t WS_LOG = WS_PROJ + (size_t)TOK * P0LD * 2;
constexpr size_t WS_QKV = WS_LOG + (size_t)TOK * 32 * 4 * 2;
constexpr size_t WS_YCAT = WS_QKV + (size_t)TOK * 3072 * 2;
constexpr size_t WS_PART = WS_YCAT + (size_t)TOK * DM * 2;
constexpr size_t WS_RSTD = WS_PART + (size_t)TOK * 32 * 4;
constexpr size_t WS_VST = WS_RSTD + (size_t)TOK * 4;
constexpr size_t WS_END = WS_VST + (size_t)TOK * 32 * 2 * 4;

#define LDS_WAIT() asm volatile("s_waitcnt lgkmcnt(0)" ::: "memory")
__device__ __forceinline__ float bf2f(bf16_t v) { return __builtin_bit_cast(float, (unsigned)v << 16); }
__device__ __forceinline__ float bflo(unsigned w) { return __builtin_bit_cast(float, w << 16); }
__device__ __forceinline__ float bfhi(unsigned w) { return __builtin_bit_cast(float, w & 0xffff0000u); }
__device__ __forceinline__ bf16_t f2bf(float f) { return (bf16_t)(cvt_pk_bf16(f, 0.f) & 0xffffu); }
__device__ __forceinline__ float silu_f(float x) { return x * __builtin_amdgcn_rcpf(1.f + __expf(-x)); }
__device__ __forceinline__ float wave_sum(float v) {
#pragma unroll
    for (int o = 1; o < 64; o <<= 1) v += __shfl_xor(v, o);
    return v;
}
__device__ __forceinline__ int crow(int r, int hi) { return (r & 3) + 8 * (r >> 2) + 4 * hi; }
__device__ __forceinline__ void unpack8(u32x4 w, float* f) {
    f[0] = bflo(w.x); f[1] = bfhi(w.x); f[2] = bflo(w.y); f[3] = bfhi(w.y); f[4] = bflo(w.z); f[5] = bfhi(w.z); f[6] = bflo(w.w); f[7] = bfhi(w.w);
}
__device__ __forceinline__ u32x4 pack8(const float* f) {
    u32x4 w; w.x = cvt_pk_bf16(f[0], f[1]); w.y = cvt_pk_bf16(f[2], f[3]); w.z = cvt_pk_bf16(f[4], f[5]); w.w = cvt_pk_bf16(f[6], f[7]); return w;
}

namespace pg8 {
struct OneUnit { int pm;
    __device__ __forceinline__ bool next(int i, Unit& u) const { if (i) return false; u.pm = pm; u.pn = 0; return true; }
    __device__ __forceinline__ void a_ready(const Unit&) const {}
    __device__ __forceinline__ void done(const Unit&) const {} };
struct EpiLog {
    static constexpr bool PERM = true, AFTER_DRAIN = false;
    float* LOG;
    __device__ __forceinline__ void operator()(const f32x4 (&acc)[2][2][4][2], const Unit& u, int wr, int wc, int fr, int fq) const {
        const int row0 = u.pm * BM + wr * 64 + fr;
        if (wc == 0) {
#pragma unroll
            for (int ai = 0; ai < 2; ++ai)
#pragma unroll
                for (int m = 0; m < 4; ++m) { float* lp = LOG + (size_t)(row0 + ai * HALF + m * 16) * 32 + 8 * fq;
                    *(f32x4*)lp = acc[ai][0][m][0]; *(f32x4*)(lp + 4) = acc[ai][0][m][1]; }
        }
    }
};
struct Epi0 {
    static constexpr bool PERM = true, AFTER_DRAIN = false;
    bf16_t* P; float* LOG;
    __device__ __forceinline__ void operator()(const f32x4 (&acc)[2][2][4][2], const Unit& u, int wr, int wc, int fr, int fq) const {
        const int row0 = u.pm * BM + wr * 64 + fr;
        if (u.pn < 26) {
            const int col0 = u.pn * BM + wc * 32 + 8 * fq;
#pragma unroll
            for (int ai = 0; ai < 2; ++ai)
#pragma unroll
                for (int m = 0; m < 4; ++m) { bf16_t* rowp = P + (size_t)(row0 + ai * HALF + m * 16) * P0LD + col0;
#pragma unroll
                    for (int bj = 0; bj < 2; ++bj) { const f32x4 v0 = acc[ai][bj][m][0], v1 = acc[ai][bj][m][1];
                        ::u32x4 w; w.x = cvt_pk_bf16(v0[0], v0[1]); w.y = cvt_pk_bf16(v0[2], v0[3]); w.z = cvt_pk_bf16(v1[0], v1[1]); w.w = cvt_pk_bf16(v1[2], v1[3]);
                        *(::u32x4*)(rowp + bj * HALF) = w; } }
        } else if (wc == 0) {
#pragma unroll
            for (int ai = 0; ai < 2; ++ai)
#pragma unroll
                for (int m = 0; m < 4; ++m) { float* lp = LOG + (size_t)(row0 + ai * HALF + m * 16) * 32 + 8 * fq;
                    *(f32x4*)lp = acc[ai][0][m][0]; *(f32x4*)(lp + 4) = acc[ai][0][m][1]; }
        }
    }
};
struct Epi1 {
    static constexpr bool PERM = true, AFTER_DRAIN = false;
    bf16_t* P; const float* RS; float* VST;
    __device__ __forceinline__ void operator()(const f32x4 (&acc)[2][2][4][2], const Unit& u, int wr, int wc, int fr, int fq) const {
        const int row0 = u.pm * BM + wr * 64 + fr; const int col0 = u.pn * BM + wc * 32 + 8 * fq; const bool act = u.pn < 16, vst = u.pn >= 8 && u.pn < 16;
        float rsv[2][4];
#pragma unroll
        for (int ai = 0; ai < 2; ++ai)
#pragma unroll
            for (int m = 0; m < 4; ++m) rsv[ai][m] = RS[row0 + ai * HALF + m * 16];
#pragma unroll
        for (int ai = 0; ai < 2; ++ai)
#pragma unroll
            for (int m = 0; m < 4; ++m) { const int row = row0 + ai * HALF + m * 16; const float rs = rsv[ai][m]; bf16_t* rowp = P + (size_t)row * N1 + col0; float s1 = 0.f, s2 = 0.f;
#pragma unroll
                for (int bj = 0; bj < 2; ++bj) { f32x4 v0 = acc[ai][bj][m][0] * rs, v1 = acc[ai][bj][m][1] * rs;
                    if (act) { f32x2 a = gelu_pk((f32x2){v0[0], v0[1]}), b = gelu_pk((f32x2){v0[2], v0[3]}), c = gelu_pk((f32x2){v1[0], v1[1]}), d = gelu_pk((f32x2){v1[2], v1[3]});
                        v0 = (f32x4){a.x, a.y, b.x, b.y}; v1 = (f32x4){c.x, c.y, d.x, d.y}; }
                    if (vst) { s1 += (v0[0] + v0[1]) + (v0[2] + v0[3]) + (v1[0] + v1[1]) + (v1[2] + v1[3]);
                        s2 += (v0[0] * v0[0] + v0[1] * v0[1]) + (v0[2] * v0[2] + v0[3] * v0[3]) + (v1[0] * v1[0] + v1[1] * v1[1]) + (v1[2] * v1[2] + v1[3] * v1[3]); }
                    ::u32x4 w; w.x = cvt_pk_bf16(v0[0], v0[1]); w.y = cvt_pk_bf16(v0[2], v0[3]); w.z = cvt_pk_bf16(v1[0], v1[1]); w.w = cvt_pk_bf16(v1[2], v1[3]);
                    *(::u32x4*)(rowp + bj * HALF) = w; }
                if (vst) { s1 += __shfl_xor(s1, 16); s1 += __shfl_xor(s1, 32); s2 += __shfl_xor(s2, 16); s2 += __shfl_xor(s2, 32);
                    if (fq == 0) *(f32x2*)(VST + ((size_t)row * 32 + (u.pn - 8) * 4 + wc) * 2) = (f32x2){s1, s2}; } }
    }
};
struct EpiRes0 {
    static constexpr bool PERM = true, AFTER_DRAIN = false;
    const float* X; bf16_t* XB; float* PART;
    __device__ __forceinline__ void operator()(const f32x4 (&acc)[2][2][4][2], const Unit& u, int wr, int wc, int fr, int fq) const {
        const int row0 = u.pm * BM + wr * 64 + fr; const int col0 = u.pn * BM + wc * 32 + 8 * fq;
#pragma unroll
        for (int ai = 0; ai < 2; ++ai) {
            f32x4 xr[4][2][2];
#pragma unroll
            for (int m = 0; m < 4; ++m)
#pragma unroll
                for (int bj = 0; bj < 2; ++bj) { const size_t off = (size_t)(row0 + ai * HALF + m * 16) * DM + col0 + bj * HALF; xr[m][bj][0] = *(const f32x4*)(X + off); xr[m][bj][1] = *(const f32x4*)(X + off + 4); }
#pragma unroll
            for (int m = 0; m < 4; ++m) { const int row = row0 + ai * HALF + m * 16; const size_t off = (size_t)row * DM + col0; float ss = 0.f;
#pragma unroll
                for (int bj = 0; bj < 2; ++bj) { const f32x4 v0 = xr[m][bj][0] + acc[ai][bj][m][0], v1 = xr[m][bj][1] + acc[ai][bj][m][1];
                    ss += (v0[0] * v0[0] + v0[1] * v0[1]) + (v0[2] * v0[2] + v0[3] * v0[3]) + (v1[0] * v1[0] + v1[1] * v1[1]) + (v1[2] * v1[2] + v1[3] * v1[3]);
                    ::u32x4 w; w.x = cvt_pk_bf16(v0[0], v0[1]); w.y = cvt_pk_bf16(v0[2], v0[3]); w.z = cvt_pk_bf16(v1[0], v1[1]); w.w = cvt_pk_bf16(v1[2], v1[3]);
                    *(::u32x4*)(XB + off + bj * HALF) = w; }
                ss += __shfl_xor(ss, 16); ss += __shfl_xor(ss, 32);
                if (fq == 0) PART[(size_t)row * 32 + u.pn * 4 + wc] = ss; } }
    }
};
struct EpiRes1 {
    static constexpr bool PERM = true, AFTER_DRAIN = false;
    const bf16_t* XB; float* O;
    __device__ __forceinline__ void operator()(const f32x4 (&acc)[2][2][4][2], const Unit& u, int wr, int wc, int fr, int fq) const {
        const int row0 = u.pm * BM + wr * 64 + fr; const int col0 = u.pn * BM + wc * 32 + 8 * fq;
        ::u32x4 xbv[2][4][2];
#pragma unroll
        for (int ai = 0; ai < 2; ++ai)
#pragma unroll
            for (int m = 0; m < 4; ++m)
#pragma unroll
                for (int bj = 0; bj < 2; ++bj) xbv[ai][m][bj] = *(const ::u32x4*)(XB + (size_t)(row0 + ai * HALF + m * 16) * DM + col0 + bj * HALF);
#pragma unroll
        for (int ai = 0; ai < 2; ++ai)
#pragma unroll
            for (int m = 0; m < 4; ++m) { const size_t off = (size_t)(row0 + ai * HALF + m * 16) * DM + col0;
#pragma unroll
                for (int bj = 0; bj < 2; ++bj) { const ::u32x4 xb = xbv[ai][m][bj];
                    const f32x4 r0 = {::bflo(xb.x), ::bfhi(xb.x), ::bflo(xb.y), ::bfhi(xb.y)}, r1 = {::bflo(xb.z), ::bfhi(xb.z), ::bflo(xb.w), ::bfhi(xb.w)};
                    *(f32x4*)(O + off + bj * HALF) = r0 + acc[ai][bj][m][0]; *(f32x4*)(O + off + bj * HALF + 4) = r1 + acc[ai][bj][m][1]; } }
    }
};
}
__device__ __forceinline__ void transpose_item(const float* __restrict__ W, int K, int Nsrc, int src_n0, bf16_t* __restrict__ WT, int dst_n0, int k0, LAS float* scr, int lane, const float* __restrict__ kscale = nullptr) {
    { const int n4 = (lane & 7) * 4; f32x4 tv[8];
#pragma unroll
        for (int i = 0; i < 8; ++i) { const int kk = (lane >> 3) + 8 * i;
            tv[i] = (src_n0 >= 0) ? *(const f32x4*)(W + (size_t)(k0 + kk) * Nsrc + src_n0 + n4) * (kscale ? kscale[k0 + kk] : 1.f) : (f32x4){0.f, 0.f, 0.f, 0.f}; }
#pragma unroll
        for (int i = 0; i < 8; ++i) { const int kk = (lane >> 3) + 8 * i; LAS float* d = scr + kk * 33 + n4; d[0] = tv[i].x; d[1] = tv[i].y; d[2] = tv[i].z; d[3] = tv[i].w; } }
    LDS_WAIT(); asm volatile("" ::: "memory");
    const int c = lane & 7;
#pragma unroll
    for (int j = 0; j < 4; ++j) { const int n = (lane >> 3) + 8 * j; const LAS float* s = scr + (8 * c) * 33 + n;
        u32x4 o; o.x = cvt_pk_bf16(s[0 * 33], s[1 * 33]); o.y = cvt_pk_bf16(s[2 * 33], s[3 * 33]); o.z = cvt_pk_bf16(s[4 * 33], s[5 * 33]); o.w = cvt_pk_bf16(s[6 * 33], s[7 * 33]);
        *(u32x4*)(WT + (size_t)(dst_n0 + n) * K + k0 + 8 * c) = o; }
    LDS_WAIT(); asm volatile("" ::: "memory");
}
__device__ __forceinline__ void rms_row(const float* __restrict__ xrow, const float* __restrict__ g, bf16_t* __restrict__ orow, int lane) {
    const f32x4* xr = (const f32x4*)xrow + lane; f32x4 v[8]; float s = 0.f;
#pragma unroll
    for (int j = 0; j < 8; ++j) { v[j] = xr[64 * j]; s += (v[j].x * v[j].x + v[j].y * v[j].y) + (v[j].z * v[j].z + v[j].w * v[j].w); }
    const float r = 1.0f / sqrtf(wave_sum(s) * (1.f / DM) + EPS);
    const f32x4* gr = (const f32x4*)g + lane; u32x2* o8 = (u32x2*)orow + lane;
#pragma unroll
    for (int j = 0; j < 8; ++j) { const f32x4 gg = gr[64 * j]; u32x2 w; w.x = cvt_pk_bf16(v[j].x * r * gg.x, v[j].y * r * gg.y); w.y = cvt_pk_bf16(v[j].z * r * gg.z, v[j].w * r * gg.w); o8[64 * j] = w; }
}
__device__ __forceinline__ void rms_row2(const float* __restrict__ xa, const float* __restrict__ xb, const float* __restrict__ g, bf16_t* __restrict__ oa, bf16_t* __restrict__ ob, int lane) {
    const f32x4* xra = (const f32x4*)xa + lane; const f32x4* xrb = (const f32x4*)xb + lane; f32x4 va[8], vb[8]; float sa = 0.f, sb = 0.f;
#pragma unroll
    for (int j = 0; j < 8; ++j) { va[j] = xra[64 * j]; vb[j] = xrb[64 * j]; }
#pragma unroll
    for (int j = 0; j < 8; ++j) { sa += (va[j].x * va[j].x + va[j].y * va[j].y) + (va[j].z * va[j].z + va[j].w * va[j].w); sb += (vb[j].x * vb[j].x + vb[j].y * vb[j].y) + (vb[j].z * vb[j].z + vb[j].w * vb[j].w); }
    const float ra = 1.0f / sqrtf(wave_sum(sa) * (1.f / DM) + EPS), rb = 1.0f / sqrtf(wave_sum(sb) * (1.f / DM) + EPS);
    const f32x4* gr = (const f32x4*)g + lane; u32x2* o8a = (u32x2*)oa + lane; u32x2* o8b = (u32x2*)ob + lane;
#pragma unroll
    for (int j = 0; j < 8; ++j) { const f32x4 gg = gr[64 * j]; u32x2 w;
        w.x = cvt_pk_bf16(va[j].x * ra * gg.x, va[j].y * ra * gg.y); w.y = cvt_pk_bf16(va[j].z * ra * gg.z, va[j].w * ra * gg.w); o8a[64 * j] = w;
        w.x = cvt_pk_bf16(vb[j].x * rb * gg.x, vb[j].y * rb * gg.y); w.y = cvt_pk_bf16(vb[j].z * rb * gg.z, vb[j].w * rb * gg.w); o8b[64 * j] = w; }
}
struct P0Args { const float* x; const float* g0; const float* g1; const float* w_in0; const float* w_out0; const float* w_in1; const float* w_out1; bf16_t* W0T; bf16_t* WO0T; bf16_t* W1T; bf16_t* WO1T; bf16_t* H; };
__device__ __forceinline__ void p0_prologue(const P0Args& a, LAS unsigned char* lds, int gw, int NGW, int wave, int lane) {
    LAS float* scr = (LAS float*)(lds + wave * 16384);
    constexpr int I0 = 32 * (N0P / 32), IO = 32 * (DM / 32), I1 = 32 * (N1 / 32);
    constexpr int NITEMS = I0 + IO + I1 + IO;
    for (int it = gw; it < NITEMS; it += NGW) {
        int r = it;
        if (r < I0) { const int nblk = N0P / 32, kb = r / nblk, nb = r % nblk, d0 = 32 * nb;
            const int src = d0 < 4096 ? d0 : (d0 < 6656 ? d0 + 32 : (d0 == 6656 ? 4096 : -1));
            transpose_item(a.w_in0, DM, 6688, src, a.W0T, d0, 64 * kb, scr, lane); continue; }
        r -= I0;
        if (r < IO) { const int nblk = DM / 32, kb = r / nblk, nb = r % nblk; transpose_item(a.w_out0, DM, DM, 32 * nb, a.WO0T, 32 * nb, 64 * kb, scr, lane); continue; }
        r -= IO;
        if (r < I1) { const int nblk = N1 / 32, kb = r / nblk, nb = r % nblk; transpose_item(a.w_in1, DM, N1, 32 * nb, a.W1T, 32 * nb, 64 * kb, scr, lane, a.g1); continue; }
        r -= I1;
        { const int nblk = DM / 32, kb = r / nblk, nb = r % nblk; transpose_item(a.w_out1, DM, DM, 32 * nb, a.WO1T, 32 * nb, 64 * kb, scr, lane); }
    }
    for (int m = gw; m < TOK; m += 2 * NGW) rms_row2(a.x + (size_t)m * DM, a.x + (size_t)(m + NGW) * DM, a.g0, a.H + (size_t)m * DM, a.H + (size_t)(m + NGW) * DM, lane);
}

__device__ __forceinline__ void p2_conv_item(const bf16_t* __restrict__ P, const float* __restrict__ cw, bf16_t* __restrict__ QKV, int item, int lane) {
    const int run = item / 6, slice = item % 6, t0 = run * 16, b = t0 / SEQ, l0 = t0 % SEQ, ch0 = slice * 512 + lane * 8;
    float w[5][8];
#pragma unroll
    for (int j = 0; j < 5; ++j) { const f32x4 a = *(const f32x4*)(cw + j * 3072 + ch0), c = *(const f32x4*)(cw + j * 3072 + ch0 + 4);
        w[j][0] = a.x; w[j][1] = a.y; w[j][2] = a.z; w[j][3] = a.w; w[j][4] = c.x; w[j][5] = c.y; w[j][6] = c.z; w[j][7] = c.w; }
    u32x4 rows[20];
#pragma unroll
    for (int r = 0; r < 20; ++r) { const int l = l0 - 2 + r, lc = l < 0 ? 0 : (l >= SEQ ? SEQ - 1 : l);
        rows[r] = *(const u32x4*)(P + (size_t)(b * SEQ + lc) * P0LD + ch0);
        if (l != lc) rows[r] = (u32x4){0u, 0u, 0u, 0u}; }
    float win[5][8];
#pragma unroll
    for (int j = 0; j < 5; ++j)
#pragma unroll
        for (int e = 0; e < 8; ++e) win[j][e] = 0.f;
#pragma unroll
    for (int r = 0; r < 20; ++r) {
#pragma unroll
        for (int j = 0; j < 4; ++j)
#pragma unroll
            for (int e = 0; e < 8; ++e) win[j][e] = win[j + 1][e];
        unpack8(rows[r], win[4]);
        if (r >= 4) {
            float y[8]; float ss = 0.f;
#pragma unroll
            for (int e = 0; e < 8; ++e) { float acc = 0.f;
#pragma unroll
                for (int j = 0; j < 5; ++j) acc = fmaf(w[j][e], win[j][e], acc);
                y[e] = silu_f(acc); ss = fmaf(y[e], y[e], ss); }
            if (slice < 4) {
                ss += __shfl_xor(ss, 1); ss += __shfl_xor(ss, 2); ss += __shfl_xor(ss, 4); ss += __shfl_xor(ss, 8);
                const float rn = 1.0f / sqrtf(ss + EPS);
#pragma unroll
                for (int e = 0; e < 8; ++e) y[e] *= rn;
            }
            *(u32x4*)(QKV + (size_t)(t0 + r - 4) * 3072 + ch0) = pack8(y);
        }
    }
}

template <int NT>
__device__ __forceinline__ void p2_rope_tokens(bf16_t* __restrict__ P, const float* __restrict__ qn_g, const float* __restrict__ kn_g, int t0, int tstride, int lane) {
    const int half = lane >> 5, i = lane & 31;
    const float inv = exp2f(-(float)i * (13.287712379549449f / 32.f));
    const int e1 = half * 64 + i, e2 = e1 + 32;
    const float gq1 = qn_g[e1], gq2 = qn_g[e2], gk1 = kn_g[e1], gk2 = kn_g[e2];
    float x1[NT][10], x2[NT][10];
#pragma unroll
    for (int k = 0; k < NT; ++k) { const bf16_t* row = P + (size_t)(t0 + k * tstride) * P0LD;
#pragma unroll
        for (int hh = 0; hh < 10; ++hh) { const bf16_t* hp = row + (hh < 8 ? C_BQ + hh * 128 : C_BK + (hh - 8) * 128); x1[k][hh] = bf2f(hp[e1]); x2[k][hh] = bf2f(hp[e2]); } }
#pragma unroll
    for (int k = 0; k < NT; ++k) { const int t = t0 + k * tstride, l = t % SEQ; bf16_t* row = P + (size_t)t * P0LD;
        const float pos = half ? (float)(l % 64) : (float)(l / 64);
        float rev = pos * inv * 0.15915494309189535f; rev -= floorf(rev);
        const float sn = __builtin_amdgcn_sinf(rev), cs = __builtin_amdgcn_cosf(rev);
#pragma unroll
        for (int hh = 0; hh < 10; ++hh) {
            bf16_t* hp = row + (hh < 8 ? C_BQ + hh * 128 : C_BK + (hh - 8) * 128);
            const float ss = wave_sum(x1[k][hh] * x1[k][hh] + x2[k][hh] * x2[k][hh]);
            const float rn = 1.0f / sqrtf(ss * (1.f / 128.f) + EPS);
            const float y1 = x1[k][hh] * rn * (hh < 8 ? gq1 : gk1), y2 = x2[k][hh] * rn * (hh < 8 ? gq2 : gk2);
            hp[e1] = f2bf(y1 * cs - y2 * sn); hp[e2] = f2bf(y2 * cs + y1 * sn);
        } }
}

template <int NT>
__device__ __forceinline__ void p4_tokens(const bf16_t* __restrict__ OF, const bf16_t* __restrict__ OB, const bf16_t* __restrict__ P, const float* __restrict__ og, bf16_t* __restrict__ Y, int t0, int lane) {
    u32x4 ra[NT][2], rb[NT][2], rg[NT][2];
#pragma unroll
    for (int k = 0; k < NT; ++k)
#pragma unroll
        for (int i = 0; i < 2; ++i) { const int col0 = i * 512 + lane * 8; const size_t t = (size_t)(t0 + k);
            ra[k][i] = *(const u32x4*)(OF + t * 1024 + col0); rb[k][i] = *(const u32x4*)(OB + t * 1024 + col0); rg[k][i] = *(const u32x4*)(P + t * P0LD + C_AG + col0); }
#pragma unroll
    for (int k = 0; k < NT; ++k)
#pragma unroll
        for (int i = 0; i < 2; ++i) { const int col0 = i * 512 + lane * 8; float a[8], b[8], g[8], y[8];
            unpack8(ra[k][i], a); unpack8(rb[k][i], b); unpack8(rg[k][i], g);
            float ss = 0.f;
#pragma unroll
            for (int e = 0; e < 8; ++e) { a[e] += b[e]; ss = fmaf(a[e], a[e], ss); }
            ss += __shfl_xor(ss, 1); ss += __shfl_xor(ss, 2); ss += __shfl_xor(ss, 4); ss += __shfl_xor(ss, 8);
            const float rn = 1.0f / sqrtf(ss * (1.f / 128.f) + EPS);
            const int e0 = col0 & 127;
#pragma unroll
            for (int e = 0; e < 8; ++e) y[e] = a[e] * rn * og[e0 + e] * silu_f(g[e]);
            *(u32x4*)(Y + (size_t)(t0 + k) * DM + col0) = pack8(y); }
}
namespace att {
constexpr int D = 128, NW = 8, QBLK = 32, KVBLK = 64;
constexpr float SCALE = 0.088388347648318440f;
constexpr float THR = 8.f;
constexpr int SDEPTH = 2;
constexpr int LDQ = P0LD, LDK = P0LD;
constexpr size_t SHM_V = KVBLK * D * 2, SHM_K = KVBLK * D * 2, SHM_ATTN = 2 * SHM_V + 2 * SHM_K + NW * 64 * 4;
#define KSWZ(row, colB) ((row) * 256 + ((colB) ^ (((row) & 7) << 4)))
#define SBAR() __builtin_amdgcn_sched_barrier(0)
__device__ __forceinline__ unsigned cvtpk(float lo, float hi) { unsigned r; asm volatile("v_cvt_pk_bf16_f32 %0, %1, %2" : "=v"(r) : "v"(lo), "v"(hi)); return r; }
__device__ __forceinline__ void partialSM(f32x16& p0, f32x16& p1, float& m_reg, float& mn, float& alpha) {
  constexpr float C = SCALE * 1.4426950408889634f;
  float pmax = p0[0]; for (int r = 1; r < 16; ++r) pmax = fmaxf(pmax, p0[r]); for (int r = 0; r < 16; ++r) pmax = fmaxf(pmax, p1[r]);
  { auto rr = __builtin_amdgcn_permlane32_swap(__float_as_uint(pmax), __float_as_uint(pmax), false, false);
    pmax = fmaxf(__uint_as_float(rr[0]), __uint_as_float(rr[1])); }
  if (__builtin_expect(__all(pmax - m_reg <= THR / SCALE), 1)) { mn = m_reg; alpha = 1.f; }
  else { mn = fmaxf(m_reg, pmax); alpha = __builtin_amdgcn_exp2f((m_reg - mn) * C); m_reg = mn; }
  float mnC = -mn * C;
  for (int r = 0; r < 16; ++r) p0[r] = fmaf(p0[r], C, mnC); for (int r = 0; r < 16; ++r) p1[r] = fmaf(p1[r], C, mnC);
  for (int r = 0; r < 16; ++r) p0[r] = __builtin_amdgcn_exp2f(p0[r]);
}
__device__ __forceinline__ void finishSM(f32x16& p0, f32x16& p1, float alpha, float& l_reg, bf16x8& pa0, bf16x8& pa1, bf16x8& pa2, bf16x8& pa3) {
  for (int r = 0; r < 16; ++r) p1[r] = __builtin_amdgcn_exp2f(p1[r]);
  float ps = 0; for (int r = 0; r < 16; ++r) ps += p0[r]; for (int r = 0; r < 16; ++r) ps += p1[r];
  { auto rr = __builtin_amdgcn_permlane32_swap(__float_as_uint(ps), __float_as_uint(ps), false, false);
    ps = __uint_as_float(rr[0]) + __uint_as_float(rr[1]); }
  l_reg = l_reg * alpha + ps;
#define PK4(P, BASE, OUT) do { unsigned a0 = cvtpk(P[BASE + 0], P[BASE + 1]), a1 = cvtpk(P[BASE + 2], P[BASE + 3]);   \
    unsigned b0 = cvtpk(P[BASE + 4], P[BASE + 5]), b1 = cvtpk(P[BASE + 6], P[BASE + 7]);                              \
    auto r0 = __builtin_amdgcn_permlane32_swap(a0, b0, false, false); auto r1 = __builtin_amdgcn_permlane32_swap(a1, b1, false, false); \
    u32x4 w = {r0[0], r1[0], r0[1], r1[1]}; OUT = *reinterpret_cast<bf16x8*>(&w); } while (0)
  PK4(p0, 0, pa0); PK4(p0, 8, pa1); PK4(p1, 0, pa2); PK4(p1, 8, pa3);
#undef PK4
}
__device__ __forceinline__ void qkt(f32x16& p0, f32x16& p1, const bf16_t* Ks, const bf16x8* qr, int r32, int hi) {
  p0 = f32x16{}; p1 = f32x16{};
  for (int d0 = 0; d0 < 8; ++d0) { int cb = (d0 * 16 + hi * 8) * 2;
    bf16x8 b0 = *reinterpret_cast<const bf16x8*>((const char*)Ks + KSWZ(r32, cb));
    bf16x8 b1 = *reinterpret_cast<const bf16x8*>((const char*)Ks + KSWZ(32 + r32, cb));
    p0 = __builtin_amdgcn_mfma_f32_32x32x16_bf16(b0, qr[d0], p0, 0, 0, 0);
    p1 = __builtin_amdgcn_mfma_f32_32x32x16_bf16(b1, qr[d0], p1, 0, 0, 0); }
}
__device__ __forceinline__ int v_st(int k, int c) { const int kk = (k & ~0xC) | ((k & 4) << 1) | ((k & 8) >> 1); return ((kk >> 3) * 4 + (c >> 5)) * 512 + ((kk & 7) * 32 + (c & 31)) * 2; }
__device__ __forceinline__ int v_rd_base(int lane) { return ((lane & 3) << 3) | (((lane >> 2) & 3) << 6) | (((lane >> 4) & 1) << 5) | (((lane >> 5) & 1) << 8); }
constexpr int v_rd_off(int d0, int ks, int half) { return d0 * 512 + ks * 4096 + half * 2048; }
template <int OFF> __device__ __forceinline__ s16x4 tr_read(int vb) {
  s16x4 r; asm volatile("ds_read_b64_tr_b16 %0, %1 offset:%2" : "=&v"(r) : "v"(vb), "i"(OFF) : "memory"); return r;
}
template <int D0> __device__ __forceinline__ void pv_one(f32x16& od, int vb, bf16x8 pa0, bf16x8 pa1, bf16x8 pa2, bf16x8 pa3) {
  const s16x4 l0 = tr_read<v_rd_off(D0, 0, 0)>(vb), h0 = tr_read<v_rd_off(D0, 0, 1)>(vb), l1 = tr_read<v_rd_off(D0, 1, 0)>(vb), h1 = tr_read<v_rd_off(D0, 1, 1)>(vb);
  const s16x4 l2 = tr_read<v_rd_off(D0, 2, 0)>(vb), h2 = tr_read<v_rd_off(D0, 2, 1)>(vb), l3 = tr_read<v_rd_off(D0, 3, 0)>(vb), h3 = tr_read<v_rd_off(D0, 3, 1)>(vb);
  asm volatile("s_waitcnt lgkmcnt(0)" ::: "memory"); SBAR();
#define PK(L, H) (bf16x8){L[0], L[1], L[2], L[3], H[0], H[1], H[2], H[3]}
  od = __builtin_amdgcn_mfma_f32_32x32x16_bf16(pa0, PK(l0, h0), od, 0, 0, 0);
  od = __builtin_amdgcn_mfma_f32_32x32x16_bf16(pa1, PK(l1, h1), od, 0, 0, 0);
  od = __builtin_amdgcn_mfma_f32_32x32x16_bf16(pa2, PK(l2, h2), od, 0, 0, 0);
  od = __builtin_amdgcn_mfma_f32_32x32x16_bf16(pa3, PK(l3, h3), od, 0, 0, 0);
#undef PK
}
__device__ __forceinline__ void pv_d0(f32x16* o, int vb, bf16x8 pa0, bf16x8 pa1, bf16x8 pa2, bf16x8 pa3) {
  pv_one<0>(o[0], vb, pa0, pa1, pa2, pa3); pv_one<1>(o[1], vb, pa0, pa1, pa2, pa3); pv_one<2>(o[2], vb, pa0, pa1, pa2, pa3); pv_one<3>(o[3], vb, pa0, pa1, pa2, pa3);
}
__device__ __forceinline__ void attn_dense_body(const bf16_t* __restrict__ Qb, const bf16_t* __restrict__ Kh, const bf16_t* __restrict__ Vh,
                                                const bf16_t* __restrict__ Gb, bf16_t* __restrict__ Yb, int seq, char* lds) {
  int tid = threadIdx.x; asm volatile("" : "+v"(tid));
  const int wid = tid >> 6, lane = tid & 63, r32 = lane & 31, hi = lane >> 5;
  bf16_t* V_lds = (bf16_t*)lds; bf16_t* K_lds = (bf16_t*)(lds + 2 * SHM_V);
  float* ws = (float*)(lds + 2 * SHM_V + 2 * SHM_K) + wid * 64; float* li_l = ws; float* al_l = ws + 32;
  float m_reg = -1e30f, l_reg = 0; f32x16 o[4] = {}; bf16x8 qr[8];
  const bf16_t* Qw = Qb + (long)(wid * QBLK + r32) * LDQ + hi * 8;
#pragma unroll
  for (int d0 = 0; d0 < 8; ++d0) qr[d0] = *reinterpret_cast<const bf16x8*>(Qw + d0 * 16);
  const int sr = tid >> 4, sc = (tid & 15) * 8, vst0 = v_st(sr, sc), vst1 = v_st(32 + sr, sc);
  const int vb0 = (int)(uintptr_t)V_lds + v_rd_base(lane);
  struct { bf16x8 vs0, vs1, ks0, ks1; } sr_[SDEPTH];
  const unsigned voff0 = (unsigned)((sr * LDK + sc) * 2), voff1 = voff0 + (unsigned)(32 * LDK * 2);
#define SLOAD(i, k0) do { const char* vb_ = (const char*)Vh + (size_t)(k0) * (LDK * 2); const char* kb_ = (const char*)Kh + (size_t)(k0) * (LDK * 2); \
    sr_[i].vs0 = *reinterpret_cast<const bf16x8*>(vb_ + voff0); sr_[i].vs1 = *reinterpret_cast<const bf16x8*>(vb_ + voff1); \
    sr_[i].ks0 = *reinterpret_cast<const bf16x8*>(kb_ + voff0); sr_[i].ks1 = *reinterpret_cast<const bf16x8*>(kb_ + voff1); } while (0)
#define SWRITE(b, i) do { *(bf16x8*)((char*)V_lds + (b) * SHM_V + vst0) = sr_[i].vs0;          \
    *(bf16x8*)((char*)V_lds + (b) * SHM_V + vst1) = sr_[i].vs1; int kc = sc * 2;               \
    *(bf16x8*)((char*)K_lds + (b) * SHM_K + KSWZ(sr, kc)) = sr_[i].ks0;                       \
    *(bf16x8*)((char*)K_lds + (b) * SHM_K + KSWZ(32 + sr, kc)) = sr_[i].ks1; } while (0)
#define SWAIT() do { if constexpr (SDEPTH == 2) asm volatile("s_waitcnt vmcnt(4)" ::: "memory"); else asm volatile("s_waitcnt vmcnt(0)" ::: "memory"); } while (0)
#define RESC(a) do { if (__any((a) < 1.f)) { if (hi == 0) al_l[r32] = (a); asm volatile("s_waitcnt lgkmcnt(0)" ::: "memory"); \
    for (int d = 0; d < 4; ++d) for (int r = 0; r < 16; ++r) o[d][r] *= al_l[crow(r, hi)]; } } while (0)
  f32x16 pA0, pA1, pB0, pB1; float mnA, mnB, alA, alB; bf16x8 pa0, pa1, pa2, pa3; const int NT = seq / KVBLK;
  constexpr int SE = 0, SO = SDEPTH - 1;
  SLOAD(SE, 0); asm volatile("s_waitcnt vmcnt(0)" ::: "memory"); SWRITE(0, SE); __syncthreads();
  qkt(pA0, pA1, K_lds, qr, r32, hi); partialSM(pA0, pA1, m_reg, mnA, alA);
  SLOAD(SO, KVBLK); if constexpr (SDEPTH == 2) { if (2 < NT) SLOAD(SE, 2 * KVBLK); }
  SWAIT(); SWRITE(1, SO); __syncthreads();
  for (int j = 1; j + 1 < NT; j += 2) {
    SBAR(); qkt(pB0, pB1, (bf16_t*)((char*)K_lds + SHM_K), qr, r32, hi);
    finishSM(pA0, pA1, alA, l_reg, pa0, pa1, pa2, pa3); SBAR();
    SLOAD(SO, (j + SDEPTH) * KVBLK); SBAR();
    pv_d0(o, vb0, pa0, pa1, pa2, pa3); partialSM(pB0, pB1, m_reg, mnB, alB);
    __syncthreads(); SWAIT(); SWRITE(0, SE);
    RESC(alB); __syncthreads();
    SBAR(); qkt(pA0, pA1, K_lds, qr, r32, hi);
    finishSM(pB0, pB1, alB, l_reg, pa0, pa1, pa2, pa3); SBAR();
    if (SDEPTH == 1 || j + 3 < NT) SLOAD(SE, (j + 1 + SDEPTH) * KVBLK); SBAR();
    pv_d0(o, vb0 + (int)SHM_V, pa0, pa1, pa2, pa3); partialSM(pA0, pA1, m_reg, mnA, alA);
    __syncthreads(); SWAIT(); SWRITE(1, SO);
    RESC(alA); __syncthreads();
  }
  SBAR(); qkt(pB0, pB1, (bf16_t*)((char*)K_lds + SHM_K), qr, r32, hi);
  finishSM(pA0, pA1, alA, l_reg, pa0, pa1, pa2, pa3); SBAR();
  pv_d0(o, vb0, pa0, pa1, pa2, pa3); partialSM(pB0, pB1, m_reg, mnB, alB);
  __syncthreads(); RESC(alB);
  finishSM(pB0, pB1, alB, l_reg, pa0, pa1, pa2, pa3); SBAR();
  pv_d0(o, vb0 + (int)SHM_V, pa0, pa1, pa2, pa3);
  if (hi == 0) li_l[r32] = l_reg; asm volatile("s_waitcnt lgkmcnt(0)" ::: "memory");
  float rli[16];
#pragma unroll
  for (int r = 0; r < 16; ++r) rli[r] = __builtin_amdgcn_rcpf(li_l[crow(r, hi)]);
  const bf16_t* Gw = Gb + (long)(wid * QBLK) * LDQ; bf16_t* Yw = Yb + (long)(wid * QBLK) * DM;
  u32x4 graw[8];
#pragma unroll
  for (int it = 0; it < 8; ++it) { const int idx = it * 64 + lane, row = idx >> 4, c8 = (idx & 15) * 8; graw[it] = *(const u32x4*)((const char*)Gw + (unsigned)((row * LDQ + c8) * 2)); }
  __syncthreads();
  { bf16_t* Ol = (bf16_t*)(lds + wid * 8192);
#pragma unroll
    for (int r = 0; r < 16; ++r) { const int orow = crow(r, hi);
#pragma unroll
      for (int d0 = 0; d0 < 4; ++d0) Ol[orow * 128 + d0 * 32 + r32] = f2bf(o[d0][r] * rli[r]); }
    asm volatile("s_waitcnt lgkmcnt(0)" ::: "memory");
#pragma unroll
    for (int it = 0; it < 8; ++it) { const int idx = it * 64 + lane, row = idx >> 4, c8 = (idx & 15) * 8; float ov[8], gv[8];
      unpack8(*(const u32x4*)(Ol + row * 128 + c8), ov); unpack8(graw[it], gv);
#pragma unroll
      for (int e = 0; e < 8; ++e) ov[e] *= silu_f(gv[e]);
      *(u32x4*)((char*)Yw + (unsigned)((row * DM + c8) * 2)) = pack8(ov); } }
  __syncthreads();
#undef SLOAD
#undef SWRITE
#undef SWAIT
#undef RESC
}
}
#ifndef DN_STAGE
#define DN_STAGE 7
#endif
namespace dn {
constexpr int KC_OFF = 0, QC_OFF = 17408, KT_OFF = 34816, VT_OFF = 53248, T1_OFF = VT_OFF + 18432, T2_OFF = T1_OFF + 9216;
constexpr int VN_OFF = VT_OFF, VNS_OFF = VT_OFF + 18432;
constexpr int MT_OFF = 90112, YF_OFF = MT_OFF + 16640, AT_OFF = YF_OFF + 4224, ST_OFF = AT_OFF + 9216, MISC_OFF = ST_OFF + 34816;
static_assert(MISC_OFF + 2048 <= LDS_BYTES - 64, "deltanet LDS map");
constexpr float SCALE = 0.088388347648318440f;
struct Args { const bf16_t* QKV; const float* LOG; const float* a_log; const float* dt_bias; bf16_t* OF; bf16_t* OB; };
__device__ __forceinline__ bf16x8 ldf(const LAS unsigned char* base, int row, int strideB, int kb) { return *(const LAS bf16x8*)(base + row * strideB + kb); }
#define DN_MFMA(a, b, c) __builtin_amdgcn_mfma_f32_32x32x16_bf16(a, b, c, 0, 0, 0)
__device__ __forceinline__ void unit(const Args& a, int un, LAS unsigned char* lds) {
    int tid = threadIdx.x; asm volatile("" : "+v"(tid));
    const int w = __builtin_amdgcn_readfirstlane(tid >> 6), lane = tid & 63, r32 = lane & 31, hi = lane >> 5;
    const int b = un >> 4, h = (un >> 1) & 7, dir = un & 1, wr = w >> 2, wc = w & 3;
    const float Aexp = expf(a.a_log[dir * 8 + h]), dtb = a.dt_bias[dir * 8 + h];
    bf16_t* __restrict__ O = dir ? a.OB : a.OF;
    LAS float* MT = (LAS float*)(lds + MT_OFF); LAS float* YF = (LAS float*)(lds + YF_OFF);
    LAS float* gc = (LAS float*)(lds + MISC_OFF); LAS float* beta = gc + 64; LAS float* eg = gc + 128; LAS float* ekl = gc + 192; LAS float* scal = gc + 256;
    __syncthreads();
    for (int i = tid; i < 34816 / 16; i += NTHR) *(LAS u32x4*)(lds + ST_OFF + i * 16) = (u32x4){0u, 0u, 0u, 0u};
    f32x16 accS[2];
#pragma unroll
    for (int r = 0; r < 16; ++r) { accS[0][r] = 0.f; accS[1][r] = 0.f; }
    u32x4 pq[2], pk[2], pv[2]; float pa = 0.f, pb = 0.f;
#define DN_LOADC(n) do { _Pragma("unroll") for (int i_ = 0; i_ < 2; ++i_) { const int idx_ = tid + NTHR * i_, c_ = idx_ & 63, d8_ = (idx_ >> 6) * 8, p_ = 64 * (n) + c_, l_ = dir ? SEQ - 1 - p_ : p_; \
        const unsigned bo_ = ((unsigned)(b * SEQ + l_) * 3072u + (unsigned)(h * 128 + d8_)) * 2u; const char* s_ = (const char*)a.QKV; \
        pq[i_] = *(const u32x4*)(s_ + bo_); pk[i_] = *(const u32x4*)(s_ + (bo_ + 2048u)); pv[i_] = *(const u32x4*)(s_ + (bo_ + 4096u)); } \
        if (w == 0) { const int p_ = 64 * (n) + lane, l_ = dir ? SEQ - 1 - p_ : p_; const unsigned lo_ = ((unsigned)(b * SEQ + l_) * 32u + (unsigned)(dir * 8 + h)) * 4u; \
            const char* l2_ = (const char*)a.LOG + (size_t)TOK * 32 * 4; pa = *(const float*)((const char*)a.LOG + lo_) + *(const float*)(l2_ + lo_); pb = *(const float*)((const char*)a.LOG + (lo_ + 64u)) + *(const float*)(l2_ + (lo_ + 64u)); } } while (0)
    DN_LOADC(0);
    for (int n = 0; n < 64; ++n) {
#pragma unroll
        for (int i = 0; i < 2; ++i) { const int idx = tid + NTHR * i, c = idx & 63, d8 = (idx >> 6) * 8;
            *(LAS u32x4*)(lds + KC_OFF + c * 272 + d8 * 2) = pk[i]; *(LAS u32x4*)(lds + QC_OFF + c * 272 + d8 * 2) = pq[i];
#pragma unroll
            for (int j = 0; j < 8; ++j) { const unsigned kw = pk[i][j >> 1], vw = pv[i][j >> 1];
                *(LAS bf16_t*)(lds + KT_OFF + (d8 + j) * 144 + c * 2) = (bf16_t)((j & 1) ? (kw >> 16) : (kw & 0xffffu));
                *(LAS bf16_t*)(lds + VT_OFF + (d8 + j) * 144 + c * 2) = (bf16_t)((j & 1) ? (vw >> 16) : (vw & 0xffffu)); } }
        if (w == 0) {
#ifdef DN_SLOWGATES
            const float x = pa + dtb; const float sp = x > 20.f ? x : log1pf(expf(x));
#else
            const float x = pa + dtb; const float ex = __expf(x); const float sp = x > 15.f ? x : (ex < 1e-4f ? ex * (1.f - 0.5f * ex) : __logf(1.f + ex));
#endif
            float g = -Aexp * sp;
#pragma unroll
            for (int o = 1; o < 64; o <<= 1) { const float y = __shfl_up(g, o); if (lane >= o) g += y; }
            const float glast = __shfl(g, 63);
#ifdef DN_SLOWGATES
            gc[lane] = g; beta[lane] = 1.f / (1.f + expf(-pb)); eg[lane] = expf(g); ekl[lane] = expf(glast - g);
            if (lane == 0) scal[0] = expf(glast);
#else
            gc[lane] = g; beta[lane] = __builtin_amdgcn_rcpf(1.f + __expf(-pb)); eg[lane] = __expf(g); ekl[lane] = __expf(glast - g);
            if (lane == 0) scal[0] = __expf(glast);
#endif
        }
        __syncthreads();
#ifdef DN_DUP_SOLVE
        for (int rep2 = 0; rep2 < 2; ++rep2) {
#endif
        {
            const int q4 = w & 3, mi = q4 >> 1, nj = q4 & 1;
            f32x16 acc;
#pragma unroll
            for (int r = 0; r < 16; ++r) acc[r] = 0.f;
            const LAS unsigned char* Ab = lds + (w < 4 ? KC_OFF : QC_OFF);
#pragma unroll
            for (int ks = 0; ks < 8; ++ks) { const int kb = (ks * 16 + hi * 8) * 2;
                acc = DN_MFMA(ldf(Ab, 32 * mi + r32, 272, kb), ldf(lds + KC_OFF, 32 * nj + r32, 272, kb), acc); }
            const int j = 32 * nj + r32; const float gcj = gc[j];
            if (w < 4) {
#pragma unroll
                for (int r = 0; r < 16; ++r) { const int i = 32 * mi + crow(r, hi); const float dec = __expf(gc[i] - gcj);
                    MT[i * 65 + j] = (i > j) ? beta[i] * acc[r] * dec : 0.f; }
            } else {
#pragma unroll
                for (int r = 0; r < 16; ++r) { const int i = 32 * mi + crow(r, hi); const float dec = __expf(gc[i] - gcj);
                    *(LAS bf16_t*)(lds + AT_OFF + i * 144 + j * 2) = f2bf((i >= j) ? acc[r] * SCALE * dec : 0.f); }
            }
        }
        __syncthreads();
#ifdef DN_L0X3
        for (int rep3 = 0; rep3 < 3; ++rep3)
#endif
        if (w == 0) {
            const int base = (lane >> 4) * 16, c = lane & 15; float x[16];
#pragma unroll
            for (int i = 0; i < 16; ++i) { float acc = (i == c) ? 1.f : 0.f;
#pragma unroll
                for (int j = 0; j < i; ++j) acc = fmaf(-MT[(base + i) * 65 + base + j], x[j], acc);
                x[i] = acc;
#ifndef DN_E1
                asm volatile("" ::: "memory");
#endif
            }
            LDS_WAIT(); asm volatile("" ::: "memory");
#pragma unroll
            for (int i = 0; i < 16; ++i) MT[(base + i) * 65 + base + c] = x[i];
        }
        __syncthreads();
        {
            const int p = tid >> 8, i = (tid >> 4) & 15, j = tid & 15, R0 = 32 * p + 16, C0 = 32 * p; float y = 0.f;
#pragma unroll
            for (int k = 0; k < 16; ++k) y = fmaf(MT[(R0 + i) * 65 + C0 + k], MT[(C0 + k) * 65 + C0 + j], y);
            YF[(p * 16 + i) * 17 + j] = y;
            __syncthreads();
            float t = 0.f;
#pragma unroll
            for (int k = 0; k < 16; ++k) t = fmaf(MT[(R0 + i) * 65 + R0 + k], YF[(p * 16 + k) * 17 + j], t);
            MT[(R0 + i) * 65 + C0 + j] = -t;
        }
        __syncthreads();
        {
            const int j = tid & 31, i0 = tid >> 5; float y0 = 0.f, y1 = 0.f;
#ifdef DN_E2
#pragma unroll
#else
#pragma unroll 8
#endif
            for (int k = 0; k < 32; ++k) { const float tk = MT[k * 65 + j]; y0 = fmaf(MT[(32 + i0) * 65 + k], tk, y0); y1 = fmaf(MT[(48 + i0) * 65 + k], tk, y1); }
            YF[i0 * 33 + j] = y0; YF[(16 + i0) * 33 + j] = y1;
            __syncthreads();
            float t0 = 0.f, t1 = 0.f;
#ifdef DN_E2
#pragma unroll
#else
#pragma unroll 8
#endif
            for (int k = 0; k < 32; ++k) { const float yk = YF[k * 33 + j]; t0 = fmaf(MT[(32 + i0) * 65 + 32 + k], yk, t0); t1 = fmaf(MT[(48 + i0) * 65 + 32 + k], yk, t1); }
            MT[(32 + i0) * 65 + j] = -t0; MT[(48 + i0) * 65 + j] = -t1;
            { const float bj = beta[j], ej = eg[j];
              *(LAS bf16_t*)(lds + T1_OFF + (32 + i0) * 144 + j * 2) = f2bf(-t0 * bj); *(LAS bf16_t*)(lds + T2_OFF + (32 + i0) * 144 + j * 2) = f2bf(t0 * bj * ej);
              *(LAS bf16_t*)(lds + T1_OFF + (48 + i0) * 144 + j * 2) = f2bf(-t1 * bj); *(LAS bf16_t*)(lds + T2_OFF + (48 + i0) * 144 + j * 2) = f2bf(t1 * bj * ej); }
#pragma unroll 1
            for (int q = 0; q < 6; ++q) { const int idx = tid + NTHR * q; int i, jj;
                if (idx < 2048) { i = idx >> 6; jj = idx & 63; } else { const int r2 = idx - 2048; i = 32 + (r2 >> 5); jj = 32 + (r2 & 31); }
                const float tv = MT[i * 65 + jj] * beta[jj];
                *(LAS bf16_t*)(lds + T1_OFF + i * 144 + jj * 2) = f2bf(tv); *(LAS bf16_t*)(lds + T2_OFF + i * 144 + jj * 2) = f2bf(-tv * eg[jj]); }
        }
        __syncthreads();
#ifdef DN_DUP_SOLVE
        }
#endif
        f32x16 accU, accW;
#pragma unroll
        for (int r = 0; r < 16; ++r) { accU[r] = 0.f; accW[r] = 0.f; }
#pragma unroll
        for (int ks = 0; ks < 4; ++ks) { const int kb = (ks * 16 + hi * 8) * 2;
            accU = DN_MFMA(ldf(lds + T1_OFF, 32 * wr + r32, 144, kb), ldf(lds + VT_OFF, 32 * wc + r32, 144, kb), accU);
            accW = DN_MFMA(ldf(lds + T2_OFF, 32 * wr + r32, 144, kb), ldf(lds + KT_OFF, 32 * wc + r32, 144, kb), accW); }
#pragma unroll
        for (int r = 0; r < 16; ++r) *(LAS bf16_t*)(lds + KC_OFF + (32 * wr + crow(r, hi)) * 272 + (32 * wc + r32) * 2) = f2bf(accW[r]);
        __syncthreads();
#ifdef DN_PF_EARLY
        if (n + 1 < 64) DN_LOADC(n + 1);
#endif
        f32x16 accQ;
#pragma unroll
        for (int r = 0; r < 16; ++r) accQ[r] = 0.f;
#if DN_STAGE >= 5
#pragma unroll 2
        for (int ks = 0; ks < 8; ++ks) { const int kb = (ks * 16 + hi * 8) * 2;
            const bf16x8 bs = ldf(lds + ST_OFF, 32 * wc + r32, 272, kb);
            accU = DN_MFMA(ldf(lds + KC_OFF, 32 * wr + r32, 272, kb), bs, accU);
            accQ = DN_MFMA(ldf(lds + QC_OFF, 32 * wr + r32, 272, kb), bs, accQ); }
#pragma unroll
        for (int rg = 0; rg < 4; ++rg) { const int c0 = 32 * wr + 8 * rg + 4 * hi, e = 32 * wc + r32;
            const f32x4 sc = *(const LAS f32x4*)(ekl + c0);
            u32x2 w1, w2; w1.x = cvt_pk_bf16(accU[4 * rg], accU[4 * rg + 1]); w1.y = cvt_pk_bf16(accU[4 * rg + 2], accU[4 * rg + 3]);
            w2.x = cvt_pk_bf16(accU[4 * rg] * sc.x, accU[4 * rg + 1] * sc.y); w2.y = cvt_pk_bf16(accU[4 * rg + 2] * sc.z, accU[4 * rg + 3] * sc.w);
            *(LAS u32x2*)(lds + VN_OFF + e * 144 + c0 * 2) = w1; *(LAS u32x2*)(lds + VNS_OFF + e * 144 + c0 * 2) = w2; }
#else
        accQ = accU;
#endif
        __syncthreads();
#ifndef DN_PF_EARLY
        if (n + 1 < 64) DN_LOADC(n + 1);
#endif
#if DN_STAGE >= 6
#pragma unroll
        for (int r = 0; r < 16; ++r) accQ[r] *= SCALE * eg[32 * wr + crow(r, hi)];
#pragma unroll
        for (int ks = 0; ks < 4; ++ks) { const int kb = (ks * 16 + hi * 8) * 2;
            accQ = DN_MFMA(ldf(lds + AT_OFF, 32 * wr + r32, 144, kb), ldf(lds + VN_OFF, 32 * wc + r32, 144, kb), accQ); }
#endif
#pragma unroll
        for (int r = 0; r < 16; ++r) { const int c = 32 * wr + crow(r, hi);
            *(LAS bf16_t*)(lds + MT_OFF + c * 256 + (32 * wc + r32) * 2) = f2bf(accQ[r]); }
#if DN_STAGE >= 7
        {
            const float egl = scal[0];
#pragma unroll
            for (int r = 0; r < 16; ++r) { accS[0][r] *= egl; accS[1][r] *= egl; }
#pragma unroll
            for (int ks = 0; ks < 4; ++ks) { const int kb = (ks * 16 + hi * 8) * 2;
                const bf16x8 bsn = ldf(lds + VNS_OFF, 32 * wc + r32, 144, kb);
                accS[0] = DN_MFMA(ldf(lds + KT_OFF, 64 * wr + r32, 144, kb), bsn, accS[0]);
                accS[1] = DN_MFMA(ldf(lds + KT_OFF, 64 * wr + 32 + r32, 144, kb), bsn, accS[1]); }
#pragma unroll
            for (int mb = 0; mb < 2; ++mb)
#pragma unroll
                for (int rg = 0; rg < 4; ++rg) { const int d0 = 64 * wr + 32 * mb + 8 * rg + 4 * hi, e = 32 * wc + r32;
                    u32x2 w1; w1.x = cvt_pk_bf16(accS[mb][4 * rg], accS[mb][4 * rg + 1]); w1.y = cvt_pk_bf16(accS[mb][4 * rg + 2], accS[mb][4 * rg + 3]);
                    *(LAS u32x2*)(lds + ST_OFF + e * 272 + d0 * 2) = w1; }
        }
#endif
        __syncthreads();
#pragma unroll
        for (int i = 0; i < 2; ++i) { const int idx = tid + NTHR * i, c = idx >> 4, e8 = (idx & 15) * 8, p = 64 * n + c, l = dir ? SEQ - 1 - p : p;
            const unsigned oo = ((unsigned)(b * SEQ + l) * 1024u + (unsigned)(h * 128 + e8)) * 2u;
            *(u32x4*)((char*)O + oo) = *(const LAS u32x4*)(lds + MT_OFF + c * 256 + e8 * 2); }
    }
#undef DN_LOADC
}
}
namespace gm {
constexpr int WS_OFF = 0, VT_OFF = 34816, ST_OFF = 69632, SL_OFF = 70656, LN_OFF = 138240;
static_assert(LN_OFF + 16384 <= LDS_BYTES - 64, "gmlp LDS map");
struct Args { const bf16_t* P1; const float* ln_g; const float* ln_b; const float* ws; const float* bs; bf16_t* Z; const float* VST; };
__device__ __forceinline__ void unit(const Args& a, int cu, LAS unsigned char* lds) {
    int tid = threadIdx.x; asm volatile("" : "+v"(tid));
    const int w = __builtin_amdgcn_readfirstlane(tid >> 6), lane = tid & 63, r32 = lane & 31, hi = lane >> 5, wr = w >> 2, wc = w & 3;
    const int t0 = cu * 128;
    LAS float* mean = (LAS float*)(lds + ST_OFF); LAS float* rstd = mean + 128; LAS float* SL = (LAS float*)(lds + SL_OFF);
    LAS float* LG = (LAS float*)(lds + LN_OFF); LAS float* LB = LG + 2048;
    f32x4 pw[8]; u32x4 pvv[4], pu[4], pg[4];
#define GM_LOAD_WV(g_) do { _Pragma("unroll") for (int i_ = 0; i_ < 8; ++i_) { const int idx_ = tid + NTHR * i_; pw[i_] = *(const f32x4*)(a.ws + (size_t)(g_) * 16384 + idx_ * 4); } \
        _Pragma("unroll") for (int i_ = 0; i_ < 4; ++i_) { const int idx_ = tid + NTHR * i_, s_ = idx_ & 127, c8_ = (idx_ >> 7) * 8; \
            pvv[i_] = *(const u32x4*)((const char*)a.P1 + (unsigned)(((t0 + s_) * N1 + 2048 + (g_) * 128 + c8_) * 2)); } } while (0)
#define GM_LOAD_UG(g_) do { _Pragma("unroll") for (int i_ = 0; i_ < 4; ++i_) { const int idx_ = tid + NTHR * i_, t_ = idx_ >> 4, c8_ = (idx_ & 15) * 8; \
            const char* pr_ = (const char*)a.P1 + (unsigned)(((t0 + t_) * N1 + (g_) * 128 + c8_) * 2); pu[i_] = *(const u32x4*)pr_; pg[i_] = *(const u32x4*)(pr_ + 8192); } } while (0)
    __syncthreads();
    GM_LOAD_WV(0);
    for (int i = tid; i < 512; i += NTHR) { *(LAS f32x4*)(LG + i * 4) = *(const f32x4*)(a.ln_g + i * 4); *(LAS f32x4*)(LB + i * 4) = *(const f32x4*)(a.ln_b + i * 4); }
    { typedef float f32x2v __attribute__((ext_vector_type(2))); f32x2v pr[16];
#pragma unroll
      for (int q = 0; q < 16; ++q) pr[q] = (lane < 32) ? *(const f32x2v*)(a.VST + ((size_t)(t0 + w * 16 + q) * 32 + lane) * 2) : (f32x2v){0.f, 0.f};
#pragma unroll
      for (int q = 0; q < 16; ++q) { const float S1 = wave_sum(pr[q].x), S2 = wave_sum(pr[q].y); const float mu = S1 * (1.f / 2048.f);
          const float var = fmaxf(S2 * (1.f / 2048.f) - mu * mu, 0.f); if (lane == 0) { mean[w * 16 + q] = mu; rstd[w * 16 + q] = 1.0f / sqrtf(var + EPS); } } }
    __syncthreads();
    for (int g = 0; g < 16; ++g) {
#ifndef GM_UG_LATE
        GM_LOAD_UG(g);
#endif
#pragma unroll
        for (int i = 0; i < 8; ++i) { const int idx = tid + NTHR * i, t = idx >> 5, s4 = (idx & 31) * 4;
            u32x2 o; o.x = cvt_pk_bf16(pw[i].x, pw[i].y); o.y = cvt_pk_bf16(pw[i].z, pw[i].w); *(LAS u32x2*)(lds + WS_OFF + t * 272 + s4 * 2) = o; }
#pragma unroll
        for (int i = 0; i < 4; ++i) { const int idx = tid + NTHR * i, s = idx & 127, c8 = (idx >> 7) * 8; float x[8];
            unpack8(pvv[i], x);
            const float mu = mean[s], rs = rstd[s];
            const f32x4 g0 = *(const LAS f32x4*)(LG + g * 128 + c8), g1 = *(const LAS f32x4*)(LG + g * 128 + c8 + 4), b0 = *(const LAS f32x4*)(LB + g * 128 + c8), b1 = *(const LAS f32x4*)(LB + g * 128 + c8 + 4);
            const float gg[8] = {g0.x, g0.y, g0.z, g0.w, g1.x, g1.y, g1.z, g1.w}, bb[8] = {b0.x, b0.y, b0.z, b0.w, b1.x, b1.y, b1.z, b1.w};
#pragma unroll
            for (int j = 0; j < 8; ++j) *(LAS bf16_t*)(lds + VT_OFF + (c8 + j) * 272 + s * 2) = f2bf((x[j] - mu) * rs * gg[j] + bb[j]); }
        __syncthreads();
        if (g + 1 < 16) GM_LOAD_WV(g + 1);
#ifdef GM_UG_LATE
        GM_LOAD_UG(g);
#endif
        f32x16 acc[2];
#pragma unroll
        for (int r = 0; r < 16; ++r) { acc[0][r] = 0.f; acc[1][r] = 0.f; }
#pragma unroll
        for (int ks = 0; ks < 8; ++ks) { const int kb = (ks * 16 + hi * 8) * 2;
            const bf16x8 bv = *(const LAS bf16x8*)(lds + VT_OFF + (32 * wc + r32) * 272 + kb);
            acc[0] = __builtin_amdgcn_mfma_f32_32x32x16_bf16(*(const LAS bf16x8*)(lds + WS_OFF + (64 * wr + r32) * 272 + kb), bv, acc[0], 0, 0, 0);
            acc[1] = __builtin_amdgcn_mfma_f32_32x32x16_bf16(*(const LAS bf16x8*)(lds + WS_OFF + (64 * wr + 32 + r32) * 272 + kb), bv, acc[1], 0, 0, 0); }
#pragma unroll
        for (int mb = 0; mb < 2; ++mb) { const float* bsp = a.bs + g * 128 + 64 * wr + 32 * mb + 4 * hi;
#pragma unroll
            for (int r = 0; r < 16; ++r) { const int t = 64 * wr + 32 * mb + crow(r, hi);
                SL[t * 132 + 32 * wc + r32] = acc[mb][r] + bsp[(r & 3) + 8 * (r >> 2)]; } }
        __syncthreads();
#pragma unroll
        for (int i = 0; i < 4; ++i) { const int idx = tid + NTHR * i, t = idx >> 4, c8 = (idx & 15) * 8, col = g * 128 + c8; float uu[8], gt[8];
            unpack8(pu[i], uu); unpack8(pg[i], gt);
            const f32x4 s0 = *(const LAS f32x4*)(SL + t * 132 + c8), s1 = *(const LAS f32x4*)(SL + t * 132 + c8 + 4);
            const float sv[8] = {s0.x, s0.y, s0.z, s0.w, s1.x, s1.y, s1.z, s1.w};
#pragma unroll
            for (int e = 0; e < 8; ++e) uu[e] = uu[e] * sv[e] * silu_f(gt[e]);
            *(u32x4*)((char*)a.Z + (unsigned)(((t0 + t) * DM + col) * 2)) = pack8(uu); }
    }
#undef GM_LOAD_WV
#undef GM_LOAD_UG
}
}

struct KArgs { const float* in[17]; float* out; unsigned char* ws; int ph_lo, ph_hi; };
#ifndef PROBE_END
#define PROBE_END 10
#endif
#ifndef DUMP_OFF
#define DUMP_OFF 0
#define DUMP_N 0
#endif
#ifndef DUP_PHASE
#define DUP_PHASE -1
#endif
#ifndef DUP_N
#define DUP_N 2
#endif
#define REPS(k) for (int rep_ = 0; rep_ < ((DUP_PHASE == (k)) ? DUP_N : 1); ++rep_)
#define REPSYNC(k) do { if (DUP_PHASE == (k) && rep_ + 1 < DUP_N) cg::this_grid().sync(); } while (0)
#ifndef PG_ALIGN59
#define PG_ALIGN59 true
#endif
#ifndef PG_ALIGN17
#define PG_ALIGN17 true
#endif
constexpr int NPHASES = 10;
__global__ void __launch_bounds__(NTHR, 2) fwd_megakernel(KArgs A) {
    __builtin_assume(__builtin_amdgcn_workitem_id_y() == 0); __builtin_assume(__builtin_amdgcn_workitem_id_z() == 0);
    extern __shared__ __attribute__((aligned(16))) unsigned char lds_raw[];
    LAS unsigned char* lds = (LAS unsigned char*)lds_raw;
    const int tid = threadIdx.x, lane = tid & 63, wave = __builtin_amdgcn_readfirstlane(tid >> 6);
    const int G = gridDim.x, bx = blockIdx.x, gw = bx * NWAVES + wave, NGW = G * NWAVES;
    unsigned char* ws = A.ws;
    const float* x = A.in[0];
    bf16_t* W0T = (bf16_t*)(ws + WS_W0T); bf16_t* WO0T = (bf16_t*)(ws + WS_WO0T); bf16_t* W1T = (bf16_t*)(ws + WS_W1T); bf16_t* WO1T = (bf16_t*)(ws + WS_WO1T);
    bf16_t* H = (bf16_t*)(ws + WS_H); bf16_t* PROJ = (bf16_t*)(ws + WS_PROJ); float* LOG = (float*)(ws + WS_LOG); bf16_t* QKV = (bf16_t*)(ws + WS_QKV); bf16_t* YCAT = (bf16_t*)(ws + WS_YCAT);
    bf16_t* OF = H; bf16_t* OB = H + (size_t)TOK * 1024; float* PART = (float*)(ws + WS_PART); float* RSTD = (float*)(ws + WS_RSTD);
    const int lo = A.ph_lo, hi = A.ph_hi;
#ifndef PHMASK
#define PHMASK 0x3ff
#endif
#define IN(k) (((PHMASK >> (k)) & 1) && lo <= (k) && (k) < hi)
#define SEAM(k) do { if (IN(k) && IN((k) + 1)) { cg::this_grid().sync(); } } while (0)
    if (IN(0)) REPS(0) { P0Args p{x, A.in[1], A.in[10], A.in[2], A.in[9], A.in[11], A.in[16], W0T, WO0T, W1T, WO1T, H}; p0_prologue(p, lds, gw, NGW, wave, lane); __syncthreads(); REPSYNC(0); }
    SEAM(0);
    if (IN(1)) REPS(1) { { pg8::Gemm g{H, W0T, TOK, P0LD, DM, DM}; pg8::StaticOrder S; S.init(TOK, P0LD, G, bx); pg8::Epi0 E{PROJ, LOG};
            pg8::gemm_phase<pg8::Epi0, pg8::StaticOrder, PG_ALIGN17, true>(lds, g, S, E); }
        for (int hu = bx; hu < 2 * (TOK / 256); hu += G) { const int kh = hu & 1;
            pg8::Gemm g{H + kh * (DM / 2), W0T + (size_t)P0LD * DM + kh * (DM / 2), TOK, 256, DM / 2, DM}; pg8::OneUnit S{hu >> 1}; pg8::EpiLog E{LOG + (size_t)kh * TOK * 32};
            pg8::gemm_phase<pg8::EpiLog, pg8::OneUnit, true, true>(lds, g, S, E); }
        REPSYNC(1); }
    SEAM(1);
    if (IN(2)) {
        REPS(2) { for (int it = gw; it < (TOK / 16) * 6; it += NGW) p2_conv_item(PROJ, A.in[3], QKV, it, lane); REPSYNC(2); }
        for (int t = gw; t < TOK; t += 2 * NGW) p2_rope_tokens<2>(PROJ, A.in[7], A.in[8], t, NGW, lane);
    }
    SEAM(2);
    if (IN(3)) REPS(3) {
        const int nq = 1, qx = 0, DNQ = 128 / nq, ATQ = 1024 / nq;
        int* ctr = (int*)(ws + WS_CTL) + 16 * qx + 128 * rep_; LAS int* slot = (LAS int*)(lds + LDS_BYTES - 16);
        int* dn_done = (int*)(ws + WS_CTL) + 512 + 64 * rep_; int* p4ctr = (int*)(ws + WS_CTL) + 768 + 64 * rep_;
#define FETCH4(item) do { __syncthreads(); if (tid == 0) *slot = atomicAdd(p4ctr, 1); __syncthreads(); item = __builtin_amdgcn_readfirstlane(*slot); } while (0)
        dn::Args da{QKV, LOG, A.in[4], A.in[5], OF, OB};
#define FETCH(item) do { __syncthreads(); if (tid == 0) *slot = atomicAdd(ctr, 1); __syncthreads(); item = __builtin_amdgcn_readfirstlane(*slot); } while (0)
        int item;
#if DUP_PHASE == 31
        for (int r31 = 0; r31 < DUP_N - 1; ++r31) { int* ctr0 = ctr; ctr = (int*)(ws + WS_CTL) + 128 + 64 * r31; FETCH(item); while (item < 128) { dn::unit(da, item, lds); FETCH(item); } ctr = ctr0; cg::this_grid().sync(); }
#endif
#if DUP_PHASE == 32
        { int* ctr0 = ctr; ctr = (int*)(ws + WS_CTL) + 128; FETCH(item); item += 128;
          while (item < DNQ + ATQ) { const int ai = qx * ATQ + (item - DNQ), qb = ai & 15, gq = (ai >> 4) & 3, kvh = (ai >> 6) & 1, b = ai >> 7, h = kvh * 4 + gq;
            const size_t r0 = (size_t)(b * SEQ + qb * 256);
            att::attn_dense_body(PROJ + r0 * P0LD + C_BQ + h * 128, PROJ + (size_t)(b * SEQ) * P0LD + C_BK + kvh * 128, PROJ + (size_t)(b * SEQ) * P0LD + C_BV + kvh * 128,
                                 PROJ + r0 * P0LD + C_BG + h * 128, YCAT + r0 * DM + 1024 + h * 128, SEQ, (char*)lds_raw);
            FETCH(item); item += 128; }
          ctr = ctr0; cg::this_grid().sync(); }
#endif
        FETCH(item);
#ifndef SKIP_DN
        while (item < DNQ) { dn::unit(da, qx * DNQ + item, lds);
            asm volatile("s_waitcnt vmcnt(0)" ::: "memory");
            __syncthreads(); if (tid == 0) { __threadfence(); atomicAdd(dn_done, 1); }
            FETCH(item); }
#endif
#ifndef SKIP_ATT
        while (item < DNQ + ATQ) { const int ai = qx * ATQ + (item - DNQ), qb = ai & 15, gq = (ai >> 4) & 3, kvh = (ai >> 6) & 1, b = ai >> 7, h = kvh * 4 + gq;
            const size_t r0 = (size_t)(b * SEQ + qb * 256);
            att::attn_dense_body(PROJ + r0 * P0LD + C_BQ + h * 128, PROJ + (size_t)(b * SEQ) * P0LD + C_BK + kvh * 128, PROJ + (size_t)(b * SEQ) * P0LD + C_BV + kvh * 128,
                                 PROJ + r0 * P0LD + C_BG + h * 128, YCAT + r0 * DM + 1024 + h * 128, SEQ, (char*)lds_raw);
            FETCH(item); }
#endif
        if (tid == 0) { while (__hip_atomic_load(dn_done, __ATOMIC_RELAXED, __HIP_MEMORY_SCOPE_AGENT) < 128) __builtin_amdgcn_s_sleep(16);
            __threadfence(); }
        __syncthreads();
        for (;;) { int c4; FETCH4(c4); if (c4 >= TOK / 128) break;
            for (int q = 0; q < 16; q += 4) p4_tokens<4>(OF, OB, PROJ, A.in[6], YCAT, c4 * 128 + wave * 16 + q, lane); }
        REPSYNC(3);
    }
    SEAM(3);
    if (IN(5)) REPS(5) { pg8::Gemm g{YCAT, WO0T, TOK, DM, DM, DM}; pg8::StaticOrder S; S.init(TOK, DM, G, bx); pg8::EpiRes0 E{x, H, PART};
        pg8::gemm_phase<pg8::EpiRes0, pg8::StaticOrder, PG_ALIGN59, true>(lds, g, S, E); REPSYNC(5); }
    SEAM(5);
    if (IN(6)) REPS(6) { for (int r = bx * NTHR + tid; r < TOK; r += G * NTHR) { const f32x4* pp = (const f32x4*)(PART + (size_t)r * 32); float ss = 0.f;
#pragma unroll
            for (int j = 0; j < 8; ++j) { const f32x4 v = pp[j]; ss += (v.x + v.y) + (v.z + v.w); }
            RSTD[r] = 1.0f / sqrtf(ss * (1.f / DM) + EPS); } REPSYNC(6); }
    SEAM(6);
    if (IN(7)) REPS(7) { pg8::Gemm g{H, W1T, TOK, N1, DM, DM}; pg8::StaticOrder S; S.init(TOK, N1, G, bx); pg8::Epi1 E{PROJ, RSTD, (float*)(ws + WS_VST)};
        pg8::gemm_phase<pg8::Epi1, pg8::StaticOrder, PG_ALIGN17, true>(lds, g, S, E); REPSYNC(7); }
    SEAM(7);
    if (IN(8)) REPS(8) { gm::Args ga{PROJ, A.in[12], A.in[13], A.in[14], A.in[15], YCAT, (const float*)(ws + WS_VST)};
        for (int cu = bx; cu < TOK / 128; cu += G) gm::unit(ga, cu, lds); REPSYNC(8); }
    SEAM(8);
    if (IN(9)) { pg8::Gemm g{YCAT, WO1T, TOK, DM, DM, DM}; pg8::StaticOrder S; S.init(TOK, DM, G, bx); pg8::EpiRes1 E{H, A.out};
        pg8::gemm_phase<pg8::EpiRes1, pg8::StaticOrder, PG_ALIGN59, true>(lds, g, S, E); }
#if PROBE_END < 10
    if (lo <= 10 && 10 < hi) { const bf16_t* src = (const bf16_t*)(ws + (size_t)DUMP_OFF); const size_t n = (size_t)DUMP_N, NO = (size_t)TOK * DM;
        for (size_t i = (size_t)bx * NTHR + tid; i < NO; i += (size_t)G * NTHR) { float acc = 0.f; for (size_t k = i; k < n; k += NO) { float v = bf2f(src[k]); if (!(fabsf(v) < 1e30f)) v = 7777.f; acc += v; } A.out[i] = acc; } }
#endif
}

extern "C" void kernel_launch(void* const* d_in, const int* in_sizes, int n_in, void* d_out, int out_size, void* d_ws, size_t ws_size, hipStream_t stream) {
    static int grid = 0;
    if (grid == 0) {
        if (n_in != 17 || in_sizes[0] != TOK * DM || out_size != TOK * DM || ws_size < WS_END) { fprintf(stderr, "kernel_launch: shape/workspace mismatch (n_in %d, ws %zu < %zu)\n", n_in, ws_size, (size_t)WS_END); grid = -1; return; }
        int dev = 0, cus = 0, per_cu = 0;
        (void)hipGetDevice(&dev); (void)hipDeviceGetAttribute(&cus, hipDeviceAttributeMultiprocessorCount, dev);
        if (hipFuncSetAttribute((const void*)fwd_megakernel, hipFuncAttributeMaxDynamicSharedMemorySize, LDS_BYTES) != hipSuccess) { fprintf(stderr, "hipFuncSetAttribute failed\n"); grid = -1; return; }
        if (hipOccupancyMaxActiveBlocksPerMultiprocessor(&per_cu, (const void*)fwd_megakernel, NTHR, LDS_BYTES) != hipSuccess || per_cu < 1) per_cu = 1;
        grid = cus * per_cu;
        fprintf(stderr, "kernel_launch: grid %d (%d CUs x %d)\n", grid, cus, per_cu);
    }
    if (grid < 0) return;
    (void)hipMemsetAsync((char*)d_ws + WS_CTL, 0, 4096, stream);
    KArgs a{};
    for (int i = 0; i < 17; ++i) a.in[i] = (const float*)d_in[i];
    a.out = (float*)d_out; a.ws = (unsigned char*)d_ws;
#if MK_LAUNCHES == 1
    a.ph_lo = 0; a.ph_hi = NPHASES;
    void* args[] = {&a};
    hipError_t e = hipLaunchCooperativeKernel((void*)fwd_megakernel, dim3(grid), dim3(NTHR), args, LDS_BYTES, stream);
    if (e != hipSuccess) fprintf(stderr, "cooperative launch failed: %s (grid %d)\n", hipGetErrorString(e), grid);
#else
    for (int p = 0; p < PROBE_END; ++p) { a.ph_lo = p; a.ph_hi = p + 1; hipLaunchKernelGGL(fwd_megakernel, dim3(grid), dim3(NTHR), LDS_BYTES, stream, a); }
#if PROBE_END < 10
    a.ph_lo = 10; a.ph_hi = 11; hipLaunchKernelGGL(fwd_megakernel, dim3(grid), dim3(NTHR), LDS_BYTES, stream, a);
#endif
#endif
}
```

```cpp
#include <hip/hip_runtime.h>
#include <hip/hip_cooperative_groups.h>
#include <cstdio>
#include <cstdint>
namespace cg = cooperative_groups;
#ifndef MK_LAUNCHES
#define MK_LAUNCHES 1
#define DUP_PHASE -1

#endif
namespace pg8 {
#define PG8_LAS __attribute__((address_space(3)))
typedef unsigned short bf16_t;
typedef short bf16x8 __attribute__((ext_vector_type(8)));
typedef float f32x4 __attribute__((ext_vector_type(4)));
typedef unsigned u32x4 __attribute__((ext_vector_type(4)));
constexpr int BM = 256, BK = 64, HALF = 128, HTB = HALF * BK * 2  , STAGE_BYTES = 8 * HTB, NXCD = 8, WGM = 4;

__host__ __device__ __forceinline__ int lds_byte(int r, int c) { const int st = (r >> 4) * 2 + (c >> 5), rr = r & 15, cc = c & 31, ob = rr * 64 + cc * 2; return st * 1024 + (ob ^ (((ob >> 9) & 1) << 5)); }
__host__ __device__ __forceinline__ void stage_rc(int b, int& R, int& C) { const int st = b / 1024, sb = b % 1024, swz = sb ^ (((sb >> 9) & 1) << 5); R = (st >> 1) * 16 + swz / 64; C = (st & 1) * 32 + (swz % 64) / 2; }
__host__ __device__ __forceinline__ int perm32(int rho) { const int n = rho >> 4, i = rho & 15; return 8 * (i >> 2) + 4 * n + (i & 3); }

struct Unit { int pm, pn; };
struct Gemm { const bf16_t* A; const bf16_t* Bt; int M, N, K, ld; };

struct StaticOrder {
    int nM, nN, nwg, G, c;
    __host__ __device__ void init(int M, int N, int G_, int c_) { nM = M / BM; nN = N / BM; nwg = nM * nN; G = G_; c = c_; }
    __host__ __device__ bool next(int i, Unit& u) const {
        const long L = (long)i * G + c; if (L >= nwg) return false;
        int wgid = (int)L; { const int q = nwg / NXCD, r = nwg % NXCD, xcd = wgid % NXCD, off = wgid / NXCD; wgid = (xcd < r ? xcd * (q + 1) : r * (q + 1) + (xcd - r) * q) + off; }
        const int nig = WGM * nN, gid = wgid / nig, fm = gid * WGM, gsz = (nM - fm) < WGM ? (nM - fm) : WGM;
        u.pm = fm + ((wgid % nig) % gsz); u.pn = (wgid % nig) / gsz; return true;
    }
    __device__ __forceinline__ void a_ready(const Unit&) const {}
    __device__ __forceinline__ void done(const Unit&) const {}
};

typedef float f32x2c_t __attribute__((ext_vector_type(2))); typedef __bf16 bf16x2c_t __attribute__((ext_vector_type(2)));
__device__ __forceinline__ unsigned cvt_pk_bf16(float lo, float hi) { f32x2c_t v = {lo, hi}; bf16x2c_t b = __builtin_convertvector(v, bf16x2c_t); return __builtin_bit_cast(unsigned, b); }
typedef float f32x2 __attribute__((ext_vector_type(2)));
__device__ __forceinline__ f32x2 gelu_pk(f32x2 v) {
    const f32x2 av = __builtin_elementwise_abs(v), d = av * 0.2316418882f + 1.0f;
    f32x2 t; t.x = __builtin_amdgcn_rcpf(d.x); t.y = __builtin_amdgcn_rcpf(d.y);
    f32x2 q = t * 0.5307027145f + (-0.7265760135f); q = q * t + 0.7107068705f; q = q * t + (-0.142248368f); q = q * t + 0.127414796f; q = q * t;
    const f32x2 s = (v * v) * (-0.72134752044f);
    f32x2 e; e.x = __builtin_amdgcn_exp2f(s.x); e.y = __builtin_amdgcn_exp2f(s.y);
    const f32x2 m = v * (q * e), r = v - m;
    f32x2 o; o.x = v.x < 0.f ? m.x : r.x; o.y = v.y < 0.f ? m.y : r.y; return o;
}

template <class Epi, class Sched, bool ALIGN_EPI = false, bool SP2 = false>
__device__ __forceinline__ void gemm_phase(PG8_LAS unsigned char* lds, const Gemm g, const Sched& S, const Epi& E) {
    const int tid = threadIdx.x, wid = __builtin_amdgcn_readfirstlane(tid >> 6), lane = tid & 63, wr = wid >> 2, wc = wid & 3, fr = lane & 15, fq = lane >> 4;
    const int K = g.ld, nt = g.K / BK;
    unsigned voffA[2], voffB[2];
#pragma unroll
    for (int i = 0; i < 2; ++i) { int R, C; stage_rc(tid * 16 + i * 8192, R, C); const int Rb = Epi::PERM ? ((R & ~31) + perm32(R & 31)) : R;
        voffA[i] = (unsigned)(R * K + C) * 2u; voffB[i] = (unsigned)(Rb * K + C) * 2u; }
    const size_t kstep = (size_t)(BK * 2);
    const size_t hstep = (size_t)HALF * K * 2;
    const size_t tstep = 2 * hstep;
    const unsigned ldsw = (unsigned)wid * 1024u;
    const int aoff = lds_byte(wr * 64 + fr, fq * 8), boff = lds_byte(wc * 32 + fr, fq * 8);
#define PG8_SA(b, h) (((b) * 2 + (h)) * HTB)
#define PG8_SB(b, h) ((4 + (b) * 2 + (h)) * HTB)
#define PG8_STAGE(bufoff, gbase, voff) do { _Pragma("unroll") for (int _i = 0; _i < 2; ++_i) \
        __builtin_amdgcn_global_load_lds((const unsigned*)((const char*)(gbase) + (voff)[_i]), (PG8_LAS unsigned*)(lds + (bufoff) + ldsw + _i * 8192), 16, 0, 0); } while (0)
#define PG8_LDA(dst, b, h) do { _Pragma("unroll") for (int m = 0; m < 4; ++m) _Pragma("unroll") for (int k = 0; k < 2; ++k) dst[m][k] = *(const PG8_LAS bf16x8*)(lds + PG8_SA(b, h) + aoff + m * 2048 + k * 1024); } while (0)
#define PG8_LDB(dst, b, h) do { _Pragma("unroll") for (int n = 0; n < 2; ++n) _Pragma("unroll") for (int k = 0; k < 2; ++k) dst[n][k] = *(const PG8_LAS bf16x8*)(lds + PG8_SB(b, h) + boff + n * 2048 + k * 1024); } while (0)
#define PG8_MMA(ai, bj, At, Bt) do { __builtin_amdgcn_s_setprio(1); _Pragma("unroll") for (int m = 0; m < 4; ++m) _Pragma("unroll") for (int n = 0; n < 2; ++n) _Pragma("unroll") for (int k = 0; k < 2; ++k) \
        acc[ai][bj][m][n] = __builtin_amdgcn_mfma_f32_16x16x32_bf16(Bt[n][k], At[m][k], acc[ai][bj][m][n], 0, 0, 0); __builtin_amdgcn_s_setprio(0); } while (0)
#define PG8_WAIT_V(n) asm volatile("s_waitcnt vmcnt(" #n ")" ::: "memory")
#define PG8_WAIT_L(n) asm volatile("s_waitcnt lgkmcnt(" #n ")" ::: "memory")
#define PG8_BAR __builtin_amdgcn_s_barrier()
#define PG8_SCHED __builtin_amdgcn_sched_barrier(0)
    Unit cur, nxt; int ui = 0;
    if (!S.next(0, cur)) return;
    f32x4 acc[2][2][4][2];
#pragma unroll
    for (int a = 0; a < 2; ++a)
#pragma unroll
        for (int b = 0; b < 2; ++b)
#pragma unroll
            for (int m = 0; m < 4; ++m)
#pragma unroll
                for (int n = 0; n < 2; ++n) acc[a][b][m][n] = (f32x4){0.f, 0.f, 0.f, 0.f};
    bf16x8 At[4][2], B0[2][2], B1[2][2];
    const char* cA = (const char*)g.A + (size_t)cur.pm * tstep; const char* cB = (const char*)g.Bt + (size_t)cur.pn * tstep;
    S.a_ready(cur);
    if constexpr (SP2) {
        PG8_STAGE(PG8_SB(0, 0), cB, voffB); PG8_STAGE(PG8_SB(0, 1), cB + hstep, voffB); PG8_STAGE(PG8_SA(0, 0), cA, voffA); PG8_STAGE(PG8_SA(0, 1), cA + hstep, voffA);
        if (wr == 1) PG8_BAR;
        PG8_WAIT_V(2); PG8_BAR;
        PG8_STAGE(PG8_SB(1, 0), cB + kstep, voffB); PG8_STAGE(PG8_SA(1, 0), cA + kstep, voffA); PG8_STAGE(PG8_SB(1, 1), cB + hstep + kstep, voffB);
        PG8_WAIT_V(6); PG8_BAR;
    } else {
        PG8_STAGE(PG8_SB(0, 0), cB, voffB); PG8_STAGE(PG8_SA(0, 0), cA, voffA); PG8_STAGE(PG8_SB(0, 1), cB + hstep, voffB); PG8_STAGE(PG8_SA(0, 1), cA + hstep, voffA);
        if (wr == 1) PG8_BAR;
        PG8_WAIT_V(4); PG8_BAR;
        PG8_STAGE(PG8_SB(1, 0), cB + kstep, voffB); PG8_STAGE(PG8_SA(1, 0), cA + kstep, voffA); PG8_STAGE(PG8_SB(1, 1), cB + hstep + kstep, voffB);
        PG8_WAIT_V(6); PG8_BAR;
    }
    for (;;) {
        const bool has_next = S.next(ui + 1, nxt);
        const char* nA = has_next ? (const char*)g.A + (size_t)nxt.pm * tstep : cA; const char* nB = has_next ? (const char*)g.Bt + (size_t)nxt.pn * tstep : cB;
        for (int t = 0; t < nt; t += 2) {
            const bool last = (t == nt - 2);
            const char* a1 = cA + (size_t)(t + 1) * kstep;
            const char* a2 = last ? nA : cA + (size_t)(t + 2) * kstep; const char* b2 = last ? nB : cB + (size_t)(t + 2) * kstep;
            const char* a3 = a2 + kstep; const char* b3 = b2 + kstep;
            if (last && has_next) S.a_ready(nxt);
            if constexpr (SP2) {
            PG8_LDB(B0, 0, 0); PG8_LDB(B1, 0, 1); PG8_SCHED; PG8_LDA(At, 0, 0); PG8_STAGE(PG8_SA(1, 1), a1 + hstep, voffA);
            PG8_WAIT_V(8); PG8_WAIT_L(0); PG8_BAR; PG8_MMA(0, 0, At, B0); PG8_MMA(0, 1, At, B1); PG8_BAR; PG8_SCHED;
            PG8_LDA(At, 0, 1); PG8_STAGE(PG8_SB(0, 0), b2, voffB); PG8_STAGE(PG8_SB(0, 1), b2 + hstep, voffB); PG8_STAGE(PG8_SA(0, 0), a2, voffA);
            PG8_WAIT_V(8); PG8_WAIT_L(0); PG8_BAR; PG8_MMA(1, 0, At, B0); PG8_MMA(1, 1, At, B1); PG8_BAR; PG8_SCHED;
            PG8_LDB(B0, 1, 0); PG8_LDB(B1, 1, 1); PG8_SCHED; PG8_LDA(At, 1, 0); PG8_STAGE(PG8_SA(0, 1), a2 + hstep, voffA);
            PG8_WAIT_V(8); PG8_WAIT_L(0); PG8_BAR; PG8_MMA(0, 0, At, B0); PG8_MMA(0, 1, At, B1); PG8_BAR; PG8_SCHED;
            PG8_LDA(At, 1, 1); PG8_STAGE(PG8_SB(1, 0), b3, voffB); PG8_STAGE(PG8_SB(1, 1), b3 + hstep, voffB); PG8_STAGE(PG8_SA(1, 0), a3, voffA);
            PG8_WAIT_V(8); PG8_WAIT_L(0); PG8_BAR; PG8_MMA(1, 0, At, B0); PG8_MMA(1, 1, At, B1); PG8_BAR; PG8_SCHED;
            } else {
            PG8_LDB(B0, 0, 0); PG8_SCHED; PG8_LDA(At, 0, 0); PG8_STAGE(PG8_SA(1, 1), a1 + hstep, voffA);
            PG8_WAIT_L(8); PG8_BAR; PG8_WAIT_L(0); PG8_MMA(0, 0, At, B0); PG8_BAR; PG8_SCHED;
            PG8_LDB(B1, 0, 1); PG8_STAGE(PG8_SB(0, 0), b2, voffB);
            PG8_BAR; PG8_WAIT_L(0); PG8_MMA(0, 1, At, B1); PG8_BAR;
            PG8_LDA(At, 0, 1); PG8_STAGE(PG8_SA(0, 0), a2, voffA);
            PG8_BAR; PG8_WAIT_L(0); PG8_MMA(1, 0, At, B0); PG8_BAR; PG8_SCHED;
            PG8_STAGE(PG8_SB(0, 1), b2 + hstep, voffB);
            PG8_WAIT_V(6); PG8_BAR; PG8_MMA(1, 1, At, B1); PG8_BAR;
            PG8_LDB(B0, 1, 0); PG8_SCHED; PG8_LDA(At, 1, 0); PG8_STAGE(PG8_SA(0, 1), a2 + hstep, voffA);
            PG8_WAIT_L(8); PG8_BAR; PG8_WAIT_L(0); PG8_MMA(0, 0, At, B0); PG8_BAR; PG8_SCHED;
            PG8_LDB(B1, 1, 1); PG8_STAGE(PG8_SB(1, 0), b3, voffB);
            PG8_BAR; PG8_WAIT_L(0); PG8_MMA(0, 1, At, B1); PG8_BAR;
            PG8_LDA(At, 1, 1); PG8_STAGE(PG8_SA(1, 0), a3, voffA);
            PG8_BAR; PG8_WAIT_L(0); PG8_MMA(1, 0, At, B0); PG8_BAR; PG8_SCHED;
            PG8_STAGE(PG8_SB(1, 1), b3 + hstep, voffB);
            PG8_WAIT_V(6); PG8_BAR; PG8_MMA(1, 1, At, B1); PG8_BAR;
            }
        }
        if constexpr (ALIGN_EPI) { if (wr == 0) PG8_BAR; }
        if constexpr (!Epi::AFTER_DRAIN) { E(acc, cur, wr, wc, fr, fq); S.done(cur); }
        if (!has_next) break;
#pragma unroll
        for (int a = 0; a < 2; ++a)
#pragma unroll
            for (int b = 0; b < 2; ++b)
#pragma unroll
                for (int m = 0; m < 4; ++m)
#pragma unroll
                    for (int n = 0; n < 2; ++n) acc[a][b][m][n] = (f32x4){0.f, 0.f, 0.f, 0.f};
        cur = nxt; cA = nA; cB = nB; ++ui;
        if constexpr (ALIGN_EPI) { if (wr == 1) PG8_BAR; }
    }
    PG8_WAIT_V(0);
    if constexpr (!ALIGN_EPI) { if (wr == 0) PG8_BAR; }
    PG8_BAR;
    if constexpr (Epi::AFTER_DRAIN) { E.fused(acc, cur, wr, wc, fr, fq, lds, wid, lane); S.done(cur); }
#undef PG8_SA
#undef PG8_SB
#undef PG8_STAGE
#undef PG8_LDA
#undef PG8_LDB
#undef PG8_MMA
#undef PG8_WAIT_V
#undef PG8_WAIT_L
#undef PG8_BAR
#undef PG8_SCHED
}
}
#define LAS __attribute__((address_space(3)))
typedef unsigned short bf16_t;
typedef short bf16x8 __attribute__((ext_vector_type(8)));
typedef short s16x4 __attribute__((ext_vector_type(4)));
typedef float f32x4 __attribute__((ext_vector_type(4)));
typedef float f32x8 __attribute__((ext_vector_type(8)));
typedef float f32x16 __attribute__((ext_vector_type(16)));
typedef unsigned u32x4 __attribute__((ext_vector_type(4)));
typedef unsigned u32x2 __attribute__((ext_vector_type(2)));
using pg8::cvt_pk_bf16;

constexpr int NB = 8, SEQ = 4096, DM = 2048, TOK = NB * SEQ;
constexpr int N0P = 6912, P0LD = 6656, N1 = 6144;
constexpr int C_AQ = 0, C_AK = 1024, C_AV = 2048, C_AG = 3072, C_BQ = 4096, C_BK = 5120, C_BV = 5376, C_BG = 5632;
constexpr float EPS = 1e-6f;
constexpr int NTHR = 512, NWAVES = 8;
constexpr int LDS_BYTES = 159744;
constexpr size_t WS_CTL = 0;
constexpr size_t WS_CTL_BYTES = 32768;
constexpr size_t WS_BAR = 16384;
constexpr size_t WS_W0T = 32768;
constexpr size_t WS_WO0T = WS_W0T + (size_t)N0P * DM * 2;
constexpr size_t WS_W1T = WS_WO0T + (size_t)DM * DM * 2;
constexpr size_t WS_WO1T = WS_W1T + (size_t)N1 * DM * 2;
constexpr size_t WS_H = WS_WO1T + (size_t)DM * DM * 2;
constexpr size_t WS_PROJ = WS_H + (size_t)TOK * DM * 2;
constexpr size_t WS_LOG = WS_PROJ + (size_t)TOK * P0LD * 2;
constexpr size_t WS_QKV = WS_LOG + (size_t)TOK * 32 * 4 * 2;
constexpr size_t WS_YCAT = WS_QKV + (size_t)TOK * 3072 * 2;
constexpr size_t WS_PART = WS_YCAT + (size_t)TOK * DM * 2;
constexpr size_t WS_RSTD = WS_PART + (size_t)TOK * 32 * 4;
constexpr size_t WS_VST = WS_RSTD + (size_t)TOK * 4;
constexpr size_t WS_END = WS_VST + (size_t)TOK * 32 * 2 * 4;

#define LDS_WAIT() asm volatile("s_waitcnt lgkmcnt(0)" ::: "memory")
__device__ __forceinline__ float bf2f(bf16_t v) { return __builtin_bit_cast(float, (unsigned)v << 16); }
__device__ __forceinline__ float bflo(unsigned w) { return __builtin_bit_cast(float, w << 16); }
__device__ __forceinline__ float bfhi(unsigned w) { return __builtin_bit_cast(float, w & 0xffff0000u); }
__device__ __forceinline__ bf16_t f2bf(float f) { return (bf16_t)(cvt_pk_bf16(f, 0.f) & 0xffffu); }
__device__ __forceinline__ float silu_f(float x) { return x * __builtin_amdgcn_rcpf(1.f + __expf(-x)); }
__device__ __forceinline__ float wave_sum(float v) {
#pragma unroll
    for (int o = 1; o < 64; o <<= 1) v += __shfl_xor(v, o);
    return v;
}
__device__ __forceinline__ int crow(int r, int hi) { return (r & 3) + 8 * (r >> 2) + 4 * hi; }
__device__ __forceinline__ void unpack8(u32x4 w, float* f) {
    f[0] = bflo(w.x); f[1] = bfhi(w.x); f[2] = bflo(w.y); f[3] = bfhi(w.y); f[4] = bflo(w.z); f[5] = bfhi(w.z); f[6] = bflo(w.w); f[7] = bfhi(w.w);
}
__device__ __forceinline__ u32x4 pack8(const float* f) {
    u32x4 w; w.x = cvt_pk_bf16(f[0], f[1]); w.y = cvt_pk_bf16(f[2], f[3]); w.z = cvt_pk_bf16(f[4], f[5]); w.w = cvt_pk_bf16(f[6], f[7]); return w;
}

namespace pg8 {
struct OneUnit { int pm;
    __device__ __forceinline__ bool next(int i, Unit& u) const { if (i) return false; u.pm = pm; u.pn = 0; return true; }
    __device__ __forceinline__ void a_ready(const Unit&) const {}
    __device__ __forceinline__ void done(const Unit&) const {} };
struct EpiLog {
    static constexpr bool PERM = true, AFTER_DRAIN = false;
    float* LOG;
    __device__ __forceinline__ void operator()(const f32x4 (&acc)[2][2][4][2], const Unit& u, int wr, int wc, int fr, int fq) const {
        const int row0 = u.pm * BM + wr * 64 + fr;
        if (wc == 0) {
#pragma unroll
            for (int ai = 0; ai < 2; ++ai)
#pragma unroll
                for (int m = 0; m < 4; ++m) { float* lp = LOG + (size_t)(row0 + ai * HALF + m * 16) * 32 + 8 * fq;
                    *(f32x4*)lp = acc[ai][0][m][0]; *(f32x4*)(lp + 4) = acc[ai][0][m][1]; }
        }
    }
};
struct Epi0 {
    static constexpr bool PERM = true, AFTER_DRAIN = false;
    bf16_t* P; float* LOG;
    __device__ __forceinline__ void operator()(const f32x4 (&acc)[2][2][4][2], const Unit& u, int wr, int wc, int fr, int fq) const {
        const int row0 = u.pm * BM + wr * 64 + fr;
        if (u.pn < 26) {
            const int col0 = u.pn * BM + wc * 32 + 8 * fq;
#pragma unroll
            for (int ai = 0; ai < 2; ++ai)
#pragma unroll
                for (int m = 0; m < 4; ++m) { bf16_t* rowp = P + (size_t)(row0 + ai * HALF + m * 16) * P0LD + col0;
#pragma unroll
                    for (int bj = 0; bj < 2; ++bj) { const f32x4 v0 = acc[ai][bj][m][0], v1 = acc[ai][bj][m][1];
                        ::u32x4 w; w.x = cvt_pk_bf16(v0[0], v0[1]); w.y = cvt_pk_bf16(v0[2], v0[3]); w.z = cvt_pk_bf16(v1[0], v1[1]); w.w = cvt_pk_bf16(v1[2], v1[3]);
                        *(::u32x4*)(rowp + bj * HALF) = w; } }
        } else if (wc == 0) {
#pragma unroll
            for (int ai = 0; ai < 2; ++ai)
#pragma unroll
                for (int m = 0; m < 4; ++m) { float* lp = LOG + (size_t)(row0 + ai * HALF + m * 16) * 32 + 8 * fq;
                    *(f32x4*)lp = acc[ai][0][m][0]; *(f32x4*)(lp + 4) = acc[ai][0][m][1]; }
        }
    }
};
struct Epi1 {
    static constexpr bool PERM = true, AFTER_DRAIN = false;
    bf16_t* P; const float* RS; float* VST;
    __device__ __forceinline__ void operator()(const f32x4 (&acc)[2][2][4][2], const Unit& u, int wr, int wc, int fr, int fq) const {
        const int row0 = u.pm * BM + wr * 64 + fr; const int col0 = u.pn * BM + wc * 32 + 8 * fq; const bool act = u.pn < 16, vst = u.pn >= 8 && u.pn < 16;
        float rsv[2][4];
#pragma unroll
        for (int ai = 0; ai < 2; ++ai)
#pragma unroll
            for (int m = 0; m < 4; ++m) rsv[ai][m] = RS[row0 + ai * HALF + m * 16];
#pragma unroll
        for (int ai = 0; ai < 2; ++ai)
#pragma unroll
            for (int m = 0; m < 4; ++m) { const int row = row0 + ai * HALF + m * 16; const float rs = rsv[ai][m]; bf16_t* rowp = P + (size_t)row * N1 + col0; float s1 = 0.f, s2 = 0.f;
#pragma unroll
                for (int bj = 0; bj < 2; ++bj) { f32x4 v0 = acc[ai][bj][m][0] * rs, v1 = acc[ai][bj][m][1] * rs;
                    if (act) { f32x2 a = gelu_pk((f32x2){v0[0], v0[1]}), b = gelu_pk((f32x2){v0[2], v0[3]}), c = gelu_pk((f32x2){v1[0], v1[1]}), d = gelu_pk((f32x2){v1[2], v1[3]});
                        v0 = (f32x4){a.x, a.y, b.x, b.y}; v1 = (f32x4){c.x, c.y, d.x, d.y}; }
                    if (vst) { s1 += (v0[0] + v0[1]) + (v0[2] + v0[3]) + (v1[0] + v1[1]) + (v1[2] + v1[3]);
                        s2 += (v0[0] * v0[0] + v0[1] * v0[1]) + (v0[2] * v0[2] + v0[3] * v0[3]) + (v1[0] * v1[0] + v1[1] * v1[1]) + (v1[2] * v1[2] + v1[3] * v1[3]); }
                    ::u32x4 w; w.x = cvt_pk_bf16(v0[0], v0[1]); w.y = cvt_pk_bf16(v0[2], v0[3]); w.z = cvt_pk_bf16(v1[0], v1[1]); w.w = cvt_pk_bf16(v1[2], v1[3]);
                    *(::u32x4*)(rowp + bj * HALF) = w; }
                if (vst) { s1 += __shfl_xor(s1, 16); s1 += __shfl_xor(s1, 32); s2 += __shfl_xor(s2, 16); s2 += __shfl_xor(s2, 32);
                    if (fq == 0) *(f32x2*)(VST + ((size_t)row * 32 + (u.pn - 8) * 4 + wc) * 2) = (f32x2){s1, s2}; } }
    }
};
struct EpiRes0 {
    static constexpr bool PERM = true, AFTER_DRAIN = false;
    const float* X; bf16_t* XB; float* PART;
    __device__ __forceinline__ void operator()(const f32x4 (&acc)[2][2][4][2], const Unit& u, int wr, int wc, int fr, int fq) const {
        const int row0 = u.pm * BM + wr * 64 + fr; const int col0 = u.pn * BM + wc * 32 + 8 * fq;
#pragma unroll
        for (int ai = 0; ai < 2; ++ai) {
            f32x4 xr[4][2][2];
#pragma unroll
            for (int m = 0; m < 4; ++m)
#pragma unroll
                for (int bj = 0; bj < 2; ++bj) { const size_t off = (size_t)(row0 + ai * HALF + m * 16) * DM + col0 + bj * HALF; xr[m][bj][0] = *(const f32x4*)(X + off); xr[m][bj][1] = *(const f32x4*)(X + off + 4); }
#pragma unroll
            for (int m = 0; m < 4; ++m) { const int row = row0 + ai * HALF + m * 16; const size_t off = (size_t)row * DM + col0; float ss = 0.f;
#pragma unroll
                for (int bj = 0; bj < 2; ++bj) { const f32x4 v0 = xr[m][bj][0] + acc[ai][bj][m][0], v1 = xr[m][bj][1] + acc[ai][bj][m][1];
                    ss += (v0[0] * v0[0] + v0[1] * v0[1]) + (v0[2] * v0[2] + v0[3] * v0[3]) + (v1[0] * v1[0] + v1[1] * v1[1]) + (v1[2] * v1[2] + v1[3] * v1[3]);
                    ::u32x4 w; w.x = cvt_pk_bf16(v0[0], v0[1]); w.y = cvt_pk_bf16(v0[2], v0[3]); w.z = cvt_pk_bf16(v1[0], v1[1]); w.w = cvt_pk_bf16(v1[2], v1[3]);
                    *(::u32x4*)(XB + off + bj * HALF) = w; }
                ss += __shfl_xor(ss, 16); ss += __shfl_xor(ss, 32);
                if (fq == 0) PART[(size_t)row * 32 + u.pn * 4 + wc] = ss; } }
    }
};
struct EpiRes1 {
    static constexpr bool PERM = true, AFTER_DRAIN = false;
    const bf16_t* XB; float* O;
    __device__ __forceinline__ void operator()(const f32x4 (&acc)[2][2][4][2], const Unit& u, int wr, int wc, int fr, int fq) const {
        const int row0 = u.pm * BM + wr * 64 + fr; const int col0 = u.pn * BM + wc * 32 + 8 * fq;
        ::u32x4 xbv[2][4][2];
#pragma unroll
        for (int ai = 0; ai < 2; ++ai)
#pragma unroll
            for (int m = 0; m < 4; ++m)
#pragma unroll
                for (int bj = 0; bj < 2; ++bj) xbv[ai][m][bj] = *(const ::u32x4*)(XB + (size_t)(row0 + ai * HALF + m * 16) * DM + col0 + bj * HALF);
#pragma unroll
        for (int ai = 0; ai < 2; ++ai)
#pragma unroll
            for (int m = 0; m < 4; ++m) { const size_t off = (size_t)(row0 + ai * HALF + m * 16) * DM + col0;
#pragma unroll
                for (int bj = 0; bj < 2; ++bj) { const ::u32x4 xb = xbv[ai][m][bj];
                    const f32x4 r0 = {::bflo(xb.x), ::bfhi(xb.x), ::bflo(xb.y), ::bfhi(xb.y)}, r1 = {::bflo(xb.z), ::bfhi(xb.z), ::bflo(xb.w), ::bfhi(xb.w)};
                    *(f32x4*)(O + off + bj * HALF) = r0 + acc[ai][bj][m][0]; *(f32x4*)(O + off + bj * HALF + 4) = r1 + acc[ai][bj][m][1]; } }
    }
};
}
__device__ __forceinline__ void transpose_item(const float* __restrict__ W, int K, int Nsrc, int src_n0, bf16_t* __restrict__ WT, int dst_n0, int k0, LAS float* scr, int lane, const float* __restrict__ kscale = nullptr) {
    { const int n4 = (lane & 7) * 4; f32x4 tv[8];
#pragma unroll
        for (int i = 0; i < 8; ++i) { const int kk = (lane >> 3) + 8 * i;
            tv[i] = (src_n0 >= 0) ? *(const f32x4*)(W + (size_t)(k0 + kk) * Nsrc + src_n0 + n4) * (kscale ? kscale[k0 + kk] : 1.f) : (f32x4){0.f, 0.f, 0.f, 0.f}; }
#pragma unroll
        for (int i = 0; i < 8; ++i) { const int kk = (lane >> 3) + 8 * i; LAS float* d = scr + kk * 33 + n4; d[0] = tv[i].x; d[1] = tv[i].y; d[2] = tv[i].z; d[3] = tv[i].w; } }
    LDS_WAIT(); asm volatile("" ::: "memory");
    const int c = lane & 7;
#pragma unroll
    for (int j = 0; j < 4; ++j) { const int n = (lane >> 3) + 8 * j; const LAS float* s = scr + (8 * c) * 33 + n;
        u32x4 o; o.x = cvt_pk_bf16(s[0 * 33], s[1 * 33]); o.y = cvt_pk_bf16(s[2 * 33], s[3 * 33]); o.z = cvt_pk_bf16(s[4 * 33], s[5 * 33]); o.w = cvt_pk_bf16(s[6 * 33], s[7 * 33]);
        *(u32x4*)(WT + (size_t)(dst_n0 + n) * K + k0 + 8 * c) = o; }
    LDS_WAIT(); asm volatile("" ::: "memory");
}
__device__ __forceinline__ void rms_row(const float* __restrict__ xrow, const float* __restrict__ g, bf16_t* __restrict__ orow, int lane) {
    const f32x4* xr = (const f32x4*)xrow + lane; f32x4 v[8]; float s = 0.f;
#pragma unroll
    for (int j = 0; j < 8; ++j) { v[j] = xr[64 * j]; s += (v[j].x * v[j].x + v[j].y * v[j].y) + (v[j].z * v[j].z + v[j].w * v[j].w); }
    const float r = 1.0f / sqrtf(wave_sum(s) * (1.f / DM) + EPS);
    const f32x4* gr = (const f32x4*)g + lane; u32x2* o8 = (u32x2*)orow + lane;
#pragma unroll
    for (int j = 0; j < 8; ++j) { const f32x4 gg = gr[64 * j]; u32x2 w; w.x = cvt_pk_bf16(v[j].x * r * gg.x, v[j].y * r * gg.y); w.y = cvt_pk_bf16(v[j].z * r * gg.z, v[j].w * r * gg.w); o8[64 * j] = w; }
}
__device__ __forceinline__ void rms_row2(const float* __restrict__ xa, const float* __restrict__ xb, const float* __restrict__ g, bf16_t* __restrict__ oa, bf16_t* __restrict__ ob, int lane) {
    const f32x4* xra = (const f32x4*)xa + lane; const f32x4* xrb = (const f32x4*)xb + lane; f32x4 va[8], vb[8]; float sa = 0.f, sb = 0.f;
#pragma unroll
    for (int j = 0; j < 8; ++j) { va[j] = xra[64 * j]; vb[j] = xrb[64 * j]; }
#pragma unroll
    for (int j = 0; j < 8; ++j) { sa += (va[j].x * va[j].x + va[j].y * va[j].y) + (va[j].z * va[j].z + va[j].w * va[j].w); sb += (vb[j].x * vb[j].x + vb[j].y * vb[j].y) + (vb[j].z * vb[j].z + vb[j].w * vb[j].w); }
    const float ra = 1.0f / sqrtf(wave_sum(sa) * (1.f / DM) + EPS), rb = 1.0f / sqrtf(wave_sum(sb) * (1.f / DM) + EPS);
    const f32x4* gr = (const f32x4*)g + lane; u32x2* o8a = (u32x2*)oa + lane; u32x2* o8b = (u32x2*)ob + lane;
#pragma unroll
    for (int j = 0; j < 8; ++j) { const f32x4 gg = gr[64 * j]; u32x2 w;
        w.x = cvt_pk_bf16(va[j].x * ra * gg.x, va[j].y * ra * gg.y); w.y = cvt_pk_bf16(va[j].z * ra * gg.z, va[j].w * ra * gg.w); o8a[64 * j] = w;
        w.x = cvt_pk_bf16(vb[j].x * rb * gg.x, vb[j].y * rb * gg.y); w.y = cvt_pk_bf16(vb[j].z * rb * gg.z, vb[j].w * rb * gg.w); o8b[64 * j] = w; }
}
struct P0Args { const float* x; const float* g0; const float* g1; const float* w_in0; const float* w_out0; const float* w_in1; const float* w_out1; bf16_t* W0T; bf16_t* WO0T; bf16_t* W1T; bf16_t* WO1T; bf16_t* H; };
__device__ __forceinline__ void p0_prologue(const P0Args& a, LAS unsigned char* lds, int gw, int NGW, int wave, int lane) {
    LAS float* scr = (LAS float*)(lds + wave * 16384);
    constexpr int I0 = 32 * (N0P / 32), IO = 32 * (DM / 32), I1 = 32 * (N1 / 32);
    constexpr int NITEMS = I0 + IO + I1 + IO;
    for (int it = gw; it < NITEMS; it += NGW) {
        int r = it;
        if (r < I0) { const int nblk = N0P / 32, kb = r / nblk, nb = r % nblk, d0 = 32 * nb;
            const int src = d0 < 4096 ? d0 : (d0 < 6656 ? d0 + 32 : (d0 == 6656 ? 4096 : -1));
            transpose_item(a.w_in0, DM, 6688, src, a.W0T, d0, 64 * kb, scr, lane); continue; }
        r -= I0;
        if (r < IO) { const int nblk = DM / 32, kb = r / nblk, nb = r % nblk; transpose_item(a.w_out0, DM, DM, 32 * nb, a.WO0T, 32 * nb, 64 * kb, scr, lane); continue; }
        r -= IO;
        if (r < I1) { const int nblk = N1 / 32, kb = r / nblk, nb = r % nblk; transpose_item(a.w_in1, DM, N1, 32 * nb, a.W1T, 32 * nb, 64 * kb, scr, lane, a.g1); continue; }
        r -= I1;
        { const int nblk = DM / 32, kb = r / nblk, nb = r % nblk; transpose_item(a.w_out1, DM, DM, 32 * nb, a.WO1T, 32 * nb, 64 * kb, scr, lane); }
    }
#ifdef P0_ROWS4
    for (int m = gw; m < TOK; m += 4 * NGW) { rms_row2(a.x + (size_t)m * DM, a.x + (size_t)(m + NGW) * DM, a.g0, a.H + (size_t)m * DM, a.H + (size_t)(m + NGW) * DM, lane);
        rms_row2(a.x + (size_t)(m + 2 * NGW) * DM, a.x + (size_t)(m + 3 * NGW) * DM, a.g0, a.H + (size_t)(m + 2 * NGW) * DM, a.H + (size_t)(m + 3 * NGW) * DM, lane); }
#else
    for (int m = gw; m < TOK; m += 2 * NGW) rms_row2(a.x + (size_t)m * DM, a.x + (size_t)(m + NGW) * DM, a.g0, a.H + (size_t)m * DM, a.H + (size_t)(m + NGW) * DM, lane);
#endif
}

__device__ __forceinline__ void p2_conv_item(const bf16_t* __restrict__ P, const float* __restrict__ cw, bf16_t* __restrict__ QKV, int item, int lane) {
    const int run = item / 6, slice = item % 6, t0 = run * 16, b = t0 / SEQ, l0 = t0 % SEQ, ch0 = slice * 512 + lane * 8;
    float w[5][8];
#pragma unroll
    for (int j = 0; j < 5; ++j) { const f32x4 a = *(const f32x4*)(cw + j * 3072 + ch0), c = *(const f32x4*)(cw + j * 3072 + ch0 + 4);
        w[j][0] = a.x; w[j][1] = a.y; w[j][2] = a.z; w[j][3] = a.w; w[j][4] = c.x; w[j][5] = c.y; w[j][6] = c.z; w[j][7] = c.w; }
    u32x4 rows[20];
#pragma unroll
    for (int r = 0; r < 20; ++r) { const int l = l0 - 2 + r, lc = l < 0 ? 0 : (l >= SEQ ? SEQ - 1 : l);
        rows[r] = *(const u32x4*)(P + (size_t)(b * SEQ + lc) * P0LD + ch0);
        if (l != lc) rows[r] = (u32x4){0u, 0u, 0u, 0u}; }
    float win[5][8];
#pragma unroll
    for (int j = 0; j < 5; ++j)
#pragma unroll
        for (int e = 0; e < 8; ++e) win[j][e] = 0.f;
#pragma unroll
    for (int r = 0; r < 20; ++r) {
#pragma unroll
        for (int j = 0; j < 4; ++j)
#pragma unroll
            for (int e = 0; e < 8; ++e) win[j][e] = win[j + 1][e];
        unpack8(rows[r], win[4]);
        if (r >= 4) {
            float y[8]; float ss = 0.f;
#pragma unroll
            for (int e = 0; e < 8; ++e) { float acc = 0.f;
#pragma unroll
                for (int j = 0; j < 5; ++j) acc = fmaf(w[j][e], win[j][e], acc);
                y[e] = silu_f(acc); ss = fmaf(y[e], y[e], ss); }
            if (slice < 4) {
                ss += __shfl_xor(ss, 1); ss += __shfl_xor(ss, 2); ss += __shfl_xor(ss, 4); ss += __shfl_xor(ss, 8);
                const float rn = 1.0f / sqrtf(ss + EPS);
#pragma unroll
                for (int e = 0; e < 8; ++e) y[e] *= rn;
            }
            *(u32x4*)(QKV + (size_t)(t0 + r - 4) * 3072 + ch0) = pack8(y);
        }
    }
}

template <int NT>
__device__ __forceinline__ void p2_rope_tokens(bf16_t* __restrict__ P, const float* __restrict__ qn_g, const float* __restrict__ kn_g, int t0, int tstride, int lane) {
    const int half = lane >> 5, i = lane & 31;
    const float inv = exp2f(-(float)i * (13.287712379549449f / 32.f));
    const int e1 = half * 64 + i, e2 = e1 + 32;
    const float gq1 = qn_g[e1], gq2 = qn_g[e2], gk1 = kn_g[e1], gk2 = kn_g[e2];
    float x1[NT][10], x2[NT][10];
#pragma unroll
    for (int k = 0; k < NT; ++k) { const bf16_t* row = P + (size_t)(t0 + k * tstride) * P0LD;
#pragma unroll
        for (int hh = 0; hh < 10; ++hh) { const bf16_t* hp = row + (hh < 8 ? C_BQ + hh * 128 : C_BK + (hh - 8) * 128); x1[k][hh] = bf2f(hp[e1]); x2[k][hh] = bf2f(hp[e2]); } }
#pragma unroll
    for (int k = 0; k < NT; ++k) { const int t = t0 + k * tstride, l = t % SEQ; bf16_t* row = P + (size_t)t * P0LD;
        const float pos = half ? (float)(l % 64) : (float)(l / 64);
        float rev = pos * inv * 0.15915494309189535f; rev -= floorf(rev);
        const float sn = __builtin_amdgcn_sinf(rev), cs = __builtin_amdgcn_cosf(rev);
#pragma unroll
        for (int hh = 0; hh < 10; ++hh) {
            bf16_t* hp = row + (hh < 8 ? C_BQ + hh * 128 : C_BK + (hh - 8) * 128);
            const float ss = wave_sum(x1[k][hh] * x1[k][hh] + x2[k][hh] * x2[k][hh]);
            const float rn = 1.0f / sqrtf(ss * (1.f / 128.f) + EPS);
            const float y1 = x1[k][hh] * rn * (hh < 8 ? gq1 : gk1), y2 = x2[k][hh] * rn * (hh < 8 ? gq2 : gk2);
            hp[e1] = f2bf(y1 * cs - y2 * sn); hp[e2] = f2bf(y2 * cs + y1 * sn);
        } }
}

template <int NT>
__device__ __forceinline__ void p4_tokens(const bf16_t* __restrict__ OF, const bf16_t* __restrict__ OB, const bf16_t* __restrict__ P, const float* __restrict__ og, bf16_t* __restrict__ Y, int t0, int lane) {
    u32x4 ra[NT][2], rb[NT][2], rg[NT][2];
#pragma unroll
    for (int k = 0; k < NT; ++k)
#pragma unroll
        for (int i = 0; i < 2; ++i) { const int col0 = i * 512 + lane * 8; const size_t t = (size_t)(t0 + k);
            ra[k][i] = *(const u32x4*)(OF + t * 1024 + col0); rb[k][i] = *(const u32x4*)(OB + t * 1024 + col0); rg[k][i] = *(const u32x4*)(P + t * P0LD + C_AG + col0); }
#pragma unroll
    for (int k = 0; k < NT; ++k)
#pragma unroll
        for (int i = 0; i < 2; ++i) { const int col0 = i * 512 + lane * 8; float a[8], b[8], g[8], y[8];
            unpack8(ra[k][i], a); unpack8(rb[k][i], b); unpack8(rg[k][i], g);
            float ss = 0.f;
#pragma unroll
            for (int e = 0; e < 8; ++e) { a[e] += b[e]; ss = fmaf(a[e], a[e], ss); }
            ss += __shfl_xor(ss, 1); ss += __shfl_xor(ss, 2); ss += __shfl_xor(ss, 4); ss += __shfl_xor(ss, 8);
            const float rn = 1.0f / sqrtf(ss * (1.f / 128.f) + EPS);
            const int e0 = col0 & 127;
#pragma unroll
            for (int e = 0; e < 8; ++e) y[e] = a[e] * rn * og[e0 + e] * silu_f(g[e]);
            *(u32x4*)(Y + (size_t)(t0 + k) * DM + col0) = pack8(y); }
}
namespace att {
constexpr int D = 128, NW = 8, QBLK = 32, KVBLK = 64;
constexpr float SCALE = 0.088388347648318440f;
constexpr float THR = 8.f;
constexpr int SDEPTH = 2;
constexpr int LDQ = P0LD, LDK = P0LD;
constexpr size_t SHM_V = KVBLK * D * 2, SHM_K = KVBLK * D * 2, SHM_ATTN = 2 * SHM_V + 2 * SHM_K + NW * 64 * 4;
#define KSWZ(row, colB) ((row) * 256 + ((colB) ^ (((row) & 7) << 4)))
#define SBAR() __builtin_amdgcn_sched_barrier(0)
__device__ __forceinline__ unsigned cvtpk(float lo, float hi) { unsigned r; asm volatile("v_cvt_pk_bf16_f32 %0, %1, %2" : "=v"(r) : "v"(lo), "v"(hi)); return r; }
__device__ __forceinline__ void partialSM(f32x16& p0, f32x16& p1, float& m_reg, float& mn, float& alpha) {
  constexpr float C = SCALE * 1.4426950408889634f;
  float pmax = p0[0]; for (int r = 1; r < 16; ++r) pmax = fmaxf(pmax, p0[r]); for (int r = 0; r < 16; ++r) pmax = fmaxf(pmax, p1[r]);
  { auto rr = __builtin_amdgcn_permlane32_swap(__float_as_uint(pmax), __float_as_uint(pmax), false, false);
    pmax = fmaxf(__uint_as_float(rr[0]), __uint_as_float(rr[1])); }
  if (__builtin_expect(__all(pmax - m_reg <= THR / SCALE), 1)) { mn = m_reg; alpha = 1.f; }
  else { mn = fmaxf(m_reg, pmax); alpha = __builtin_amdgcn_exp2f((m_reg - mn) * C); m_reg = mn; }
  float mnC = -mn * C;
  for (int r = 0; r < 16; ++r) p0[r] = fmaf(p0[r], C, mnC); for (int r = 0; r < 16; ++r) p1[r] = fmaf(p1[r], C, mnC);
  for (int r = 0; r < 16; ++r) p0[r] = __builtin_amdgcn_exp2f(p0[r]);
}
__device__ __forceinline__ void finishSM(f32x16& p0, f32x16& p1, float alpha, float& l_reg, bf16x8& pa0, bf16x8& pa1, bf16x8& pa2, bf16x8& pa3) {
  for (int r = 0; r < 16; ++r) p1[r] = __builtin_amdgcn_exp2f(p1[r]);
  float ps = 0; for (int r = 0; r < 16; ++r) ps += p0[r]; for (int r = 0; r < 16; ++r) ps += p1[r];
  { auto rr = __builtin_amdgcn_permlane32_swap(__float_as_uint(ps), __float_as_uint(ps), false, false);
    ps = __uint_as_float(rr[0]) + __uint_as_float(rr[1]); }
  l_reg = l_reg * alpha + ps;
#define PK4(P, BASE, OUT) do { unsigned a0 = cvtpk(P[BASE + 0], P[BASE + 1]), a1 = cvtpk(P[BASE + 2], P[BASE + 3]);   \
    unsigned b0 = cvtpk(P[BASE + 4], P[BASE + 5]), b1 = cvtpk(P[BASE + 6], P[BASE + 7]);                              \
    auto r0 = __builtin_amdgcn_permlane32_swap(a0, b0, false, false); auto r1 = __builtin_amdgcn_permlane32_swap(a1, b1, false, false); \
    u32x4 w = {r0[0], r1[0], r0[1], r1[1]}; OUT = *reinterpret_cast<bf16x8*>(&w); } while (0)
  PK4(p0, 0, pa0); PK4(p0, 8, pa1); PK4(p1, 0, pa2); PK4(p1, 8, pa3);
#undef PK4
}
__device__ __forceinline__ void qkt(f32x16& p0, f32x16& p1, const bf16_t* Ks, const bf16x8* qr, int r32, int hi) {
  p0 = f32x16{}; p1 = f32x16{};
  for (int d0 = 0; d0 < 8; ++d0) { int cb = (d0 * 16 + hi * 8) * 2;
    bf16x8 b0 = *reinterpret_cast<const bf16x8*>((const char*)Ks + KSWZ(r32, cb));
    bf16x8 b1 = *reinterpret_cast<const bf16x8*>((const char*)Ks + KSWZ(32 + r32, cb));
    p0 = __builtin_amdgcn_mfma_f32_32x32x16_bf16(b0, qr[d0], p0, 0, 0, 0);
    p1 = __builtin_amdgcn_mfma_f32_32x32x16_bf16(b1, qr[d0], p1, 0, 0, 0); }
}
__device__ __forceinline__ int v_st(int k, int c) { const int kk = (k & ~0xC) | ((k & 4) << 1) | ((k & 8) >> 1); return ((kk >> 3) * 4 + (c >> 5)) * 512 + ((kk & 7) * 32 + (c & 31)) * 2; }
__device__ __forceinline__ int v_rd_base(int lane) { return ((lane & 3) << 3) | (((lane >> 2) & 3) << 6) | (((lane >> 4) & 1) << 5) | (((lane >> 5) & 1) << 8); }
constexpr int v_rd_off(int d0, int ks, int half) { return d0 * 512 + ks * 4096 + half * 2048; }
template <int OFF> __device__ __forceinline__ s16x4 tr_read(int vb) {
  s16x4 r; asm volatile("ds_read_b64_tr_b16 %0, %1 offset:%2" : "=&v"(r) : "v"(vb), "i"(OFF) : "memory"); return r;
}
template <int D0> __device__ __forceinline__ void pv_one(f32x16& od, int vb, bf16x8 pa0, bf16x8 pa1, bf16x8 pa2, bf16x8 pa3) {
  const s16x4 l0 = tr_read<v_rd_off(D0, 0, 0)>(vb), h0 = tr_read<v_rd_off(D0, 0, 1)>(vb), l1 = tr_read<v_rd_off(D0, 1, 0)>(vb), h1 = tr_read<v_rd_off(D0, 1, 1)>(vb);
  const s16x4 l2 = tr_read<v_rd_off(D0, 2, 0)>(vb), h2 = tr_read<v_rd_off(D0, 2, 1)>(vb), l3 = tr_read<v_rd_off(D0, 3, 0)>(vb), h3 = tr_read<v_rd_off(D0, 3, 1)>(vb);
  asm volatile("s_waitcnt lgkmcnt(0)" ::: "memory"); SBAR();
#define PK(L, H) (bf16x8){L[0], L[1], L[2], L[3], H[0], H[1], H[2], H[3]}
  od = __builtin_amdgcn_mfma_f32_32x32x16_bf16(pa0, PK(l0, h0), od, 0, 0, 0);
  od = __builtin_amdgcn_mfma_f32_32x32x16_bf16(pa1, PK(l1, h1), od, 0, 0, 0);
  od = __builtin_amdgcn_mfma_f32_32x32x16_bf16(pa2, PK(l2, h2), od, 0, 0, 0);
  od = __builtin_amdgcn_mfma_f32_32x32x16_bf16(pa3, PK(l3, h3), od, 0, 0, 0);
#undef PK
}
__device__ __forceinline__ void pv_d0(f32x16* o, int vb, bf16x8 pa0, bf16x8 pa1, bf16x8 pa2, bf16x8 pa3) {
  pv_one<0>(o[0], vb, pa0, pa1, pa2, pa3); pv_one<1>(o[1], vb, pa0, pa1, pa2, pa3); pv_one<2>(o[2], vb, pa0, pa1, pa2, pa3); pv_one<3>(o[3], vb, pa0, pa1, pa2, pa3);
}
__device__ __forceinline__ void attn_dense_body(const bf16_t* __restrict__ Qb, const bf16_t* __restrict__ Kh, const bf16_t* __restrict__ Vh,
                                                const bf16_t* __restrict__ Gb, bf16_t* __restrict__ Yb, int seq, char* lds) {
  int tid = threadIdx.x; asm volatile("" : "+v"(tid));
  const int wid = tid >> 6, lane = tid & 63, r32 = lane & 31, hi = lane >> 5;
  bf16_t* V_lds = (bf16_t*)lds; bf16_t* K_lds = (bf16_t*)(lds + 2 * SHM_V);
  float* ws = (float*)(lds + 2 * SHM_V + 2 * SHM_K) + wid * 64; float* li_l = ws; float* al_l = ws + 32;
  float m_reg = -1e30f, l_reg = 0; f32x16 o[4] = {}; bf16x8 qr[8];
  const bf16_t* Qw = Qb + (long)(wid * QBLK + r32) * LDQ + hi * 8;
#pragma unroll
  for (int d0 = 0; d0 < 8; ++d0) qr[d0] = *reinterpret_cast<const bf16x8*>(Qw + d0 * 16);
  const int sr = tid >> 4, sc = (tid & 15) * 8, vst0 = v_st(sr, sc), vst1 = v_st(32 + sr, sc);
  const int vb0 = (int)(uintptr_t)V_lds + v_rd_base(lane);
  struct { bf16x8 vs0, vs1, ks0, ks1; } sr_[SDEPTH];
  const unsigned voff0 = (unsigned)((sr * LDK + sc) * 2), voff1 = voff0 + (unsigned)(32 * LDK * 2);
#define SLOAD(i, k0) do { const char* vb_ = (const char*)Vh + (size_t)(k0) * (LDK * 2); const char* kb_ = (const char*)Kh + (size_t)(k0) * (LDK * 2); \
    sr_[i].vs0 = *reinterpret_cast<const bf16x8*>(vb_ + voff0); sr_[i].vs1 = *reinterpret_cast<const bf16x8*>(vb_ + voff1); \
    sr_[i].ks0 = *reinterpret_cast<const bf16x8*>(kb_ + voff0); sr_[i].ks1 = *reinterpret_cast<const bf16x8*>(kb_ + voff1); } while (0)
#define SWRITE(b, i) do { *(bf16x8*)((char*)V_lds + (b) * SHM_V + vst0) = sr_[i].vs0;          \
    *(bf16x8*)((char*)V_lds + (b) * SHM_V + vst1) = sr_[i].vs1; int kc = sc * 2;               \
    *(bf16x8*)((char*)K_lds + (b) * SHM_K + KSWZ(sr, kc)) = sr_[i].ks0;                       \
    *(bf16x8*)((char*)K_lds + (b) * SHM_K + KSWZ(32 + sr, kc)) = sr_[i].ks1; } while (0)
#define SWAIT() do { if constexpr (SDEPTH == 2) asm volatile("s_waitcnt vmcnt(4)" ::: "memory"); else asm volatile("s_waitcnt vmcnt(0)" ::: "memory"); } while (0)
#define RESC(a) do { if (__any((a) < 1.f)) { if (hi == 0) al_l[r32] = (a); asm volatile("s_waitcnt lgkmcnt(0)" ::: "memory"); \
    for (int d = 0; d < 4; ++d) for (int r = 0; r < 16; ++r) o[d][r] *= al_l[crow(r, hi)]; } } while (0)
  f32x16 pA0, pA1, pB0, pB1; float mnA, mnB, alA, alB; bf16x8 pa0, pa1, pa2, pa3; const int NT = seq / KVBLK;
  constexpr int SE = 0, SO = SDEPTH - 1;
  SLOAD(SE, 0); asm volatile("s_waitcnt vmcnt(0)" ::: "memory"); SWRITE(0, SE); __syncthreads();
  qkt(pA0, pA1, K_lds, qr, r32, hi); partialSM(pA0, pA1, m_reg, mnA, alA);
  SLOAD(SO, KVBLK); if constexpr (SDEPTH == 2) { if (2 < NT) SLOAD(SE, 2 * KVBLK); }
  SWAIT(); SWRITE(1, SO); __syncthreads();
  for (int j = 1; j + 1 < NT; j += 2) {
    SBAR(); qkt(pB0, pB1, (bf16_t*)((char*)K_lds + SHM_K), qr, r32, hi);
    finishSM(pA0, pA1, alA, l_reg, pa0, pa1, pa2, pa3); SBAR();
    SLOAD(SO, (j + SDEPTH) * KVBLK); SBAR();
    pv_d0(o, vb0, pa0, pa1, pa2, pa3); partialSM(pB0, pB1, m_reg, mnB, alB);
    __syncthreads(); SWAIT(); SWRITE(0, SE);
    RESC(alB); __syncthreads();
    SBAR(); qkt(pA0, pA1, K_lds, qr, r32, hi);
    finishSM(pB0, pB1, alB, l_reg, pa0, pa1, pa2, pa3); SBAR();
    if (SDEPTH == 1 || j + 3 < NT) SLOAD(SE, (j + 1 + SDEPTH) * KVBLK); SBAR();
    pv_d0(o, vb0 + (int)SHM_V, pa0, pa1, pa2, pa3); partialSM(pA0, pA1, m_reg, mnA, alA);
    __syncthreads(); SWAIT(); SWRITE(1, SO);
    RESC(alA); __syncthreads();
  }
  SBAR(); qkt(pB0, pB1, (bf16_t*)((char*)K_lds + SHM_K), qr, r32, hi);
  finishSM(pA0, pA1, alA, l_reg, pa0, pa1, pa2, pa3); SBAR();
  pv_d0(o, vb0, pa0, pa1, pa2, pa3); partialSM(pB0, pB1, m_reg, mnB, alB);
  __syncthreads(); RESC(alB);
  finishSM(pB0, pB1, alB, l_reg, pa0, pa1, pa2, pa3); SBAR();
  pv_d0(o, vb0 + (int)SHM_V, pa0, pa1, pa2, pa3);
  if (hi == 0) li_l[r32] = l_reg; asm volatile("s_waitcnt lgkmcnt(0)" ::: "memory");
  float rli[16];
#pragma unroll
  for (int r = 0; r < 16; ++r) rli[r] = __builtin_amdgcn_rcpf(li_l[crow(r, hi)]);
  const bf16_t* Gw = Gb + (long)(wid * QBLK) * LDQ; bf16_t* Yw = Yb + (long)(wid * QBLK) * DM;
  u32x4 graw[8];
#pragma unroll
  for (int it = 0; it < 8; ++it) { const int idx = it * 64 + lane, row = idx >> 4, c8 = (idx & 15) * 8; graw[it] = *(const u32x4*)((const char*)Gw + (unsigned)((row * LDQ + c8) * 2)); }
  __syncthreads();
  { bf16_t* Ol = (bf16_t*)(lds + wid * 8192);
#pragma unroll
    for (int r = 0; r < 16; ++r) { const int orow = crow(r, hi);
#pragma unroll
      for (int d0 = 0; d0 < 4; ++d0) Ol[orow * 128 + d0 * 32 + r32] = f2bf(o[d0][r] * rli[r]); }
    asm volatile("s_waitcnt lgkmcnt(0)" ::: "memory");
#pragma unroll
    for (int it = 0; it < 8; ++it) { const int idx = it * 64 + lane, row = idx >> 4, c8 = (idx & 15) * 8; float ov[8], gv[8];
      unpack8(*(const u32x4*)(Ol + row * 128 + c8), ov); unpack8(graw[it], gv);
#pragma unroll
      for (int e = 0; e < 8; ++e) ov[e] *= silu_f(gv[e]);
      *(u32x4*)((char*)Yw + (unsigned)((row * DM + c8) * 2)) = pack8(ov); } }
  __syncthreads();
#undef SLOAD
#undef SWRITE
#undef SWAIT
#undef RESC
}
}
#ifndef DN_STAGE
#define DN_STAGE 7
#endif
namespace dn {
constexpr int KC_OFF = 0, QC_OFF = 17408, KT_OFF = 34816, VT_OFF = 53248, T1_OFF = VT_OFF + 18432, T2_OFF = T1_OFF + 9216;
constexpr int VN_OFF = VT_OFF, VNS_OFF = VT_OFF + 18432;
constexpr int MT_OFF = 90112, YF_OFF = MT_OFF + 16640, AT_OFF = YF_OFF + 4224, ST_OFF = AT_OFF + 9216, MISC_OFF = ST_OFF + 34816;
static_assert(MISC_OFF + 2048 <= LDS_BYTES - 64, "deltanet LDS map");
constexpr float SCALE = 0.088388347648318440f;
struct Args { const bf16_t* QKV; const float* LOG; const float* a_log; const float* dt_bias; bf16_t* OF; bf16_t* OB; };
__device__ __forceinline__ bf16x8 ldf(const LAS unsigned char* base, int row, int strideB, int kb) { return *(const LAS bf16x8*)(base + row * strideB + kb); }
#define DN_MFMA(a, b, c) __builtin_amdgcn_mfma_f32_32x32x16_bf16(a, b, c, 0, 0, 0)
__device__ __forceinline__ void unit(const Args& a, int un, LAS unsigned char* lds) {
    int tid = threadIdx.x; asm volatile("" : "+v"(tid));
    const int w = __builtin_amdgcn_readfirstlane(tid >> 6), lane = tid & 63, r32 = lane & 31, hi = lane >> 5;
    const int b = un >> 4, h = (un >> 1) & 7, dir = un & 1, wr = w >> 2, wc = w & 3;
    const float Aexp = expf(a.a_log[dir * 8 + h]), dtb = a.dt_bias[dir * 8 + h];
    bf16_t* __restrict__ O = dir ? a.OB : a.OF;
    LAS float* MT = (LAS float*)(lds + MT_OFF); LAS float* YF = (LAS float*)(lds + YF_OFF);
    LAS float* gc = (LAS float*)(lds + MISC_OFF); LAS float* beta = gc + 64; LAS float* eg = gc + 128; LAS float* ekl = gc + 192; LAS float* scal = gc + 256;
    __syncthreads();
    for (int i = tid; i < 34816 / 16; i += NTHR) *(LAS u32x4*)(lds + ST_OFF + i * 16) = (u32x4){0u, 0u, 0u, 0u};
    f32x16 accS[2];
#pragma unroll
    for (int r = 0; r < 16; ++r) { accS[0][r] = 0.f; accS[1][r] = 0.f; }
    u32x4 pq[2], pk[2], pv[2]; float pa = 0.f, pb = 0.f;
#define DN_LOADC(n) do { _Pragma("unroll") for (int i_ = 0; i_ < 2; ++i_) { const int idx_ = tid + NTHR * i_, c_ = idx_ & 63, d8_ = (idx_ >> 6) * 8, p_ = 64 * (n) + c_, l_ = dir ? SEQ - 1 - p_ : p_; \
        const unsigned bo_ = ((unsigned)(b * SEQ + l_) * 3072u + (unsigned)(h * 128 + d8_)) * 2u; const char* s_ = (const char*)a.QKV; \
        pq[i_] = *(const u32x4*)(s_ + bo_); pk[i_] = *(const u32x4*)(s_ + (bo_ + 2048u)); pv[i_] = *(const u32x4*)(s_ + (bo_ + 4096u)); } \
        if (w == 0) { const int p_ = 64 * (n) + lane, l_ = dir ? SEQ - 1 - p_ : p_; const unsigned lo_ = ((unsigned)(b * SEQ + l_) * 32u + (unsigned)(dir * 8 + h)) * 4u; \
            const char* l2_ = (const char*)a.LOG + (size_t)TOK * 32 * 4; pa = *(const float*)((const char*)a.LOG + lo_) + *(const float*)(l2_ + lo_); pb = *(const float*)((const char*)a.LOG + (lo_ + 64u)) + *(const float*)(l2_ + (lo_ + 64u)); } } while (0)
    DN_LOADC(0);
    for (int n = 0; n < 64; ++n) {
#pragma unroll
        for (int i = 0; i < 2; ++i) { const int idx = tid + NTHR * i, c = idx & 63, d8 = (idx >> 6) * 8;
            *(LAS u32x4*)(lds + KC_OFF + c * 272 + d8 * 2) = pk[i]; *(LAS u32x4*)(lds + QC_OFF + c * 272 + d8 * 2) = pq[i];
#pragma unroll
            for (int j = 0; j < 8; ++j) { const unsigned kw = pk[i][j >> 1], vw = pv[i][j >> 1];
                *(LAS bf16_t*)(lds + KT_OFF + (d8 + j) * 144 + c * 2) = (bf16_t)((j & 1) ? (kw >> 16) : (kw & 0xffffu));
                *(LAS bf16_t*)(lds + VT_OFF + (d8 + j) * 144 + c * 2) = (bf16_t)((j & 1) ? (vw >> 16) : (vw & 0xffffu)); } }
        if (w == 0) {
#ifdef DN_SLOWGATES
            const float x = pa + dtb; const float sp = x > 20.f ? x : log1pf(expf(x));
#else
            const float x = pa + dtb; const float ex = __expf(x); const float sp = x > 15.f ? x : (ex < 1e-4f ? ex * (1.f - 0.5f * ex) : __logf(1.f + ex));
#endif
            float g = -Aexp * sp;
#pragma unroll
            for (int o = 1; o < 64; o <<= 1) { const float y = __shfl_up(g, o); if (lane >= o) g += y; }
            const float glast = __shfl(g, 63);
#ifdef DN_SLOWGATES
            gc[lane] = g; beta[lane] = 1.f / (1.f + expf(-pb)); eg[lane] = expf(g); ekl[lane] = expf(glast - g);
            if (lane == 0) scal[0] = expf(glast);
#else
            gc[lane] = g; beta[lane] = __builtin_amdgcn_rcpf(1.f + __expf(-pb)); eg[lane] = __expf(g); ekl[lane] = __expf(glast - g);
            if (lane == 0) scal[0] = __expf(glast);
#endif
        }
        __syncthreads();
#ifdef DN_DUP_SOLVE
        for (int rep2 = 0; rep2 < 2; ++rep2) {
#endif
        {
            const int q4 = w & 3, mi = q4 >> 1, nj = q4 & 1;
            f32x16 acc;
#pragma unroll
            for (int r = 0; r < 16; ++r) acc[r] = 0.f;
            const LAS unsigned char* Ab = lds + (w < 4 ? KC_OFF : QC_OFF);
#pragma unroll
            for (int ks = 0; ks < 8; ++ks) { const int kb = (ks * 16 + hi * 8) * 2;
                acc = DN_MFMA(ldf(Ab, 32 * mi + r32, 272, kb), ldf(lds + KC_OFF, 32 * nj + r32, 272, kb), acc); }
            const int j = 32 * nj + r32; const float gcj = gc[j];
            if (w < 4) {
#pragma unroll
                for (int r = 0; r < 16; ++r) { const int i = 32 * mi + crow(r, hi); const float dec = __expf(gc[i] - gcj);
                    MT[i * 65 + j] = (i > j) ? beta[i] * acc[r] * dec : 0.f; }
            } else {
#pragma unroll
                for (int r = 0; r < 16; ++r) { const int i = 32 * mi + crow(r, hi); const float dec = __expf(gc[i] - gcj);
                    *(LAS bf16_t*)(lds + AT_OFF + i * 144 + j * 2) = f2bf((i >= j) ? acc[r] * SCALE * dec : 0.f); }
            }
        }
        __syncthreads();
#ifdef DN_L0X3
        for (int rep3 = 0; rep3 < 3; ++rep3)
#endif
        if (w == 0) {
            const int base = (lane >> 4) * 16, c = lane & 15; float x[16];
#pragma unroll
            for (int i = 0; i < 16; ++i) { float acc = (i == c) ? 1.f : 0.f;
#pragma unroll
                for (int j = 0; j < i; ++j) acc = fmaf(-MT[(base + i) * 65 + base + j], x[j], acc);
                x[i] = acc;
#ifndef DN_E1
                asm volatile("" ::: "memory");
#endif
            }
            LDS_WAIT(); asm volatile("" ::: "memory");
#pragma unroll
            for (int i = 0; i < 16; ++i) MT[(base + i) * 65 + base + c] = x[i];
        }
        __syncthreads();
        {
            const int p = tid >> 8, i = (tid >> 4) & 15, j = tid & 15, R0 = 32 * p + 16, C0 = 32 * p; float y = 0.f;
#pragma unroll
            for (int k = 0; k < 16; ++k) y = fmaf(MT[(R0 + i) * 65 + C0 + k], MT[(C0 + k) * 65 + C0 + j], y);
            YF[(p * 16 + i) * 17 + j] = y;
            __syncthreads();
            float t = 0.f;
#pragma unroll
            for (int k = 0; k < 16; ++k) t = fmaf(MT[(R0 + i) * 65 + R0 + k], YF[(p * 16 + k) * 17 + j], t);
            MT[(R0 + i) * 65 + C0 + j] = -t;
        }
        __syncthreads();
        {
            const int j = tid & 31, i0 = tid >> 5; float y0 = 0.f, y1 = 0.f;
#ifdef DN_E2
#pragma unroll
#else
#pragma unroll 8
#endif
            for (int k = 0; k < 32; ++k) { const float tk = MT[k * 65 + j]; y0 = fmaf(MT[(32 + i0) * 65 + k], tk, y0); y1 = fmaf(MT[(48 + i0) * 65 + k], tk, y1); }
            YF[i0 * 33 + j] = y0; YF[(16 + i0) * 33 + j] = y1;
            __syncthreads();
            float t0 = 0.f, t1 = 0.f;
#ifdef DN_E2
#pragma unroll
#else
#pragma unroll 8
#endif
            for (int k = 0; k < 32; ++k) { const float yk = YF[k * 33 + j]; t0 = fmaf(MT[(32 + i0) * 65 + 32 + k], yk, t0); t1 = fmaf(MT[(48 + i0) * 65 + 32 + k], yk, t1); }
            MT[(32 + i0) * 65 + j] = -t0; MT[(48 + i0) * 65 + j] = -t1;
            { const float bj = beta[j], ej = eg[j];
              *(LAS bf16_t*)(lds + T1_OFF + (32 + i0) * 144 + j * 2) = f2bf(-t0 * bj); *(LAS bf16_t*)(lds + T2_OFF + (32 + i0) * 144 + j * 2) = f2bf(t0 * bj * ej);
              *(LAS bf16_t*)(lds + T1_OFF + (48 + i0) * 144 + j * 2) = f2bf(-t1 * bj); *(LAS bf16_t*)(lds + T2_OFF + (48 + i0) * 144 + j * 2) = f2bf(t1 * bj * ej); }
#pragma unroll 1
            for (int q = 0; q < 6; ++q) { const int idx = tid + NTHR * q; int i, jj;
                if (idx < 2048) { i = idx >> 6; jj = idx & 63; } else { const int r2 = idx - 2048; i = 32 + (r2 >> 5); jj = 32 + (r2 & 31); }
                const float tv = MT[i * 65 + jj] * beta[jj];
                *(LAS bf16_t*)(lds + T1_OFF + i * 144 + jj * 2) = f2bf(tv); *(LAS bf16_t*)(lds + T2_OFF + i * 144 + jj * 2) = f2bf(-tv * eg[jj]); }
        }
        __syncthreads();
#ifdef DN_DUP_SOLVE
        }
#endif
        f32x16 accU, accW;
#pragma unroll
        for (int r = 0; r < 16; ++r) { accU[r] = 0.f; accW[r] = 0.f; }
#pragma unroll
        for (int ks = 0; ks < 4; ++ks) { const int kb = (ks * 16 + hi * 8) * 2;
            accU = DN_MFMA(ldf(lds + T1_OFF, 32 * wr + r32, 144, kb), ldf(lds + VT_OFF, 32 * wc + r32, 144, kb), accU);
            accW = DN_MFMA(ldf(lds + T2_OFF, 32 * wr + r32, 144, kb), ldf(lds + KT_OFF, 32 * wc + r32, 144, kb), accW); }
#pragma unroll
        for (int r = 0; r < 16; ++r) *(LAS bf16_t*)(lds + KC_OFF + (32 * wr + crow(r, hi)) * 272 + (32 * wc + r32) * 2) = f2bf(accW[r]);
        __syncthreads();
#ifdef DN_PF_EARLY
        if (n + 1 < 64) DN_LOADC(n + 1);
#endif
        f32x16 accQ;
#pragma unroll
        for (int r = 0; r < 16; ++r) accQ[r] = 0.f;
#if DN_STAGE >= 5
#pragma unroll 2
        for (int ks = 0; ks < 8; ++ks) { const int kb = (ks * 16 + hi * 8) * 2;
            const bf16x8 bs = ldf(lds + ST_OFF, 32 * wc + r32, 272, kb);
            accU = DN_MFMA(ldf(lds + KC_OFF, 32 * wr + r32, 272, kb), bs, accU);
            accQ = DN_MFMA(ldf(lds + QC_OFF, 32 * wr + r32, 272, kb), bs, accQ); }
#pragma unroll
        for (int rg = 0; rg < 4; ++rg) { const int c0 = 32 * wr + 8 * rg + 4 * hi, e = 32 * wc + r32;
            const f32x4 sc = *(const LAS f32x4*)(ekl + c0);
            u32x2 w1, w2; w1.x = cvt_pk_bf16(accU[4 * rg], accU[4 * rg + 1]); w1.y = cvt_pk_bf16(accU[4 * rg + 2], accU[4 * rg + 3]);
            w2.x = cvt_pk_bf16(accU[4 * rg] * sc.x, accU[4 * rg + 1] * sc.y); w2.y = cvt_pk_bf16(accU[4 * rg + 2] * sc.z, accU[4 * rg + 3] * sc.w);
            *(LAS u32x2*)(lds + VN_OFF + e * 144 + c0 * 2) = w1; *(LAS u32x2*)(lds + VNS_OFF + e * 144 + c0 * 2) = w2; }
#else
        accQ = accU;
#endif
        __syncthreads();
#ifndef DN_PF_EARLY
        if (n + 1 < 64) DN_LOADC(n + 1);
#endif
#if DN_STAGE >= 6
#pragma unroll
        for (int r = 0; r < 16; ++r) accQ[r] *= SCALE * eg[32 * wr + crow(r, hi)];
#pragma unroll
        for (int ks = 0; ks < 4; ++ks) { const int kb = (ks * 16 + hi * 8) * 2;
            accQ = DN_MFMA(ldf(lds + AT_OFF, 32 * wr + r32, 144, kb), ldf(lds + VN_OFF, 32 * wc + r32, 144, kb), accQ); }
#endif
#pragma unroll
        for (int r = 0; r < 16; ++r) { const int c = 32 * wr + crow(r, hi);
            *(LAS bf16_t*)(lds + MT_OFF + c * 256 + (32 * wc + r32) * 2) = f2bf(accQ[r]); }
#if DN_STAGE >= 7
        {
            const float egl = scal[0];
#pragma unroll
            for (int r = 0; r < 16; ++r) { accS[0][r] *= egl; accS[1][r] *= egl; }
#pragma unroll
            for (int ks = 0; ks < 4; ++ks) { const int kb = (ks * 16 + hi * 8) * 2;
                const bf16x8 bsn = ldf(lds + VNS_OFF, 32 * wc + r32, 144, kb);
                accS[0] = DN_MFMA(ldf(lds + KT_OFF, 64 * wr + r32, 144, kb), bsn, accS[0]);
                accS[1] = DN_MFMA(ldf(lds + KT_OFF, 64 * wr + 32 + r32, 144, kb), bsn, accS[1]); }
#pragma unroll
            for (int mb = 0; mb < 2; ++mb)
#pragma unroll
                for (int rg = 0; rg < 4; ++rg) { const int d0 = 64 * wr + 32 * mb + 8 * rg + 4 * hi, e = 32 * wc + r32;
                    u32x2 w1; w1.x = cvt_pk_bf16(accS[mb][4 * rg], accS[mb][4 * rg + 1]); w1.y = cvt_pk_bf16(accS[mb][4 * rg + 2], accS[mb][4 * rg + 3]);
                    *(LAS u32x2*)(lds + ST_OFF + e * 272 + d0 * 2) = w1; }
        }
#endif
        __syncthreads();
#pragma unroll
        for (int i = 0; i < 2; ++i) { const int idx = tid + NTHR * i, c = idx >> 4, e8 = (idx & 15) * 8, p = 64 * n + c, l = dir ? SEQ - 1 - p : p;
            const unsigned oo = ((unsigned)(b * SEQ + l) * 1024u + (unsigned)(h * 128 + e8)) * 2u;
            *(u32x4*)((char*)O + oo) = *(const LAS u32x4*)(lds + MT_OFF + c * 256 + e8 * 2); }
    }
#undef DN_LOADC
}
}
namespace gm {
constexpr int WS_OFF = 0, VT_OFF = 34816, ST_OFF = 69632, SL_OFF = 70656, LN_OFF = 138240;
static_assert(LN_OFF + 16384 <= LDS_BYTES - 64, "gmlp LDS map");
struct Args { const bf16_t* P1; const float* ln_g; const float* ln_b; const float* ws; const float* bs; bf16_t* Z; const float* VST; };
__device__ __forceinline__ void unit(const Args& a, int cu, LAS unsigned char* lds) {
    int tid = threadIdx.x; asm volatile("" : "+v"(tid));
    const int w = __builtin_amdgcn_readfirstlane(tid >> 6), lane = tid & 63, r32 = lane & 31, hi = lane >> 5, wr = w >> 2, wc = w & 3;
    const int t0 = cu * 128;
    LAS float* mean = (LAS float*)(lds + ST_OFF); LAS float* rstd = mean + 128; LAS float* SL = (LAS float*)(lds + SL_OFF);
    LAS float* LG = (LAS float*)(lds + LN_OFF); LAS float* LB = LG + 2048;
    f32x4 pw[8]; u32x4 pvv[4], pu[4], pg[4];
#define GM_LOAD_WV(g_) do { _Pragma("unroll") for (int i_ = 0; i_ < 8; ++i_) { const int idx_ = tid + NTHR * i_; pw[i_] = *(const f32x4*)(a.ws + (size_t)(g_) * 16384 + idx_ * 4); } \
        _Pragma("unroll") for (int i_ = 0; i_ < 4; ++i_) { const int idx_ = tid + NTHR * i_, s_ = idx_ & 127, c8_ = (idx_ >> 7) * 8; \
            pvv[i_] = *(const u32x4*)((const char*)a.P1 + (unsigned)(((t0 + s_) * N1 + 2048 + (g_) * 128 + c8_) * 2)); } } while (0)
#define GM_LOAD_UG(g_) do { _Pragma("unroll") for (int i_ = 0; i_ < 4; ++i_) { const int idx_ = tid + NTHR * i_, t_ = idx_ >> 4, c8_ = (idx_ & 15) * 8; \
            const char* pr_ = (const char*)a.P1 + (unsigned)(((t0 + t_) * N1 + (g_) * 128 + c8_) * 2); pu[i_] = *(const u32x4*)pr_; pg[i_] = *(const u32x4*)(pr_ + 8192); } } while (0)
    __syncthreads();
    GM_LOAD_WV(0);
    for (int i = tid; i < 512; i += NTHR) { *(LAS f32x4*)(LG + i * 4) = *(const f32x4*)(a.ln_g + i * 4); *(LAS f32x4*)(LB + i * 4) = *(const f32x4*)(a.ln_b + i * 4); }
    { typedef float f32x2v __attribute__((ext_vector_type(2))); f32x2v pr[16];
#pragma unroll
      for (int q = 0; q < 16; ++q) pr[q] = (lane < 32) ? *(const f32x2v*)(a.VST + ((size_t)(t0 + w * 16 + q) * 32 + lane) * 2) : (f32x2v){0.f, 0.f};
#pragma unroll
      for (int q = 0; q < 16; ++q) { const float S1 = wave_sum(pr[q].x), S2 = wave_sum(pr[q].y); const float mu = S1 * (1.f / 2048.f);
          const float var = fmaxf(S2 * (1.f / 2048.f) - mu * mu, 0.f); if (lane == 0) { mean[w * 16 + q] = mu; rstd[w * 16 + q] = 1.0f / sqrtf(var + EPS); } } }
    __syncthreads();
    for (int g = 0; g < 16; ++g) {
#ifndef GM_UG_LATE
        GM_LOAD_UG(g);
#endif
#pragma unroll
        for (int i = 0; i < 8; ++i) { const int idx = tid + NTHR * i, t = idx >> 5, s4 = (idx & 31) * 4;
            u32x2 o; o.x = cvt_pk_bf16(pw[i].x, pw[i].y); o.y = cvt_pk_bf16(pw[i].z, pw[i].w); *(LAS u32x2*)(lds + WS_OFF + t * 272 + s4 * 2) = o; }
#pragma unroll
        for (int i = 0; i < 4; ++i) { const int idx = tid + NTHR * i, s = idx & 127, c8 = (idx >> 7) * 8; float x[8];
            unpack8(pvv[i], x);
            const float mu = mean[s], rs = rstd[s];
            const f32x4 g0 = *(const LAS f32x4*)(LG + g * 128 + c8), g1 = *(const LAS f32x4*)(LG + g * 128 + c8 + 4), b0 = *(const LAS f32x4*)(LB + g * 128 + c8), b1 = *(const LAS f32x4*)(LB + g * 128 + c8 + 4);
            const float gg[8] = {g0.x, g0.y, g0.z, g0.w, g1.x, g1.y, g1.z, g1.w}, bb[8] = {b0.x, b0.y, b0.z, b0.w, b1.x, b1.y, b1.z, b1.w};
#pragma unroll
            for (int j = 0; j < 8; ++j) *(LAS bf16_t*)(lds + VT_OFF + (c8 + j) * 272 + s * 2) = f2bf((x[j] - mu) * rs * gg[j] + bb[j]); }
        __syncthreads();
        if (g + 1 < 16) GM_LOAD_WV(g + 1);
#ifdef GM_UG_LATE
        GM_LOAD_UG(g);
#endif
        f32x16 acc[2];
#pragma unroll
        for (int r = 0; r < 16; ++r) { acc[0][r] = 0.f; acc[1][r] = 0.f; }
#pragma unroll
        for (int ks = 0; ks < 8; ++ks) { const int kb = (ks * 16 + hi * 8) * 2;
            const bf16x8 bv = *(const LAS bf16x8*)(lds + VT_OFF + (32 * wc + r32) * 272 + kb);
            acc[0] = __builtin_amdgcn_mfma_f32_32x32x16_bf16(*(const LAS bf16x8*)(lds + WS_OFF + (64 * wr + r32) * 272 + kb), bv, acc[0], 0, 0, 0);
            acc[1] = __builtin_amdgcn_mfma_f32_32x32x16_bf16(*(const LAS bf16x8*)(lds + WS_OFF + (64 * wr + 32 + r32) * 272 + kb), bv, acc[1], 0, 0, 0); }
#pragma unroll
        for (int mb = 0; mb < 2; ++mb) { const float* bsp = a.bs + g * 128 + 64 * wr + 32 * mb + 4 * hi;
#pragma unroll
            for (int r = 0; r < 16; ++r) { const int t = 64 * wr + 32 * mb + crow(r, hi);
                SL[t * 132 + 32 * wc + r32] = acc[mb][r] + bsp[(r & 3) + 8 * (r >> 2)]; } }
        __syncthreads();
#pragma unroll
        for (int i = 0; i < 4; ++i) { const int idx = tid + NTHR * i, t = idx >> 4, c8 = (idx & 15) * 8, col = g * 128 + c8; float uu[8], gt[8];
            unpack8(pu[i], uu); unpack8(pg[i], gt);
            const f32x4 s0 = *(const LAS f32x4*)(SL + t * 132 + c8), s1 = *(const LAS f32x4*)(SL + t * 132 + c8 + 4);
            const float sv[8] = {s0.x, s0.y, s0.z, s0.w, s1.x, s1.y, s1.z, s1.w};
#pragma unroll
            for (int e = 0; e < 8; ++e) uu[e] = uu[e] * sv[e] * silu_f(gt[e]);
            *(u32x4*)((char*)a.Z + (unsigned)(((t0 + t) * DM + col) * 2)) = pack8(uu); }
    }
#undef GM_LOAD_WV
#undef GM_LOAD_UG
}
}

#define XB_TMO      128
#define XB_XCNT(j)  (256  + 64 * (j))
#define XB_XSUB(j)  (1280 + 64 * (j))
#define XB_XGEN(j)  (2304 + 64 * (j))
#define XB_TOP      3328
#define XB_TOPGEN   3392
#define XCD_BAR_WORDS 3456
#define XB_SPIN_CAP (1u << 18)

__device__ __forceinline__ unsigned xb_ld(unsigned* p)              { return __hip_atomic_load(p, __ATOMIC_RELAXED, __HIP_MEMORY_SCOPE_AGENT); }
__device__ __forceinline__ unsigned xb_add(unsigned* p, unsigned v) { return __hip_atomic_fetch_add(p, v, __ATOMIC_RELAXED, __HIP_MEMORY_SCOPE_AGENT); }
__device__ __forceinline__ unsigned xb_xcc_id() { return (unsigned)__builtin_amdgcn_s_getreg((3 << 11) | 20) & 0xFu; }
#define XB_SPIN(cond, bar) do { unsigned _sp = 0; while (cond) { __builtin_amdgcn_s_sleep(1); \
    if ((++_sp & 255u) == 0u) { if (xb_ld(&(bar)[XB_TMO])) break; if (_sp > XB_SPIN_CAP) { atomicAdd(&(bar)[XB_TMO], 1u); break; } } } } while (0)

struct XcdBarrier {
    unsigned* bar; unsigned x;
    volatile LAS unsigned* st;
};

__device__ __forceinline__ XcdBarrier xcd_barrier_post(unsigned* bar, volatile LAS unsigned* st) {
    XcdBarrier b; b.bar = bar; b.x = xb_xcc_id(); b.st = st;
    if (threadIdx.x == 0) (void)xb_add(&bar[XB_XCNT(b.x)], 1u);
    return b;
}
__device__ __forceinline__ void xcd_barrier_complete(unsigned* bar, unsigned x, unsigned& nloc, unsigned& nx) {
    const unsigned G = gridDim.x * gridDim.y * gridDim.z;
    unsigned sum, cnt, mine, sp = 0u;
    for (;;) {
        sum = 0u; cnt = 0u; mine = 0u;
#pragma unroll
        for (unsigned j = 0; j < 16; ++j) { const unsigned c = xb_ld(&bar[XB_XCNT(j)]); sum += c; cnt += (c > 0u) ? 1u : 0u; mine = (j == x) ? c : mine; }
        if (sum == G) break;
        __builtin_amdgcn_s_sleep(1);
        if ((++sp & 255u) == 0u) { if (xb_ld(&bar[XB_TMO])) break; if (sp > XB_SPIN_CAP) { atomicAdd(&bar[XB_TMO], 1u); break; } }
    }
    nloc = mine > 0u ? mine : 1u; nx = cnt > 0u ? cnt : 1u;
}

__device__ __forceinline__ void xcd_barrier(const XcdBarrier& b) {
    asm volatile("s_waitcnt vmcnt(0)" ::: "memory");
    __syncthreads();
    if (threadIdx.x == 0) {
        unsigned* bar = b.bar;
        __builtin_amdgcn_s_waitcnt(0);
        unsigned nloc = b.st[0], nx = b.st[1];
        if (nloc == 0u) { xcd_barrier_complete(bar, b.x, nloc, nx); b.st[0] = nloc; b.st[1] = nx; }
        const unsigned old = xb_add(&bar[XB_XSUB(b.x)], 1u);
        const unsigned gen = old / nloc;
        if (old + 1u == (gen + 1u) * nloc) {
            __builtin_amdgcn_fence(__ATOMIC_RELEASE, "agent");
            asm volatile("s_waitcnt vmcnt(0)" ::: "memory");
            const unsigned og = xb_add(&bar[XB_TOP], 1u);
            const unsigned tg = og / nx;
            if (og + 1u == (tg + 1u) * nx) xb_add(&bar[XB_TOPGEN], 1u);
            else XB_SPIN(xb_ld(&bar[XB_TOPGEN]) == tg, bar);
            __builtin_amdgcn_fence(__ATOMIC_ACQUIRE, "agent");
            xb_add(&bar[XB_XGEN(b.x)], 1u);
            asm volatile("s_waitcnt vmcnt(0)" ::: "memory");
        } else {
            XB_SPIN(xb_ld(&bar[XB_XGEN(b.x)]) == gen, bar);
            __builtin_amdgcn_fence(__ATOMIC_ACQUIRE, "agent");
            asm volatile("s_waitcnt vmcnt(0)" ::: "memory");
        }
    }
    __syncthreads();
}

struct KArgs { const float* in[17]; float* out; unsigned char* ws; int ph_lo, ph_hi; };
#ifndef PROBE_END
#define PROBE_END 10
#endif
#ifndef DUMP_OFF
#define DUMP_OFF 0
#define DUMP_N 0
#endif
#ifndef DUP_PHASE
#define DUP_PHASE -1
#endif
#ifndef DUP_N
#define DUP_N 2
#endif
#define REPS(k) for (int rep_ = 0; rep_ < ((DUP_PHASE == (k)) ? DUP_N : 1); ++rep_)
#define REPSYNC(k) do { if (DUP_PHASE == (k) && rep_ + 1 < DUP_N) cg::this_grid().sync(); } while (0)
#ifndef PG_ALIGN59
#define PG_ALIGN59 true
#endif
#ifndef PG_ALIGN17
#define PG_ALIGN17 true
#endif
constexpr int NPHASES = 10;
__global__ void __launch_bounds__(NTHR, 2) fwd_megakernel(KArgs A) {
    __builtin_assume(__builtin_amdgcn_workitem_id_y() == 0); __builtin_assume(__builtin_amdgcn_workitem_id_z() == 0);
    extern __shared__ __attribute__((aligned(16))) unsigned char lds_raw[];
    LAS unsigned char* lds = (LAS unsigned char*)lds_raw;
    const int tid = threadIdx.x, lane = tid & 63, wave = __builtin_amdgcn_readfirstlane(tid >> 6);
    const int G = gridDim.x, bx = blockIdx.x, gw = bx * NWAVES + wave, NGW = G * NWAVES;
    unsigned char* ws = A.ws;
    const float* x = A.in[0];
    bf16_t* W0T = (bf16_t*)(ws + WS_W0T); bf16_t* WO0T = (bf16_t*)(ws + WS_WO0T); bf16_t* W1T = (bf16_t*)(ws + WS_W1T); bf16_t* WO1T = (bf16_t*)(ws + WS_WO1T);
    bf16_t* H = (bf16_t*)(ws + WS_H); bf16_t* PROJ = (bf16_t*)(ws + WS_PROJ); float* LOG = (float*)(ws + WS_LOG); bf16_t* QKV = (bf16_t*)(ws + WS_QKV); bf16_t* YCAT = (bf16_t*)(ws + WS_YCAT);
    bf16_t* OF = H; bf16_t* OB = H + (size_t)TOK * 1024; float* PART = (float*)(ws + WS_PART); float* RSTD = (float*)(ws + WS_RSTD);
    const int lo = A.ph_lo, hi = A.ph_hi;
    volatile LAS unsigned* xst = (volatile LAS unsigned*)(lds + LDS_BYTES - 32);
    if (tid < 2) xst[tid] = 0u;
    __syncthreads();
    XcdBarrier xbar; xbar.bar = (unsigned*)(ws + WS_BAR); xbar.x = 0; xbar.st = xst;
    if (MK_LAUNCHES == 1) xbar = xcd_barrier_post((unsigned*)(ws + WS_BAR), xst);
    if (A.ph_lo < 0) cg::this_grid().sync();
#ifndef PHMASK
#define PHMASK 0x3ff
#endif
#define IN(k) (((PHMASK >> (k)) & 1) && lo <= (k) && (k) < hi)
#ifndef SYNC_REPS
#define SYNC_REPS 1
#endif
#define SEAM(k) do { if (IN(k) && IN((k) + 1)) { for (int sr_ = 0; sr_ < SYNC_REPS; ++sr_) { if (MK_LAUNCHES != 1) cg::this_grid().sync(); else xcd_barrier(xbar); } } } while (0)
    if (IN(0)) REPS(0) { P0Args p{x, A.in[1], A.in[10], A.in[2], A.in[9], A.in[11], A.in[16], W0T, WO0T, W1T, WO1T, H}; p0_prologue(p, lds, gw, NGW, wave, lane); __syncthreads(); REPSYNC(0); }
    SEAM(0);
    if (IN(1)) REPS(1) { { pg8::Gemm g{H, W0T, TOK, P0LD, DM, DM}; pg8::StaticOrder S; S.init(TOK, P0LD, G, bx); pg8::Epi0 E{PROJ, LOG};
            pg8::gemm_phase<pg8::Epi0, pg8::StaticOrder, PG_ALIGN17, true>(lds, g, S, E); }
        for (int hu = bx; hu < 2 * (TOK / 256); hu += G) { const int kh = hu & 1;
            pg8::Gemm g{H + kh * (DM / 2), W0T + (size_t)P0LD * DM + kh * (DM / 2), TOK, 256, DM / 2, DM}; pg8::OneUnit S{hu >> 1}; pg8::EpiLog E{LOG + (size_t)kh * TOK * 32};
            pg8::gemm_phase<pg8::EpiLog, pg8::OneUnit, true, true>(lds, g, S, E); }
        REPSYNC(1); }
    SEAM(1);
    if (IN(2)) {
        REPS(2) { for (int it = gw; it < (TOK / 16) * 6; it += NGW) p2_conv_item(PROJ, A.in[3], QKV, it, lane); REPSYNC(2); }
        for (int t = gw; t < TOK; t += 2 * NGW) p2_rope_tokens<2>(PROJ, A.in[7], A.in[8], t, NGW, lane);
    }
    SEAM(2);
    if (IN(3)) REPS(3) {
        const int nq = 1, qx = 0, DNQ = 128 / nq, ATQ = 1024 / nq;
        int* ctr = (int*)(ws + WS_CTL) + 16 * qx + 128 * rep_; LAS int* slot = (LAS int*)(lds + LDS_BYTES - 16);
        int* dn_done = (int*)(ws + WS_CTL) + 512 + 64 * rep_; int* p4ctr = (int*)(ws + WS_CTL) + 768 + 64 * rep_;
#define FETCH4(item) do { __syncthreads(); if (tid == 0) *slot = atomicAdd(p4ctr, 1); __syncthreads(); item = __builtin_amdgcn_readfirstlane(*slot); } while (0)
        dn::Args da{QKV, LOG, A.in[4], A.in[5], OF, OB};
#define FETCH(item) do { __syncthreads(); if (tid == 0) *slot = atomicAdd(ctr, 1); __syncthreads(); item = __builtin_amdgcn_readfirstlane(*slot); } while (0)
        int item;
#if DUP_PHASE == 31
        for (int r31 = 0; r31 < DUP_N - 1; ++r31) { int* ctr0 = ctr; ctr = (int*)(ws + WS_CTL) + 128 + 64 * r31; FETCH(item); while (item < 128) { dn::unit(da, item, lds); FETCH(item); } ctr = ctr0; cg::this_grid().sync(); }
#endif
#if DUP_PHASE == 32
        { int* ctr0 = ctr; ctr = (int*)(ws + WS_CTL) + 128; FETCH(item); item += 128;
          while (item < DNQ + ATQ) { const int ai = qx * ATQ + (item - DNQ), qb = ai & 15, gq = (ai >> 4) & 3, kvh = (ai >> 6) & 1, b = ai >> 7, h = kvh * 4 + gq;
            const size_t r0 = (size_t)(b * SEQ + qb * 256);
            att::attn_dense_body(PROJ + r0 * P0LD + C_BQ + h * 128, PROJ + (size_t)(b * SEQ) * P0LD + C_BK + kvh * 128, PROJ + (size_t)(b * SEQ) * P0LD + C_BV + kvh * 128,
                                 PROJ + r0 * P0LD + C_BG + h * 128, YCAT + r0 * DM + 1024 + h * 128, SEQ, (char*)lds_raw);
            FETCH(item); item += 128; }
          ctr = ctr0; cg::this_grid().sync(); }
#endif
        FETCH(item);
#ifndef SKIP_DN
        while (item < DNQ) { dn::unit(da, qx * DNQ + item, lds);
            asm volatile("s_waitcnt vmcnt(0)" ::: "memory");
            __syncthreads(); if (tid == 0) { __threadfence(); atomicAdd(dn_done, 1); }
            FETCH(item); }
#endif
#ifndef SKIP_ATT
        while (item < DNQ + ATQ) { const int ai = qx * ATQ + (item - DNQ), qb = ai & 15, gq = (ai >> 4) & 3, kvh = (ai >> 6) & 1, b = ai >> 7, h = kvh * 4 + gq;
            const size_t r0 = (size_t)(b * SEQ + qb * 256);
            att::attn_dense_body(PROJ + r0 * P0LD + C_BQ + h * 128, PROJ + (size_t)(b * SEQ) * P0LD + C_BK + kvh * 128, PROJ + (size_t)(b * SEQ) * P0LD + C_BV + kvh * 128,
                                 PROJ + r0 * P0LD + C_BG + h * 128, YCAT + r0 * DM + 1024 + h * 128, SEQ, (char*)lds_raw);
            FETCH(item); }
#endif
        if (tid == 0) { while (__hip_atomic_load(dn_done, __ATOMIC_RELAXED, __HIP_MEMORY_SCOPE_AGENT) < 128) __builtin_amdgcn_s_sleep(16);
            __threadfence(); }
        __syncthreads();
        for (;;) { int c4; FETCH4(c4); if (c4 >= TOK / 128) break;
            for (int q = 0; q < 16; q += 4) p4_tokens<4>(OF, OB, PROJ, A.in[6], YCAT, c4 * 128 + wave * 16 + q, lane); }
        REPSYNC(3);
    }
    SEAM(3);
    if (IN(5)) REPS(5) { pg8::Gemm g{YCAT, WO0T, TOK, DM, DM, DM}; pg8::StaticOrder S; S.init(TOK, DM, G, bx); pg8::EpiRes0 E{x, H, PART};
        pg8::gemm_phase<pg8::EpiRes0, pg8::StaticOrder, PG_ALIGN59, true>(lds, g, S, E); REPSYNC(5); }
    SEAM(5);
    if (IN(6)) REPS(6) { for (int r = bx * NTHR + tid; r < TOK; r += G * NTHR) { const f32x4* pp = (const f32x4*)(PART + (size_t)r * 32); float ss = 0.f;
#pragma unroll
            for (int j = 0; j < 8; ++j) { const f32x4 v = pp[j]; ss += (v.x + v.y) + (v.z + v.w); }
            RSTD[r] = 1.0f / sqrtf(ss * (1.f / DM) + EPS); } REPSYNC(6); }
    SEAM(6);
    if (IN(7)) REPS(7) { pg8::Gemm g{H, W1T, TOK, N1, DM, DM}; pg8::StaticOrder S; S.init(TOK, N1, G, bx); pg8::Epi1 E{PROJ, RSTD, (float*)(ws + WS_VST)};
        pg8::gemm_phase<pg8::Epi1, pg8::StaticOrder, PG_ALIGN17, true>(lds, g, S, E); REPSYNC(7); }
    SEAM(7);
    if (IN(8)) REPS(8) { gm::Args ga{PROJ, A.in[12], A.in[13], A.in[14], A.in[15], YCAT, (const float*)(ws + WS_VST)};
        for (int cu = bx; cu < TOK / 128; cu += G) gm::unit(ga, cu, lds); REPSYNC(8); }
    SEAM(8);
    if (IN(9)) { pg8::Gemm g{YCAT, WO1T, TOK, DM, DM, DM}; pg8::StaticOrder S; S.init(TOK, DM, G, bx); pg8::EpiRes1 E{H, A.out};
        pg8::gemm_phase<pg8::EpiRes1, pg8::StaticOrder, PG_ALIGN59, true>(lds, g, S, E); }
#if PROBE_END < 10
    if (lo <= 10 && 10 < hi) { const bf16_t* src = (const bf16_t*)(ws + (size_t)DUMP_OFF); const size_t n = (size_t)DUMP_N, NO = (size_t)TOK * DM;
        for (size_t i = (size_t)bx * NTHR + tid; i < NO; i += (size_t)G * NTHR) { float acc = 0.f; for (size_t k = i; k < n; k += NO) { float v = bf2f(src[k]); if (!(fabsf(v) < 1e30f)) v = 7777.f; acc += v; } A.out[i] = acc; } }
#endif
}

extern "C" void kernel_launch(void* const* d_in, const int* in_sizes, int n_in, void* d_out, int out_size, void* d_ws, size_t ws_size, hipStream_t stream) {
    static int grid = 0;
    if (grid == 0) {
        if (n_in != 17 || in_sizes[0] != TOK * DM || out_size != TOK * DM || ws_size < WS_END) { fprintf(stderr, "kernel_launch: shape/workspace mismatch (n_in %d, ws %zu < %zu)\n", n_in, ws_size, (size_t)WS_END); grid = -1; return; }
        int dev = 0, cus = 0, per_cu = 0;
        (void)hipGetDevice(&dev); (void)hipDeviceGetAttribute(&cus, hipDeviceAttributeMultiprocessorCount, dev);
        if (hipFuncSetAttribute((const void*)fwd_megakernel, hipFuncAttributeMaxDynamicSharedMemorySize, LDS_BYTES) != hipSuccess) { fprintf(stderr, "hipFuncSetAttribute failed\n"); grid = -1; return; }
        if (hipOccupancyMaxActiveBlocksPerMultiprocessor(&per_cu, (const void*)fwd_megakernel, NTHR, LDS_BYTES) != hipSuccess || per_cu < 1) per_cu = 1;
        grid = cus * per_cu;
        fprintf(stderr, "kernel_launch: grid %d (%d CUs x %d)\n", grid, cus, per_cu);
    }
    if (grid < 0) return;
    (void)hipMemsetAsync((char*)d_ws + WS_CTL, 0, WS_CTL_BYTES, stream);
    KArgs a{};
    for (int i = 0; i < 17; ++i) a.in[i] = (const float*)d_in[i];
    a.out = (float*)d_out; a.ws = (unsigned char*)d_ws;
#if MK_LAUNCHES == 1
    a.ph_lo = 0; a.ph_hi = NPHASES;
    void* args[] = {&a};
    hipError_t e = hipLaunchCooperativeKernel((void*)fwd_megakernel, dim3(grid), dim3(NTHR), args, LDS_BYTES, stream);
    if (e != hipSuccess) fprintf(stderr, "cooperative launch failed: %s (grid %d)\n", hipGetErrorString(e), grid);
#else
    for (int p = 0; p < PROBE_END; ++p) { a.ph_lo = p; a.ph_hi = p + 1; hipLaunchKernelGGL(fwd_megakernel, dim3(grid), dim3(NTHR), LDS_BYTES, stream, a); }
#if PROBE_END < 10
    a.ph_lo = 10; a.ph_hi = 11; hipLaunchKernelGGL(fwd_megakernel, dim3(grid), dim3(NTHR), LDS_BYTES, stream, a);
#endif
#endif
}
```

```cpp
#include <hip/hip_runtime.h>
#include <hip/hip_cooperative_groups.h>
#include <cstdio>
#include <cstdint>
namespace cg = cooperative_groups;
#ifndef MK_LAUNCHES
#define MK_LAUNCHES 1
#define DUP_PHASE -1
#define LATE_W 1
#endif
namespace pg8 {
#define PG8_LAS __attribute__((address_space(3)))
typedef unsigned short bf16_t;
typedef short bf16x8 __attribute__((ext_vector_type(8)));
typedef float f32x4 __attribute__((ext_vector_type(4)));
typedef unsigned u32x4 __attribute__((ext_vector_type(4)));
constexpr int BM = 256, BK = 64, HALF = 128, HTB = HALF * BK * 2  , STAGE_BYTES = 8 * HTB, NXCD = 8, WGM = 4;

__host__ __device__ __forceinline__ int lds_byte(int r, int c) { const int st = (r >> 4) * 2 + (c >> 5), rr = r & 15, cc = c & 31, ob = rr * 64 + cc * 2; return st * 1024 + (ob ^ (((ob >> 9) & 1) << 5)); }
__host__ __device__ __forceinline__ void stage_rc(int b, int& R, int& C) { const int st = b / 1024, sb = b % 1024, swz = sb ^ (((sb >> 9) & 1) << 5); R = (st >> 1) * 16 + swz / 64; C = (st & 1) * 32 + (swz % 64) / 2; }
__host__ __device__ __forceinline__ int perm32(int rho) { const int n = rho >> 4, i = rho & 15; return 8 * (i >> 2) + 4 * n + (i & 3); }

struct Unit { int pm, pn; };
struct Gemm { const bf16_t* A; const bf16_t* Bt; int M, N, K, ld; };

struct StaticOrder {
    int nM, nN, nwg, G, c;
    __host__ __device__ void init(int M, int N, int G_, int c_) { nM = M / BM; nN = N / BM; nwg = nM * nN; G = G_; c = c_; }
    __host__ __device__ bool next(int i, Unit& u) const {
        const long L = (long)i * G + c; if (L >= nwg) return false;
        int wgid = (int)L; { const int q = nwg / NXCD, r = nwg % NXCD, xcd = wgid % NXCD, off = wgid / NXCD; wgid = (xcd < r ? xcd * (q + 1) : r * (q + 1) + (xcd - r) * q) + off; }
        const int nig = WGM * nN, gid = wgid / nig, fm = gid * WGM, gsz = (nM - fm) < WGM ? (nM - fm) : WGM;
        u.pm = fm + ((wgid % nig) % gsz); u.pn = (wgid % nig) / gsz; return true;
    }
    __device__ __forceinline__ void a_ready(const Unit&) const {}
    __device__ __forceinline__ void done(const Unit&) const {}
};

typedef float f32x2c_t __attribute__((ext_vector_type(2))); typedef __bf16 bf16x2c_t __attribute__((ext_vector_type(2)));
__device__ __forceinline__ unsigned cvt_pk_bf16(float lo, float hi) { f32x2c_t v = {lo, hi}; bf16x2c_t b = __builtin_convertvector(v, bf16x2c_t); return __builtin_bit_cast(unsigned, b); }
typedef float f32x2 __attribute__((ext_vector_type(2)));
__device__ __forceinline__ f32x2 gelu_pk(f32x2 v) {
    const f32x2 av = __builtin_elementwise_abs(v), d = av * 0.2316418882f + 1.0f;
    f32x2 t; t.x = __builtin_amdgcn_rcpf(d.x); t.y = __builtin_amdgcn_rcpf(d.y);
    f32x2 q = t * 0.5307027145f + (-0.7265760135f); q = q * t + 0.7107068705f; q = q * t + (-0.142248368f); q = q * t + 0.127414796f; q = q * t;
    const f32x2 s = (v * v) * (-0.72134752044f);
    f32x2 e; e.x = __builtin_amdgcn_exp2f(s.x); e.y = __builtin_amdgcn_exp2f(s.y);
    const f32x2 m = v * (q * e), r = v - m;
    f32x2 o; o.x = v.x < 0.f ? m.x : r.x; o.y = v.y < 0.f ? m.y : r.y; return o;
}

template <class Epi, class Sched, bool ALIGN_EPI = false, bool SP2 = false>
__device__ __forceinline__ void gemm_phase(PG8_LAS unsigned char* lds, const Gemm g, const Sched& S, const Epi& E) {
    const int tid = threadIdx.x, wid = __builtin_amdgcn_readfirstlane(tid >> 6), lane = tid & 63, wr = wid >> 2, wc = wid & 3, fr = lane & 15, fq = lane >> 4;
    const int K = g.ld, nt = g.K / BK;
    unsigned voffA[2], voffB[2];
#pragma unroll
    for (int i = 0; i < 2; ++i) { int R, C; stage_rc(tid * 16 + i * 8192, R, C); const int Rb = Epi::PERM ? ((R & ~31) + perm32(R & 31)) : R;
        voffA[i] = (unsigned)(R * K + C) * 2u; voffB[i] = (unsigned)(Rb * K + C) * 2u; }
    const size_t kstep = (size_t)(BK * 2);
    const size_t hstep = (size_t)HALF * K * 2;
    const size_t tstep = 2 * hstep;
    const unsigned ldsw = (unsigned)wid * 1024u;
    const int aoff = lds_byte(wr * 64 + fr, fq * 8), boff = lds_byte(wc * 32 + fr, fq * 8);
#define PG8_SA(b, h) (((b) * 2 + (h)) * HTB)
#define PG8_SB(b, h) ((4 + (b) * 2 + (h)) * HTB)
#define PG8_STAGE(bufoff, gbase, voff) do { _Pragma("unroll") for (int _i = 0; _i < 2; ++_i) \
        __builtin_amdgcn_global_load_lds((const unsigned*)((const char*)(gbase) + (voff)[_i]), (PG8_LAS unsigned*)(lds + (bufoff) + ldsw + _i * 8192), 16, 0, 0); } while (0)
#define PG8_LDA(dst, b, h) do { _Pragma("unroll") for (int m = 0; m < 4; ++m) _Pragma("unroll") for (int k = 0; k < 2; ++k) dst[m][k] = *(const PG8_LAS bf16x8*)(lds + PG8_SA(b, h) + aoff + m * 2048 + k * 1024); } while (0)
#define PG8_LDB(dst, b, h) do { _Pragma("unroll") for (int n = 0; n < 2; ++n) _Pragma("unroll") for (int k = 0; k < 2; ++k) dst[n][k] = *(const PG8_LAS bf16x8*)(lds + PG8_SB(b, h) + boff + n * 2048 + k * 1024); } while (0)
#define PG8_MMA(ai, bj, At, Bt) do { __builtin_amdgcn_s_setprio(1); _Pragma("unroll") for (int m = 0; m < 4; ++m) _Pragma("unroll") for (int n = 0; n < 2; ++n) _Pragma("unroll") for (int k = 0; k < 2; ++k) \
        acc[ai][bj][m][n] = __builtin_amdgcn_mfma_f32_16x16x32_bf16(Bt[n][k], At[m][k], acc[ai][bj][m][n], 0, 0, 0); __builtin_amdgcn_s_setprio(0); } while (0)
#define PG8_WAIT_V(n) asm volatile("s_waitcnt vmcnt(" #n ")" ::: "memory")
#define PG8_WAIT_L(n) asm volatile("s_waitcnt lgkmcnt(" #n ")" ::: "memory")
#define PG8_BAR __builtin_amdgcn_s_barrier()
#define PG8_SCHED __builtin_amdgcn_sched_barrier(0)
    Unit cur, nxt; int ui = 0;
    if (!S.next(0, cur)) return;
    f32x4 acc[2][2][4][2];
#pragma unroll
    for (int a = 0; a < 2; ++a)
#pragma unroll
        for (int b = 0; b < 2; ++b)
#pragma unroll
            for (int m = 0; m < 4; ++m)
#pragma unroll
                for (int n = 0; n < 2; ++n) acc[a][b][m][n] = (f32x4){0.f, 0.f, 0.f, 0.f};
    bf16x8 At[4][2], B0[2][2], B1[2][2];
    const char* cA = (const char*)g.A + (size_t)cur.pm * tstep; const char* cB = (const char*)g.Bt + (size_t)cur.pn * tstep;
    S.a_ready(cur);
    if constexpr (SP2) {
        PG8_STAGE(PG8_SB(0, 0), cB, voffB); PG8_STAGE(PG8_SB(0, 1), cB + hstep, voffB); PG8_STAGE(PG8_SA(0, 0), cA, voffA); PG8_STAGE(PG8_SA(0, 1), cA + hstep, voffA);
        if (wr == 1) PG8_BAR;
        PG8_WAIT_V(2); PG8_BAR;
        PG8_STAGE(PG8_SB(1, 0), cB + kstep, voffB); PG8_STAGE(PG8_SA(1, 0), cA + kstep, voffA); PG8_STAGE(PG8_SB(1, 1), cB + hstep + kstep, voffB);
        PG8_WAIT_V(6); PG8_BAR;
    } else {
        PG8_STAGE(PG8_SB(0, 0), cB, voffB); PG8_STAGE(PG8_SA(0, 0), cA, voffA); PG8_STAGE(PG8_SB(0, 1), cB + hstep, voffB); PG8_STAGE(PG8_SA(0, 1), cA + hstep, voffA);
        if (wr == 1) PG8_BAR;
        PG8_WAIT_V(4); PG8_BAR;
        PG8_STAGE(PG8_SB(1, 0), cB + kstep, voffB); PG8_STAGE(PG8_SA(1, 0), cA + kstep, voffA); PG8_STAGE(PG8_SB(1, 1), cB + hstep + kstep, voffB);
        PG8_WAIT_V(6); PG8_BAR;
    }
    for (;;) {
        const bool has_next = S.next(ui + 1, nxt);
        const char* nA = has_next ? (const char*)g.A + (size_t)nxt.pm * tstep : cA; const char* nB = has_next ? (const char*)g.Bt + (size_t)nxt.pn * tstep : cB;
        for (int t = 0; t < nt; t += 2) {
            const bool last = (t == nt - 2);
            const char* a1 = cA + (size_t)(t + 1) * kstep;
            const char* a2 = last ? nA : cA + (size_t)(t + 2) * kstep; const char* b2 = last ? nB : cB + (size_t)(t + 2) * kstep;
            const char* a3 = a2 + kstep; const char* b3 = b2 + kstep;
            if (last && has_next) S.a_ready(nxt);
            if constexpr (SP2) {
            PG8_LDB(B0, 0, 0); PG8_LDB(B1, 0, 1); PG8_SCHED; PG8_LDA(At, 0, 0); PG8_STAGE(PG8_SA(1, 1), a1 + hstep, voffA);
            PG8_WAIT_V(8); PG8_WAIT_L(0); PG8_BAR; PG8_MMA(0, 0, At, B0); PG8_MMA(0, 1, At, B1); PG8_BAR; PG8_SCHED;
            PG8_LDA(At, 0, 1); PG8_STAGE(PG8_SB(0, 0), b2, voffB); PG8_STAGE(PG8_SB(0, 1), b2 + hstep, voffB); PG8_STAGE(PG8_SA(0, 0), a2, voffA);
            PG8_WAIT_V(8); PG8_WAIT_L(0); PG8_BAR; PG8_MMA(1, 0, At, B0); PG8_MMA(1, 1, At, B1); PG8_BAR; PG8_SCHED;
            PG8_LDB(B0, 1, 0); PG8_LDB(B1, 1, 1); PG8_SCHED; PG8_LDA(At, 1, 0); PG8_STAGE(PG8_SA(0, 1), a2 + hstep, voffA);
            PG8_WAIT_V(8); PG8_WAIT_L(0); PG8_BAR; PG8_MMA(0, 0, At, B0); PG8_MMA(0, 1, At, B1); PG8_BAR; PG8_SCHED;
            PG8_LDA(At, 1, 1); PG8_STAGE(PG8_SB(1, 0), b3, voffB); PG8_STAGE(PG8_SB(1, 1), b3 + hstep, voffB); PG8_STAGE(PG8_SA(1, 0), a3, voffA);
            PG8_WAIT_V(8); PG8_WAIT_L(0); PG8_BAR; PG8_MMA(1, 0, At, B0); PG8_MMA(1, 1, At, B1); PG8_BAR; PG8_SCHED;
            } else {
            PG8_LDB(B0, 0, 0); PG8_SCHED; PG8_LDA(At, 0, 0); PG8_STAGE(PG8_SA(1, 1), a1 + hstep, voffA);
            PG8_WAIT_L(8); PG8_BAR; PG8_WAIT_L(0); PG8_MMA(0, 0, At, B0); PG8_BAR; PG8_SCHED;
            PG8_LDB(B1, 0, 1); PG8_STAGE(PG8_SB(0, 0), b2, voffB);
            PG8_BAR; PG8_WAIT_L(0); PG8_MMA(0, 1, At, B1); PG8_BAR;
            PG8_LDA(At, 0, 1); PG8_STAGE(PG8_SA(0, 0), a2, voffA);
            PG8_BAR; PG8_WAIT_L(0); PG8_MMA(1, 0, At, B0); PG8_BAR; PG8_SCHED;
            PG8_STAGE(PG8_SB(0, 1), b2 + hstep, voffB);
            PG8_WAIT_V(6); PG8_BAR; PG8_MMA(1, 1, At, B1); PG8_BAR;
            PG8_LDB(B0, 1, 0); PG8_SCHED; PG8_LDA(At, 1, 0); PG8_STAGE(PG8_SA(0, 1), a2 + hstep, voffA);
            PG8_WAIT_L(8); PG8_BAR; PG8_WAIT_L(0); PG8_MMA(0, 0, At, B0); PG8_BAR; PG8_SCHED;
            PG8_LDB(B1, 1, 1); PG8_STAGE(PG8_SB(1, 0), b3, voffB);
            PG8_BAR; PG8_WAIT_L(0); PG8_MMA(0, 1, At, B1); PG8_BAR;
            PG8_LDA(At, 1, 1); PG8_STAGE(PG8_SA(1, 0), a3, voffA);
            PG8_BAR; PG8_WAIT_L(0); PG8_MMA(1, 0, At, B0); PG8_BAR; PG8_SCHED;
            PG8_STAGE(PG8_SB(1, 1), b3 + hstep, voffB);
            PG8_WAIT_V(6); PG8_BAR; PG8_MMA(1, 1, At, B1); PG8_BAR;
            }
        }
        if constexpr (ALIGN_EPI) { if (wr == 0) PG8_BAR; }
        if constexpr (!Epi::AFTER_DRAIN) { E(acc, cur, wr, wc, fr, fq); S.done(cur); }
        if (!has_next) break;
#pragma unroll
        for (int a = 0; a < 2; ++a)
#pragma unroll
            for (int b = 0; b < 2; ++b)
#pragma unroll
                for (int m = 0; m < 4; ++m)
#pragma unroll
                    for (int n = 0; n < 2; ++n) acc[a][b][m][n] = (f32x4){0.f, 0.f, 0.f, 0.f};
        cur = nxt; cA = nA; cB = nB; ++ui;
        if constexpr (ALIGN_EPI) { if (wr == 1) PG8_BAR; }
    }
    PG8_WAIT_V(0);
    if constexpr (!ALIGN_EPI) { if (wr == 0) PG8_BAR; }
    PG8_BAR;
    if constexpr (Epi::AFTER_DRAIN) { E.fused(acc, cur, wr, wc, fr, fq, lds, wid, lane); S.done(cur); }
#undef PG8_SA
#undef PG8_SB
#undef PG8_STAGE
#undef PG8_LDA
#undef PG8_LDB
#undef PG8_MMA
#undef PG8_WAIT_V
#undef PG8_WAIT_L
#undef PG8_BAR
#undef PG8_SCHED
}
}
#define LAS __attribute__((address_space(3)))
typedef unsigned short bf16_t;
typedef short bf16x8 __attribute__((ext_vector_type(8)));
typedef short s16x4 __attribute__((ext_vector_type(4)));
typedef float f32x4 __attribute__((ext_vector_type(4)));
typedef float f32x8 __attribute__((ext_vector_type(8)));
typedef float f32x16 __attribute__((ext_vector_type(16)));
typedef unsigned u32x4 __attribute__((ext_vector_type(4)));
typedef unsigned u32x2 __attribute__((ext_vector_type(2)));
using pg8::cvt_pk_bf16;

constexpr int NB = 8, SEQ = 4096, DM = 2048, TOK = NB * SEQ;
constexpr int N0P = 6912, P0LD = 6656, N1 = 6144;
constexpr int C_AQ = 0, C_AK = 1024, C_AV = 2048, C_AG = 3072, C_BQ = 4096, C_BK = 5120, C_BV = 5376, C_BG = 5632;
constexpr float EPS = 1e-6f;
constexpr int NTHR = 512, NWAVES = 8;
constexpr int LDS_BYTES = 159744;
constexpr size_t WS_CTL = 0;
constexpr size_t WS_CTL_BYTES = 32768;
constexpr size_t WS_BAR = 16384;
constexpr size_t WS_W0T = 32768;
constexpr size_t WS_WO0T = WS_W0T + (size_t)N0P * DM * 2;
constexpr size_t WS_W1T = WS_WO0T + (size_t)DM * DM * 2;
constexpr size_t WS_WO1T = WS_W1T + (size_t)N1 * DM * 2;
constexpr size_t WS_H = WS_WO1T + (size_t)DM * DM * 2;
constexpr size_t WS_PROJ = WS_H + (size_t)TOK * DM * 2;
constexpr size_t WS_LOG = WS_PROJ + (size_t)TOK * P0LD * 2;
constexpr size_t WS_QKV = WS_LOG + (size_t)TOK * 32 * 4 * 2;
constexpr size_t WS_YCAT = WS_QKV + (size_t)TOK * 3072 * 2;
constexpr size_t WS_PART = WS_YCAT + (size_t)TOK * DM * 2;
constexpr size_t WS_RSTD = WS_PART + (size_t)TOK * 32 * 4;
constexpr size_t WS_VST = WS_RSTD + (size_t)TOK * 4;
constexpr size_t WS_END = WS_VST + (size_t)TOK * 32 * 2 * 4;

#define LDS_WAIT() asm volatile("s_waitcnt lgkmcnt(0)" ::: "memory")
__device__ __forceinline__ float bf2f(bf16_t v) { return __builtin_bit_cast(float, (unsigned)v << 16); }
__device__ __forceinline__ float bflo(unsigned w) { return __builtin_bit_cast(float, w << 16); }
__device__ __forceinline__ float bfhi(unsigned w) { return __builtin_bit_cast(float, w & 0xffff0000u); }
__device__ __forceinline__ bf16_t f2bf(float f) { return (bf16_t)(cvt_pk_bf16(f, 0.f) & 0xffffu); }
__device__ __forceinline__ float silu_f(float x) { return x * __builtin_amdgcn_rcpf(1.f + __expf(-x)); }
__device__ __forceinline__ float wave_sum(float v) {
#pragma unroll
    for (int o = 1; o < 64; o <<= 1) v += __shfl_xor(v, o);
    return v;
}
__device__ __forceinline__ int crow(int r, int hi) { return (r & 3) + 8 * (r >> 2) + 4 * hi; }
__device__ __forceinline__ void unpack8(u32x4 w, float* f) {
    f[0] = bflo(w.x); f[1] = bfhi(w.x); f[2] = bflo(w.y); f[3] = bfhi(w.y); f[4] = bflo(w.z); f[5] = bfhi(w.z); f[6] = bflo(w.w); f[7] = bfhi(w.w);
}
__device__ __forceinline__ u32x4 pack8(const float* f) {
    u32x4 w; w.x = cvt_pk_bf16(f[0], f[1]); w.y = cvt_pk_bf16(f[2], f[3]); w.z = cvt_pk_bf16(f[4], f[5]); w.w = cvt_pk_bf16(f[6], f[7]); return w;
}

#ifdef PG_NT_STORE
#define PG_STORE_C(p, v) __builtin_nontemporal_store((v), (p))
#else
#define PG_STORE_C(p, v) (*(p) = (v))
#endif
namespace pg8 {
struct OneUnit { int pm;
    __device__ __forceinline__ bool next(int i, Unit& u) const { if (i) return false; u.pm = pm; u.pn = 0; return true; }
    __device__ __forceinline__ void a_ready(const Unit&) const {}
    __device__ __forceinline__ void done(const Unit&) const {} };
struct EpiLog {
    static constexpr bool PERM = true, AFTER_DRAIN = false;
    float* LOG;
    __device__ __forceinline__ void operator()(const f32x4 (&acc)[2][2][4][2], const Unit& u, int wr, int wc, int fr, int fq) const {
        const int row0 = u.pm * BM + wr * 64 + fr;
        if (wc == 0) {
#pragma unroll
            for (int ai = 0; ai < 2; ++ai)
#pragma unroll
                for (int m = 0; m < 4; ++m) { float* lp = LOG + (size_t)(row0 + ai * HALF + m * 16) * 32 + 8 * fq;
                    *(f32x4*)lp = acc[ai][0][m][0]; *(f32x4*)(lp + 4) = acc[ai][0][m][1]; }
        }
    }
};
struct Epi0 {
    static constexpr bool PERM = true, AFTER_DRAIN = false;
    bf16_t* P; float* LOG;
    __device__ __forceinline__ void operator()(const f32x4 (&acc)[2][2][4][2], const Unit& u, int wr, int wc, int fr, int fq) const {
        const int row0 = u.pm * BM + wr * 64 + fr;
        if (u.pn < 26) {
            const int col0 = u.pn * BM + wc * 32 + 8 * fq;
#pragma unroll
            for (int ai = 0; ai < 2; ++ai)
#pragma unroll
                for (int m = 0; m < 4; ++m) { bf16_t* rowp = P + (size_t)(row0 + ai * HALF + m * 16) * P0LD + col0;
#pragma unroll
                    for (int bj = 0; bj < 2; ++bj) { const f32x4 v0 = acc[ai][bj][m][0], v1 = acc[ai][bj][m][1];
                        ::u32x4 w; w.x = cvt_pk_bf16(v0[0], v0[1]); w.y = cvt_pk_bf16(v0[2], v0[3]); w.z = cvt_pk_bf16(v1[0], v1[1]); w.w = cvt_pk_bf16(v1[2], v1[3]);
                        PG_STORE_C((::u32x4*)(rowp + bj * HALF), w); } }
        } else if (wc == 0) {
#pragma unroll
            for (int ai = 0; ai < 2; ++ai)
#pragma unroll
                for (int m = 0; m < 4; ++m) { float* lp = LOG + (size_t)(row0 + ai * HALF + m * 16) * 32 + 8 * fq;
                    *(f32x4*)lp = acc[ai][0][m][0]; *(f32x4*)(lp + 4) = acc[ai][0][m][1]; }
        }
    }
};
struct Epi1 {
    static constexpr bool PERM = true, AFTER_DRAIN = false;
    bf16_t* P; const float* RS; float* VST;
    __device__ __forceinline__ void operator()(const f32x4 (&acc)[2][2][4][2], const Unit& u, int wr, int wc, int fr, int fq) const {
        const int row0 = u.pm * BM + wr * 64 + fr; const int col0 = u.pn * BM + wc * 32 + 8 * fq; const bool act = u.pn < 16, vst = u.pn >= 8 && u.pn < 16;
        float rsv[2][4];
#pragma unroll
        for (int ai = 0; ai < 2; ++ai)
#pragma unroll
            for (int m = 0; m < 4; ++m) rsv[ai][m] = RS[row0 + ai * HALF + m * 16];
#pragma unroll
        for (int ai = 0; ai < 2; ++ai)
#pragma unroll
            for (int m = 0; m < 4; ++m) { const int row = row0 + ai * HALF + m * 16; const float rs = rsv[ai][m]; bf16_t* rowp = P + (size_t)row * N1 + col0; float s1 = 0.f, s2 = 0.f;
#pragma unroll
                for (int bj = 0; bj < 2; ++bj) { f32x4 v0 = acc[ai][bj][m][0] * rs, v1 = acc[ai][bj][m][1] * rs;
                    if (act) { f32x2 a = gelu_pk((f32x2){v0[0], v0[1]}), b = gelu_pk((f32x2){v0[2], v0[3]}), c = gelu_pk((f32x2){v1[0], v1[1]}), d = gelu_pk((f32x2){v1[2], v1[3]});
                        v0 = (f32x4){a.x, a.y, b.x, b.y}; v1 = (f32x4){c.x, c.y, d.x, d.y}; }
                    if (vst) { s1 += (v0[0] + v0[1]) + (v0[2] + v0[3]) + (v1[0] + v1[1]) + (v1[2] + v1[3]);
                        s2 += (v0[0] * v0[0] + v0[1] * v0[1]) + (v0[2] * v0[2] + v0[3] * v0[3]) + (v1[0] * v1[0] + v1[1] * v1[1]) + (v1[2] * v1[2] + v1[3] * v1[3]); }
                    ::u32x4 w; w.x = cvt_pk_bf16(v0[0], v0[1]); w.y = cvt_pk_bf16(v0[2], v0[3]); w.z = cvt_pk_bf16(v1[0], v1[1]); w.w = cvt_pk_bf16(v1[2], v1[3]);
                    PG_STORE_C((::u32x4*)(rowp + bj * HALF), w); }
                if (vst) { s1 += __shfl_xor(s1, 16); s1 += __shfl_xor(s1, 32); s2 += __shfl_xor(s2, 16); s2 += __shfl_xor(s2, 32);
                    if (fq == 0) *(f32x2*)(VST + ((size_t)row * 32 + (u.pn - 8) * 4 + wc) * 2) = (f32x2){s1, s2}; } }
    }
};
struct EpiRes0 {
    static constexpr bool PERM = true, AFTER_DRAIN = false;
    const float* X; bf16_t* XB; float* PART;
    __device__ __forceinline__ void operator()(const f32x4 (&acc)[2][2][4][2], const Unit& u, int wr, int wc, int fr, int fq) const {
        const int row0 = u.pm * BM + wr * 64 + fr; const int col0 = u.pn * BM + wc * 32 + 8 * fq;
#pragma unroll
        for (int ai = 0; ai < 2; ++ai) {
            f32x4 xr[4][2][2];
#pragma unroll
            for (int m = 0; m < 4; ++m)
#pragma unroll
                for (int bj = 0; bj < 2; ++bj) { const size_t off = (size_t)(row0 + ai * HALF + m * 16) * DM + col0 + bj * HALF; xr[m][bj][0] = *(const f32x4*)(X + off); xr[m][bj][1] = *(const f32x4*)(X + off + 4); }
#pragma unroll
            for (int m = 0; m < 4; ++m) { const int row = row0 + ai * HALF + m * 16; const size_t off = (size_t)row * DM + col0; float ss = 0.f;
#pragma unroll
                for (int bj = 0; bj < 2; ++bj) { const f32x4 v0 = xr[m][bj][0] + acc[ai][bj][m][0], v1 = xr[m][bj][1] + acc[ai][bj][m][1];
                    ss += (v0[0] * v0[0] + v0[1] * v0[1]) + (v0[2] * v0[2] + v0[3] * v0[3]) + (v1[0] * v1[0] + v1[1] * v1[1]) + (v1[2] * v1[2] + v1[3] * v1[3]);
                    ::u32x4 w; w.x = cvt_pk_bf16(v0[0], v0[1]); w.y = cvt_pk_bf16(v0[2], v0[3]); w.z = cvt_pk_bf16(v1[0], v1[1]); w.w = cvt_pk_bf16(v1[2], v1[3]);
                    *(::u32x4*)(XB + off + bj * HALF) = w; }
                ss += __shfl_xor(ss, 16); ss += __shfl_xor(ss, 32);
                if (fq == 0) PART[(size_t)row * 32 + u.pn * 4 + wc] = ss; } }
    }
};
struct EpiRes1 {
    static constexpr bool PERM = true, AFTER_DRAIN = false;
    const bf16_t* XB; float* O;
    __device__ __forceinline__ void operator()(const f32x4 (&acc)[2][2][4][2], const Unit& u, int wr, int wc, int fr, int fq) const {
        const int row0 = u.pm * BM + wr * 64 + fr; const int col0 = u.pn * BM + wc * 32 + 8 * fq;
        ::u32x4 xbv[2][4][2];
#pragma unroll
        for (int ai = 0; ai < 2; ++ai)
#pragma unroll
            for (int m = 0; m < 4; ++m)
#pragma unroll
                for (int bj = 0; bj < 2; ++bj) xbv[ai][m][bj] = *(const ::u32x4*)(XB + (size_t)(row0 + ai * HALF + m * 16) * DM + col0 + bj * HALF);
#pragma unroll
        for (int ai = 0; ai < 2; ++ai)
#pragma unroll
            for (int m = 0; m < 4; ++m) { const size_t off = (size_t)(row0 + ai * HALF + m * 16) * DM + col0;
#pragma unroll
                for (int bj = 0; bj < 2; ++bj) { const ::u32x4 xb = xbv[ai][m][bj];
                    const f32x4 r0 = {::bflo(xb.x), ::bfhi(xb.x), ::bflo(xb.y), ::bfhi(xb.y)}, r1 = {::bflo(xb.z), ::bfhi(xb.z), ::bflo(xb.w), ::bfhi(xb.w)};
                    *(f32x4*)(O + off + bj * HALF) = r0 + acc[ai][bj][m][0]; *(f32x4*)(O + off + bj * HALF + 4) = r1 + acc[ai][bj][m][1]; } }
    }
};
}
__device__ __forceinline__ void transpose_item(const float* __restrict__ W, int K, int Nsrc, int src_n0, bf16_t* __restrict__ WT, int dst_n0, int k0, LAS float* scr, int lane, const float* __restrict__ kscale = nullptr) {
    { const int n4 = (lane & 7) * 4; f32x4 tv[8];
#pragma unroll
        for (int i = 0; i < 8; ++i) { const int kk = (lane >> 3) + 8 * i;
            tv[i] = (src_n0 >= 0) ? *(const f32x4*)(W + (size_t)(k0 + kk) * Nsrc + src_n0 + n4) * (kscale ? kscale[k0 + kk] : 1.f) : (f32x4){0.f, 0.f, 0.f, 0.f}; }
#pragma unroll
        for (int i = 0; i < 8; ++i) { const int kk = (lane >> 3) + 8 * i; LAS float* d = scr + kk * 33 + n4; d[0] = tv[i].x; d[1] = tv[i].y; d[2] = tv[i].z; d[3] = tv[i].w; } }
    LDS_WAIT(); asm volatile("" ::: "memory");
    const int c = lane & 7;
#pragma unroll
    for (int j = 0; j < 4; ++j) { const int n = (lane >> 3) + 8 * j; const LAS float* s = scr + (8 * c) * 33 + n;
        u32x4 o; o.x = cvt_pk_bf16(s[0 * 33], s[1 * 33]); o.y = cvt_pk_bf16(s[2 * 33], s[3 * 33]); o.z = cvt_pk_bf16(s[4 * 33], s[5 * 33]); o.w = cvt_pk_bf16(s[6 * 33], s[7 * 33]);
        *(u32x4*)(WT + (size_t)(dst_n0 + n) * K + k0 + 8 * c) = o; }
    LDS_WAIT(); asm volatile("" ::: "memory");
}
__device__ __forceinline__ void rms_row(const float* __restrict__ xrow, const float* __restrict__ g, bf16_t* __restrict__ orow, int lane) {
    const f32x4* xr = (const f32x4*)xrow + lane; f32x4 v[8]; float s = 0.f;
#pragma unroll
    for (int j = 0; j < 8; ++j) { v[j] = xr[64 * j]; s += (v[j].x * v[j].x + v[j].y * v[j].y) + (v[j].z * v[j].z + v[j].w * v[j].w); }
    const float r = 1.0f / sqrtf(wave_sum(s) * (1.f / DM) + EPS);
    const f32x4* gr = (const f32x4*)g + lane; u32x2* o8 = (u32x2*)orow + lane;
#pragma unroll
    for (int j = 0; j < 8; ++j) { const f32x4 gg = gr[64 * j]; u32x2 w; w.x = cvt_pk_bf16(v[j].x * r * gg.x, v[j].y * r * gg.y); w.y = cvt_pk_bf16(v[j].z * r * gg.z, v[j].w * r * gg.w); o8[64 * j] = w; }
}
__device__ __forceinline__ void rms_row2(const float* __restrict__ xa, const float* __restrict__ xb, const float* __restrict__ g, bf16_t* __restrict__ oa, bf16_t* __restrict__ ob, int lane) {
    const f32x4* xra = (const f32x4*)xa + lane; const f32x4* xrb = (const f32x4*)xb + lane; f32x4 va[8], vb[8]; float sa = 0.f, sb = 0.f;
#pragma unroll
    for (int j = 0; j < 8; ++j) { va[j] = xra[64 * j]; vb[j] = xrb[64 * j]; }
#pragma unroll
    for (int j = 0; j < 8; ++j) { sa += (va[j].x * va[j].x + va[j].y * va[j].y) + (va[j].z * va[j].z + va[j].w * va[j].w); sb += (vb[j].x * vb[j].x + vb[j].y * vb[j].y) + (vb[j].z * vb[j].z + vb[j].w * vb[j].w); }
    const float ra = 1.0f / sqrtf(wave_sum(sa) * (1.f / DM) + EPS), rb = 1.0f / sqrtf(wave_sum(sb) * (1.f / DM) + EPS);
    const f32x4* gr = (const f32x4*)g + lane; u32x2* o8a = (u32x2*)oa + lane; u32x2* o8b = (u32x2*)ob + lane;
#pragma unroll
    for (int j = 0; j < 8; ++j) { const f32x4 gg = gr[64 * j]; u32x2 w;
        w.x = cvt_pk_bf16(va[j].x * ra * gg.x, va[j].y * ra * gg.y); w.y = cvt_pk_bf16(va[j].z * ra * gg.z, va[j].w * ra * gg.w); o8a[64 * j] = w;
        w.x = cvt_pk_bf16(vb[j].x * rb * gg.x, vb[j].y * rb * gg.y); w.y = cvt_pk_bf16(vb[j].z * rb * gg.z, vb[j].w * rb * gg.w); o8b[64 * j] = w; }
}
struct P0Args { const float* x; const float* g0; const float* g1; const float* w_in0; const float* w_out0; const float* w_in1; const float* w_out1; bf16_t* W0T; bf16_t* WO0T; bf16_t* W1T; bf16_t* WO1T; bf16_t* H; };
__device__ __forceinline__ void p0_prologue(const P0Args& a, LAS unsigned char* lds, int gw, int NGW, int wave, int lane) {
    LAS float* scr = (LAS float*)(lds + wave * 16384);
    constexpr int I0 = 32 * (N0P / 32), IO = 32 * (DM / 32), I1 = 32 * (N1 / 32);
#ifdef LATE_W
    constexpr int NITEMS = I0;
#else
    constexpr int NITEMS = I0 + IO + I1 + IO;
#endif
    for (int it = gw; it < NITEMS; it += NGW) {
        int r = it;
        if (r < I0) { const int nblk = N0P / 32, kb = r / nblk, nb = r % nblk, d0 = 32 * nb;
            const int src = d0 < 4096 ? d0 : (d0 < 6656 ? d0 + 32 : (d0 == 6656 ? 4096 : -1));
            transpose_item(a.w_in0, DM, 6688, src, a.W0T, d0, 64 * kb, scr, lane); continue; }
        r -= I0;
        if (r < IO) { const int nblk = DM / 32, kb = r / nblk, nb = r % nblk; transpose_item(a.w_out0, DM, DM, 32 * nb, a.WO0T, 32 * nb, 64 * kb, scr, lane); continue; }
        r -= IO;
        if (r < I1) { const int nblk = N1 / 32, kb = r / nblk, nb = r % nblk; transpose_item(a.w_in1, DM, N1, 32 * nb, a.W1T, 32 * nb, 64 * kb, scr, lane, a.g1); continue; }
        r -= I1;
        { const int nblk = DM / 32, kb = r / nblk, nb = r % nblk; transpose_item(a.w_out1, DM, DM, 32 * nb, a.WO1T, 32 * nb, 64 * kb, scr, lane); }
    }
#ifdef P0_ROWS4
    for (int m = gw; m < TOK; m += 4 * NGW) { rms_row2(a.x + (size_t)m * DM, a.x + (size_t)(m + NGW) * DM, a.g0, a.H + (size_t)m * DM, a.H + (size_t)(m + NGW) * DM, lane);
        rms_row2(a.x + (size_t)(m + 2 * NGW) * DM, a.x + (size_t)(m + 3 * NGW) * DM, a.g0, a.H + (size_t)(m + 2 * NGW) * DM, a.H + (size_t)(m + 3 * NGW) * DM, lane); }
#else
    for (int m = gw; m < TOK; m += 2 * NGW) rms_row2(a.x + (size_t)m * DM, a.x + (size_t)(m + NGW) * DM, a.g0, a.H + (size_t)m * DM, a.H + (size_t)(m + NGW) * DM, lane);
#endif
}

constexpr int LATE_IO = 32 * (DM / 32), LATE_I1 = 32 * (N1 / 32), LATE_ITEMS = LATE_IO + LATE_I1 + LATE_IO;
__device__ __forceinline__ void p0_late_item(const P0Args& a, LAS float* scr, int r, int lane) {
    if (r < LATE_IO) { const int nblk = DM / 32, kb = r / nblk, nb = r % nblk; transpose_item(a.w_out0, DM, DM, 32 * nb, a.WO0T, 32 * nb, 64 * kb, scr, lane); return; }
    r -= LATE_IO;
    if (r < LATE_I1) { const int nblk = N1 / 32, kb = r / nblk, nb = r % nblk; transpose_item(a.w_in1, DM, N1, 32 * nb, a.W1T, 32 * nb, 64 * kb, scr, lane, a.g1); return; }
    r -= LATE_I1;
    { const int nblk = DM / 32, kb = r / nblk, nb = r % nblk; transpose_item(a.w_out1, DM, DM, 32 * nb, a.WO1T, 32 * nb, 64 * kb, scr, lane); }
}

__device__ __forceinline__ void p2_conv_item(const bf16_t* __restrict__ P, const float* __restrict__ cw, bf16_t* __restrict__ QKV, int item, int lane) {
    const int run = item / 6, slice = item % 6, t0 = run * 16, b = t0 / SEQ, l0 = t0 % SEQ, ch0 = slice * 512 + lane * 8;
    float w[5][8];
#pragma unroll
    for (int j = 0; j < 5; ++j) { const f32x4 a = *(const f32x4*)(cw + j * 3072 + ch0), c = *(const f32x4*)(cw + j * 3072 + ch0 + 4);
        w[j][0] = a.x; w[j][1] = a.y; w[j][2] = a.z; w[j][3] = a.w; w[j][4] = c.x; w[j][5] = c.y; w[j][6] = c.z; w[j][7] = c.w; }
    u32x4 rows[20];
#pragma unroll
    for (int r = 0; r < 20; ++r) { const int l = l0 - 2 + r, lc = l < 0 ? 0 : (l >= SEQ ? SEQ - 1 : l);
        rows[r] = *(const u32x4*)(P + (size_t)(b * SEQ + lc) * P0LD + ch0);
        if (l != lc) rows[r] = (u32x4){0u, 0u, 0u, 0u}; }
    float win[5][8];
#pragma unroll
    for (int j = 0; j < 5; ++j)
#pragma unroll
        for (int e = 0; e < 8; ++e) win[j][e] = 0.f;
#pragma unroll
    for (int r = 0; r < 20; ++r) {
#pragma unroll
        for (int j = 0; j < 4; ++j)
#pragma unroll
            for (int e = 0; e < 8; ++e) win[j][e] = win[j + 1][e];
        unpack8(rows[r], win[4]);
        if (r >= 4) {
            float y[8]; float ss = 0.f;
#pragma unroll
            for (int e = 0; e < 8; ++e) { float acc = 0.f;
#pragma unroll
                for (int j = 0; j < 5; ++j) acc = fmaf(w[j][e], win[j][e], acc);
                y[e] = silu_f(acc); ss = fmaf(y[e], y[e], ss); }
            if (slice < 4) {
                ss += __shfl_xor(ss, 1); ss += __shfl_xor(ss, 2); ss += __shfl_xor(ss, 4); ss += __shfl_xor(ss, 8);
                const float rn = 1.0f / sqrtf(ss + EPS);
#pragma unroll
                for (int e = 0; e < 8; ++e) y[e] *= rn;
            }
            *(u32x4*)(QKV + (size_t)(t0 + r - 4) * 3072 + ch0) = pack8(y);
        }
    }
}

template <int NT>
__device__ __forceinline__ void p2_rope_tokens(bf16_t* __restrict__ P, const float* __restrict__ qn_g, const float* __restrict__ kn_g, int t0, int tstride, int lane) {
    const int half = lane >> 5, i = lane & 31;
    const float inv = exp2f(-(float)i * (13.287712379549449f / 32.f));
    const int e1 = half * 64 + i, e2 = e1 + 32;
    const float gq1 = qn_g[e1], gq2 = qn_g[e2], gk1 = kn_g[e1], gk2 = kn_g[e2];
    float x1[NT][10], x2[NT][10];
#pragma unroll
    for (int k = 0; k < NT; ++k) { const bf16_t* row = P + (size_t)(t0 + k * tstride) * P0LD;
#pragma unroll
        for (int hh = 0; hh < 10; ++hh) { const bf16_t* hp = row + (hh < 8 ? C_BQ + hh * 128 : C_BK + (hh - 8) * 128); x1[k][hh] = bf2f(hp[e1]); x2[k][hh] = bf2f(hp[e2]); } }
#pragma unroll
    for (int k = 0; k < NT; ++k) { const int t = t0 + k * tstride, l = t % SEQ; bf16_t* row = P + (size_t)t * P0LD;
        const float pos = half ? (float)(l % 64) : (float)(l / 64);
        float rev = pos * inv * 0.15915494309189535f; rev -= floorf(rev);
        const float sn = __builtin_amdgcn_sinf(rev), cs = __builtin_amdgcn_cosf(rev);
#pragma unroll
        for (int hh = 0; hh < 10; ++hh) {
            bf16_t* hp = row + (hh < 8 ? C_BQ + hh * 128 : C_BK + (hh - 8) * 128);
            const float ss = wave_sum(x1[k][hh] * x1[k][hh] + x2[k][hh] * x2[k][hh]);
            const float rn = 1.0f / sqrtf(ss * (1.f / 128.f) + EPS);
            const float y1 = x1[k][hh] * rn * (hh < 8 ? gq1 : gk1), y2 = x2[k][hh] * rn * (hh < 8 ? gq2 : gk2);
            hp[e1] = f2bf(y1 * cs - y2 * sn); hp[e2] = f2bf(y2 * cs + y1 * sn);
        } }
}

template <int NT>
__device__ __forceinline__ void p4_tokens(const bf16_t* __restrict__ OF, const bf16_t* __restrict__ OB, const bf16_t* __restrict__ P, const float* __restrict__ og, bf16_t* __restrict__ Y, int t0, int lane) {
    u32x4 ra[NT][2], rb[NT][2], rg[NT][2];
#pragma unroll
    for (int k = 0; k < NT; ++k)
#pragma unroll
        for (int i = 0; i < 2; ++i) { const int col0 = i * 512 + lane * 8; const size_t t = (size_t)(t0 + k);
            ra[k][i] = *(const u32x4*)(OF + t * 1024 + col0); rb[k][i] = *(const u32x4*)(OB + t * 1024 + col0); rg[k][i] = *(const u32x4*)(P + t * P0LD + C_AG + col0); }
#pragma unroll
    for (int k = 0; k < NT; ++k)
#pragma unroll
        for (int i = 0; i < 2; ++i) { const int col0 = i * 512 + lane * 8; float a[8], b[8], g[8], y[8];
            unpack8(ra[k][i], a); unpack8(rb[k][i], b); unpack8(rg[k][i], g);
            float ss = 0.f;
#pragma unroll
            for (int e = 0; e < 8; ++e) { a[e] += b[e]; ss = fmaf(a[e], a[e], ss); }
            ss += __shfl_xor(ss, 1); ss += __shfl_xor(ss, 2); ss += __shfl_xor(ss, 4); ss += __shfl_xor(ss, 8);
            const float rn = 1.0f / sqrtf(ss * (1.f / 128.f) + EPS);
            const int e0 = col0 & 127;
#pragma unroll
            for (int e = 0; e < 8; ++e) y[e] = a[e] * rn * og[e0 + e] * silu_f(g[e]);
            *(u32x4*)(Y + (size_t)(t0 + k) * DM + col0) = pack8(y); }
}
namespace att {
constexpr int D = 128, NW = 8, QBLK = 32, KVBLK = 64;
constexpr float SCALE = 0.088388347648318440f;
constexpr float THR = 8.f;
constexpr int SDEPTH = 2;
constexpr int LDQ = P0LD, LDK = P0LD;
constexpr size_t SHM_V = KVBLK * D * 2, SHM_K = KVBLK * D * 2, SHM_ATTN = 2 * SHM_V + 2 * SHM_K + NW * 64 * 4;
#define KSWZ(row, colB) ((row) * 256 + ((colB) ^ (((row) & 7) << 4)))
#define SBAR() __builtin_amdgcn_sched_barrier(0)
__device__ __forceinline__ unsigned cvtpk(float lo, float hi) { unsigned r; asm volatile("v_cvt_pk_bf16_f32 %0, %1, %2" : "=v"(r) : "v"(lo), "v"(hi)); return r; }
__device__ __forceinline__ void partialSM(f32x16& p0, f32x16& p1, float& m_reg, float& mn, float& alpha) {
  constexpr float C = SCALE * 1.4426950408889634f;
  float pmax = p0[0]; for (int r = 1; r < 16; ++r) pmax = fmaxf(pmax, p0[r]); for (int r = 0; r < 16; ++r) pmax = fmaxf(pmax, p1[r]);
  { auto rr = __builtin_amdgcn_permlane32_swap(__float_as_uint(pmax), __float_as_uint(pmax), false, false);
    pmax = fmaxf(__uint_as_float(rr[0]), __uint_as_float(rr[1])); }
  if (__builtin_expect(__all(pmax - m_reg <= THR / SCALE), 1)) { mn = m_reg; alpha = 1.f; }
  else { mn = fmaxf(m_reg, pmax); alpha = __builtin_amdgcn_exp2f((m_reg - mn) * C); m_reg = mn; }
  float mnC = -mn * C;
  for (int r = 0; r < 16; ++r) p0[r] = fmaf(p0[r], C, mnC); for (int r = 0; r < 16; ++r) p1[r] = fmaf(p1[r], C, mnC);
  for (int r = 0; r < 16; ++r) p0[r] = __builtin_amdgcn_exp2f(p0[r]);
}
__device__ __forceinline__ void finishSM(f32x16& p0, f32x16& p1, float alpha, float& l_reg, bf16x8& pa0, bf16x8& pa1, bf16x8& pa2, bf16x8& pa3) {
  for (int r = 0; r < 16; ++r) p1[r] = __builtin_amdgcn_exp2f(p1[r]);
  float ps = 0; for (int r = 0; r < 16; ++r) ps += p0[r]; for (int r = 0; r < 16; ++r) ps += p1[r];
  { auto rr = __builtin_amdgcn_permlane32_swap(__float_as_uint(ps), __float_as_uint(ps), false, false);
    ps = __uint_as_float(rr[0]) + __uint_as_float(rr[1]); }
  l_reg = l_reg * alpha + ps;
#define PK4(P, BASE, OUT) do { unsigned a0 = cvtpk(P[BASE + 0], P[BASE + 1]), a1 = cvtpk(P[BASE + 2], P[BASE + 3]);   \
    unsigned b0 = cvtpk(P[BASE + 4], P[BASE + 5]), b1 = cvtpk(P[BASE + 6], P[BASE + 7]);                              \
    auto r0 = __builtin_amdgcn_permlane32_swap(a0, b0, false, false); auto r1 = __builtin_amdgcn_permlane32_swap(a1, b1, false, false); \
    u32x4 w = {r0[0], r1[0], r0[1], r1[1]}; OUT = *reinterpret_cast<bf16x8*>(&w); } while (0)
  PK4(p0, 0, pa0); PK4(p0, 8, pa1); PK4(p1, 0, pa2); PK4(p1, 8, pa3);
#undef PK4
}
__device__ __forceinline__ void qkt(f32x16& p0, f32x16& p1, const bf16_t* Ks, const bf16x8* qr, int r32, int hi) {
  p0 = f32x16{}; p1 = f32x16{};
  for (int d0 = 0; d0 < 8; ++d0) { int cb = (d0 * 16 + hi * 8) * 2;
    bf16x8 b0 = *reinterpret_cast<const bf16x8*>((const char*)Ks + KSWZ(r32, cb));
    bf16x8 b1 = *reinterpret_cast<const bf16x8*>((const char*)Ks + KSWZ(32 + r32, cb));
    p0 = __builtin_amdgcn_mfma_f32_32x32x16_bf16(b0, qr[d0], p0, 0, 0, 0);
    p1 = __builtin_amdgcn_mfma_f32_32x32x16_bf16(b1, qr[d0], p1, 0, 0, 0); }
}
__device__ __forceinline__ int v_st(int k, int c) { const int kk = (k & ~0xC) | ((k & 4) << 1) | ((k & 8) >> 1); return ((kk >> 3) * 4 + (c >> 5)) * 512 + ((kk & 7) * 32 + (c & 31)) * 2; }
__device__ __forceinline__ int v_rd_base(int lane) { return ((lane & 3) << 3) | (((lane >> 2) & 3) << 6) | (((lane >> 4) & 1) << 5) | (((lane >> 5) & 1) << 8); }
constexpr int v_rd_off(int d0, int ks, int half) { return d0 * 512 + ks * 4096 + half * 2048; }
template <int OFF> __device__ __forceinline__ s16x4 tr_read(int vb) {
  s16x4 r; asm volatile("ds_read_b64_tr_b16 %0, %1 offset:%2" : "=&v"(r) : "v"(vb), "i"(OFF) : "memory"); return r;
}
template <int D0> __device__ __forceinline__ void pv_one(f32x16& od, int vb, bf16x8 pa0, bf16x8 pa1, bf16x8 pa2, bf16x8 pa3) {
  const s16x4 l0 = tr_read<v_rd_off(D0, 0, 0)>(vb), h0 = tr_read<v_rd_off(D0, 0, 1)>(vb), l1 = tr_read<v_rd_off(D0, 1, 0)>(vb), h1 = tr_read<v_rd_off(D0, 1, 1)>(vb);
  const s16x4 l2 = tr_read<v_rd_off(D0, 2, 0)>(vb), h2 = tr_read<v_rd_off(D0, 2, 1)>(vb), l3 = tr_read<v_rd_off(D0, 3, 0)>(vb), h3 = tr_read<v_rd_off(D0, 3, 1)>(vb);
  asm volatile("s_waitcnt lgkmcnt(0)" ::: "memory"); SBAR();
#define PK(L, H) (bf16x8){L[0], L[1], L[2], L[3], H[0], H[1], H[2], H[3]}
  od = __builtin_amdgcn_mfma_f32_32x32x16_bf16(pa0, PK(l0, h0), od, 0, 0, 0);
  od = __builtin_amdgcn_mfma_f32_32x32x16_bf16(pa1, PK(l1, h1), od, 0, 0, 0);
  od = __builtin_amdgcn_mfma_f32_32x32x16_bf16(pa2, PK(l2, h2), od, 0, 0, 0);
  od = __builtin_amdgcn_mfma_f32_32x32x16_bf16(pa3, PK(l3, h3), od, 0, 0, 0);
#undef PK
}
__device__ __forceinline__ void pv_d0(f32x16* o, int vb, bf16x8 pa0, bf16x8 pa1, bf16x8 pa2, bf16x8 pa3) {
  pv_one<0>(o[0], vb, pa0, pa1, pa2, pa3); pv_one<1>(o[1], vb, pa0, pa1, pa2, pa3); pv_one<2>(o[2], vb, pa0, pa1, pa2, pa3); pv_one<3>(o[3], vb, pa0, pa1, pa2, pa3);
}
__device__ __forceinline__ void attn_dense_body(const bf16_t* __restrict__ Qb, const bf16_t* __restrict__ Kh, const bf16_t* __restrict__ Vh,
                                                const bf16_t* __restrict__ Gb, bf16_t* __restrict__ Yb, int seq, char* lds) {
  int tid = threadIdx.x; asm volatile("" : "+v"(tid));
  const int wid = tid >> 6, lane = tid & 63, r32 = lane & 31, hi = lane >> 5;
  bf16_t* V_lds = (bf16_t*)lds; bf16_t* K_lds = (bf16_t*)(lds + 2 * SHM_V);
  float* ws = (float*)(lds + 2 * SHM_V + 2 * SHM_K) + wid * 64; float* li_l = ws; float* al_l = ws + 32;
  float m_reg = -1e30f, l_reg = 0; f32x16 o[4] = {}; bf16x8 qr[8];
  const bf16_t* Qw = Qb + (long)(wid * QBLK + r32) * LDQ + hi * 8;
#pragma unroll
  for (int d0 = 0; d0 < 8; ++d0) qr[d0] = *reinterpret_cast<const bf16x8*>(Qw + d0 * 16);
  const int sr = tid >> 4, sc = (tid & 15) * 8, vst0 = v_st(sr, sc), vst1 = v_st(32 + sr, sc);
  const int vb0 = (int)(uintptr_t)V_lds + v_rd_base(lane);
  struct { bf16x8 vs0, vs1, ks0, ks1; } sr_[SDEPTH];
  const unsigned voff0 = (unsigned)((sr * LDK + sc) * 2), voff1 = voff0 + (unsigned)(32 * LDK * 2);
#define SLOAD(i, k0) do { const char* vb_ = (const char*)Vh + (size_t)(k0) * (LDK * 2); const char* kb_ = (const char*)Kh + (size_t)(k0) * (LDK * 2); \
    sr_[i].vs0 = *reinterpret_cast<const bf16x8*>(vb_ + voff0); sr_[i].vs1 = *reinterpret_cast<const bf16x8*>(vb_ + voff1); \
    sr_[i].ks0 = *reinterpret_cast<const bf16x8*>(kb_ + voff0); sr_[i].ks1 = *reinterpret_cast<const bf16x8*>(kb_ + voff1); } while (0)
#define SWRITE(b, i) do { *(bf16x8*)((char*)V_lds + (b) * SHM_V + vst0) = sr_[i].vs0;          \
    *(bf16x8*)((char*)V_lds + (b) * SHM_V + vst1) = sr_[i].vs1; int kc = sc * 2;               \
    *(bf16x8*)((char*)K_lds + (b) * SHM_K + KSWZ(sr, kc)) = sr_[i].ks0;                       \
    *(bf16x8*)((char*)K_lds + (b) * SHM_K + KSWZ(32 + sr, kc)) = sr_[i].ks1; } while (0)
#define SWAIT() do { if constexpr (SDEPTH == 2) asm volatile("s_waitcnt vmcnt(4)" ::: "memory"); else asm volatile("s_waitcnt vmcnt(0)" ::: "memory"); } while (0)
#define RESC(a) do { if (__any((a) < 1.f)) { if (hi == 0) al_l[r32] = (a); asm volatile("s_waitcnt lgkmcnt(0)" ::: "memory"); \
    for (int d = 0; d < 4; ++d) for (int r = 0; r < 16; ++r) o[d][r] *= al_l[crow(r, hi)]; } } while (0)
  f32x16 pA0, pA1, pB0, pB1; float mnA, mnB, alA, alB; bf16x8 pa0, pa1, pa2, pa3; const int NT = seq / KVBLK;
#ifdef ATT_PRIO
  if (wid >= 4) __builtin_amdgcn_s_setprio(1);
#endif
  constexpr int SE = 0, SO = SDEPTH - 1;
  const bool young = __builtin_amdgcn_readfirstlane(wid) >= 4; (void)young;
  SLOAD(SE, 0); asm volatile("s_waitcnt vmcnt(0)" ::: "memory"); SWRITE(0, SE); __syncthreads();
  qkt(pA0, pA1, K_lds, qr, r32, hi); partialSM(pA0, pA1, m_reg, mnA, alA);
  SLOAD(SO, KVBLK); if constexpr (SDEPTH == 2) { if (2 < NT) SLOAD(SE, 2 * KVBLK); }
  SWAIT(); SWRITE(1, SO); __syncthreads();
  for (int j = 1; j + 1 < NT; j += 2) {
#ifdef ATT_STAGGER
    if (!young) { SBAR(); qkt(pB0, pB1, (bf16_t*)((char*)K_lds + SHM_K), qr, r32, hi);
      finishSM(pA0, pA1, alA, l_reg, pa0, pa1, pa2, pa3); SBAR();
      SLOAD(SO, (j + SDEPTH) * KVBLK); SBAR();
      pv_d0(o, vb0, pa0, pa1, pa2, pa3); partialSM(pB0, pB1, m_reg, mnB, alB); }
    else { SBAR(); finishSM(pA0, pA1, alA, l_reg, pa0, pa1, pa2, pa3); SBAR();
      SLOAD(SO, (j + SDEPTH) * KVBLK); SBAR();
      pv_d0(o, vb0, pa0, pa1, pa2, pa3); SBAR();
      qkt(pB0, pB1, (bf16_t*)((char*)K_lds + SHM_K), qr, r32, hi); partialSM(pB0, pB1, m_reg, mnB, alB); }
    __syncthreads(); SWAIT(); SWRITE(0, SE);
    RESC(alB); __syncthreads();
    if (!young) { SBAR(); qkt(pA0, pA1, K_lds, qr, r32, hi);
      finishSM(pB0, pB1, alB, l_reg, pa0, pa1, pa2, pa3); SBAR();
      if (SDEPTH == 1 || j + 3 < NT) SLOAD(SE, (j + 1 + SDEPTH) * KVBLK); SBAR();
      pv_d0(o, vb0 + (int)SHM_V, pa0, pa1, pa2, pa3); partialSM(pA0, pA1, m_reg, mnA, alA); }
    else { SBAR(); finishSM(pB0, pB1, alB, l_reg, pa0, pa1, pa2, pa3); SBAR();
      if (SDEPTH == 1 || j + 3 < NT) SLOAD(SE, (j + 1 + SDEPTH) * KVBLK); SBAR();
      pv_d0(o, vb0 + (int)SHM_V, pa0, pa1, pa2, pa3); SBAR();
      qkt(pA0, pA1, K_lds, qr, r32, hi); partialSM(pA0, pA1, m_reg, mnA, alA); }
    __syncthreads(); SWAIT(); SWRITE(1, SO);
    RESC(alA); __syncthreads();
#else
    SBAR(); qkt(pB0, pB1, (bf16_t*)((char*)K_lds + SHM_K), qr, r32, hi);
    finishSM(pA0, pA1, alA, l_reg, pa0, pa1, pa2, pa3); SBAR();
    SLOAD(SO, (j + SDEPTH) * KVBLK); SBAR();
    pv_d0(o, vb0, pa0, pa1, pa2, pa3); partialSM(pB0, pB1, m_reg, mnB, alB);
    __syncthreads(); SWAIT(); SWRITE(0, SE);
    RESC(alB); __syncthreads();
    SBAR(); qkt(pA0, pA1, K_lds, qr, r32, hi);
    finishSM(pB0, pB1, alB, l_reg, pa0, pa1, pa2, pa3); SBAR();
    if (SDEPTH == 1 || j + 3 < NT) SLOAD(SE, (j + 1 + SDEPTH) * KVBLK); SBAR();
    pv_d0(o, vb0 + (int)SHM_V, pa0, pa1, pa2, pa3); partialSM(pA0, pA1, m_reg, mnA, alA);
    __syncthreads(); SWAIT(); SWRITE(1, SO);
    RESC(alA); __syncthreads();
#endif
  }
  SBAR(); qkt(pB0, pB1, (bf16_t*)((char*)K_lds + SHM_K), qr, r32, hi);
  finishSM(pA0, pA1, alA, l_reg, pa0, pa1, pa2, pa3); SBAR();
  pv_d0(o, vb0, pa0, pa1, pa2, pa3); partialSM(pB0, pB1, m_reg, mnB, alB);
  __syncthreads(); RESC(alB);
  finishSM(pB0, pB1, alB, l_reg, pa0, pa1, pa2, pa3); SBAR();
  pv_d0(o, vb0 + (int)SHM_V, pa0, pa1, pa2, pa3);
#ifdef ATT_PRIO
  __builtin_amdgcn_s_setprio(0);
#endif
  if (hi == 0) li_l[r32] = l_reg; asm volatile("s_waitcnt lgkmcnt(0)" ::: "memory");
  float rli[16];
#pragma unroll
  for (int r = 0; r < 16; ++r) rli[r] = __builtin_amdgcn_rcpf(li_l[crow(r, hi)]);
  const bf16_t* Gw = Gb + (long)(wid * QBLK) * LDQ; bf16_t* Yw = Yb + (long)(wid * QBLK) * DM;
  u32x4 graw[8];
#pragma unroll
  for (int it = 0; it < 8; ++it) { const int idx = it * 64 + lane, row = idx >> 4, c8 = (idx & 15) * 8; graw[it] = *(const u32x4*)((const char*)Gw + (unsigned)((row * LDQ + c8) * 2)); }
  __syncthreads();
  { bf16_t* Ol = (bf16_t*)(lds + wid * 8192);
#pragma unroll
    for (int r = 0; r < 16; ++r) { const int orow = crow(r, hi);
#pragma unroll
      for (int d0 = 0; d0 < 4; ++d0) Ol[orow * 128 + d0 * 32 + r32] = f2bf(o[d0][r] * rli[r]); }
    asm volatile("s_waitcnt lgkmcnt(0)" ::: "memory");
#pragma unroll
    for (int it = 0; it < 8; ++it) { const int idx = it * 64 + lane, row = idx >> 4, c8 = (idx & 15) * 8; float ov[8], gv[8];
      unpack8(*(const u32x4*)(Ol + row * 128 + c8), ov); unpack8(graw[it], gv);
#pragma unroll
      for (int e = 0; e < 8; ++e) ov[e] *= silu_f(gv[e]);
      *(u32x4*)((char*)Yw + (unsigned)((row * DM + c8) * 2)) = pack8(ov); } }
  __syncthreads();
#undef SLOAD
#undef SWRITE
#undef SWAIT
#undef RESC
}
}
#ifndef DN_STAGE
#define DN_STAGE 7
#endif
namespace dn {
constexpr int KC_OFF = 0, QC_OFF = 17408, KT_OFF = 34816, VT_OFF = 53248, T1_OFF = VT_OFF + 18432, T2_OFF = T1_OFF + 9216;
constexpr int VN_OFF = VT_OFF, VNS_OFF = VT_OFF + 18432;
constexpr int MT_OFF = 90112, YF_OFF = MT_OFF + 16640, AT_OFF = YF_OFF + 4224, ST_OFF = AT_OFF + 9216, MISC_OFF = ST_OFF + 34816;
static_assert(MISC_OFF + 2048 <= LDS_BYTES - 64, "deltanet LDS map");
constexpr float SCALE = 0.088388347648318440f;
struct Args { const bf16_t* QKV; const float* LOG; const float* a_log; const float* dt_bias; bf16_t* OF; bf16_t* OB; };
__device__ __forceinline__ bf16x8 ldf(const LAS unsigned char* base, int row, int strideB, int kb) { return *(const LAS bf16x8*)(base + row * strideB + kb); }
#define DN_MFMA(a, b, c) __builtin_amdgcn_mfma_f32_32x32x16_bf16(a, b, c, 0, 0, 0)
__device__ __forceinline__ void unit(const Args& a, int un, LAS unsigned char* lds) {
    int tid = threadIdx.x; asm volatile("" : "+v"(tid));
    const int w = __builtin_amdgcn_readfirstlane(tid >> 6), lane = tid & 63, r32 = lane & 31, hi = lane >> 5;
    const int b = un >> 4, h = (un >> 1) & 7, dir = un & 1, wr = w >> 2, wc = w & 3;
    const float Aexp = expf(a.a_log[dir * 8 + h]), dtb = a.dt_bias[dir * 8 + h];
    bf16_t* __restrict__ O = dir ? a.OB : a.OF;
    LAS float* MT = (LAS float*)(lds + MT_OFF); LAS float* YF = (LAS float*)(lds + YF_OFF);
    LAS float* gc = (LAS float*)(lds + MISC_OFF); LAS float* beta = gc + 64; LAS float* eg = gc + 128; LAS float* ekl = gc + 192; LAS float* scal = gc + 256;
    __syncthreads();
    for (int i = tid; i < 34816 / 16; i += NTHR) *(LAS u32x4*)(lds + ST_OFF + i * 16) = (u32x4){0u, 0u, 0u, 0u};
    f32x16 accS[2];
#pragma unroll
    for (int r = 0; r < 16; ++r) { accS[0][r] = 0.f; accS[1][r] = 0.f; }
    u32x4 pq[2], pk[2], pv[2]; float pa = 0.f, pb = 0.f;
#define DN_LOADC(n) do { _Pragma("unroll") for (int i_ = 0; i_ < 2; ++i_) { const int idx_ = tid + NTHR * i_, c_ = idx_ & 63, d8_ = (idx_ >> 6) * 8, p_ = 64 * (n) + c_, l_ = dir ? SEQ - 1 - p_ : p_; \
        const unsigned bo_ = ((unsigned)(b * SEQ + l_) * 3072u + (unsigned)(h * 128 + d8_)) * 2u; const char* s_ = (const char*)a.QKV; \
        pq[i_] = *(const u32x4*)(s_ + bo_); pk[i_] = *(const u32x4*)(s_ + (bo_ + 2048u)); pv[i_] = *(const u32x4*)(s_ + (bo_ + 4096u)); } \
        if (w == 0) { const int p_ = 64 * (n) + lane, l_ = dir ? SEQ - 1 - p_ : p_; const unsigned lo_ = ((unsigned)(b * SEQ + l_) * 32u + (unsigned)(dir * 8 + h)) * 4u; \
            const char* l2_ = (const char*)a.LOG + (size_t)TOK * 32 * 4; pa = *(const float*)((const char*)a.LOG + lo_) + *(const float*)(l2_ + lo_); pb = *(const float*)((const char*)a.LOG + (lo_ + 64u)) + *(const float*)(l2_ + (lo_ + 64u)); } } while (0)
    DN_LOADC(0);
    for (int n = 0; n < 64; ++n) {
#pragma unroll
        for (int i = 0; i < 2; ++i) { const int idx = tid + NTHR * i, c = idx & 63, d8 = (idx >> 6) * 8;
            *(LAS u32x4*)(lds + KC_OFF + c * 272 + d8 * 2) = pk[i]; *(LAS u32x4*)(lds + QC_OFF + c * 272 + d8 * 2) = pq[i];
#pragma unroll
            for (int j = 0; j < 8; ++j) { const unsigned kw = pk[i][j >> 1], vw = pv[i][j >> 1];
                *(LAS bf16_t*)(lds + KT_OFF + (d8 + j) * 144 + c * 2) = (bf16_t)((j & 1) ? (kw >> 16) : (kw & 0xffffu));
                *(LAS bf16_t*)(lds + VT_OFF + (d8 + j) * 144 + c * 2) = (bf16_t)((j & 1) ? (vw >> 16) : (vw & 0xffffu)); } }
        if (w == 0) {
#ifdef DN_SLOWGATES
            const float x = pa + dtb; const float sp = x > 20.f ? x : log1pf(expf(x));
#else
            const float x = pa + dtb; const float ex = __expf(x); const float sp = x > 15.f ? x : (ex < 1e-4f ? ex * (1.f - 0.5f * ex) : __logf(1.f + ex));
#endif
            float g = -Aexp * sp;
#pragma unroll
            for (int o = 1; o < 64; o <<= 1) { const float y = __shfl_up(g, o); if (lane >= o) g += y; }
            const float glast = __shfl(g, 63);
#ifdef DN_SLOWGATES
            gc[lane] = g; beta[lane] = 1.f / (1.f + expf(-pb)); eg[lane] = expf(g); ekl[lane] = expf(glast - g);
            if (lane == 0) scal[0] = expf(glast);
#else
            gc[lane] = g; beta[lane] = __builtin_amdgcn_rcpf(1.f + __expf(-pb)); eg[lane] = __expf(g); ekl[lane] = __expf(glast - g);
            if (lane == 0) scal[0] = __expf(glast);
#endif
        }
        __syncthreads();
#ifdef DN_DUP_SOLVE
        for (int rep2 = 0; rep2 < 2; ++rep2) {
#endif
        {
            const int q4 = w & 3, mi = q4 >> 1, nj = q4 & 1;
            f32x16 acc;
#pragma unroll
            for (int r = 0; r < 16; ++r) acc[r] = 0.f;
            const LAS unsigned char* Ab = lds + (w < 4 ? KC_OFF : QC_OFF);
#pragma unroll
            for (int ks = 0; ks < 8; ++ks) { const int kb = (ks * 16 + hi * 8) * 2;
                acc = DN_MFMA(ldf(Ab, 32 * mi + r32, 272, kb), ldf(lds + KC_OFF, 32 * nj + r32, 272, kb), acc); }
            const int j = 32 * nj + r32; const float gcj = gc[j];
            if (w < 4) {
#pragma unroll
                for (int r = 0; r < 16; ++r) { const int i = 32 * mi + crow(r, hi); const float dec = __expf(gc[i] - gcj);
                    MT[i * 65 + j] = (i > j) ? beta[i] * acc[r] * dec : 0.f; }
            } else {
#pragma unroll
                for (int r = 0; r < 16; ++r) { const int i = 32 * mi + crow(r, hi); const float dec = __expf(gc[i] - gcj);
                    *(LAS bf16_t*)(lds + AT_OFF + i * 144 + j * 2) = f2bf((i >= j) ? acc[r] * SCALE * dec : 0.f); }
            }
        }
        __syncthreads();
#ifdef DN_L0X3
        for (int rep3 = 0; rep3 < 3; ++rep3)
#endif
        if (w == 0) {
            const int base = (lane >> 4) * 16, c = lane & 15; float x[16];
#pragma unroll
            for (int i = 0; i < 16; ++i) { float acc = (i == c) ? 1.f : 0.f;
#pragma unroll
                for (int j = 0; j < i; ++j) acc = fmaf(-MT[(base + i) * 65 + base + j], x[j], acc);
                x[i] = acc;
#ifndef DN_E1
                asm volatile("" ::: "memory");
#endif
            }
            LDS_WAIT(); asm volatile("" ::: "memory");
#pragma unroll
            for (int i = 0; i < 16; ++i) MT[(base + i) * 65 + base + c] = x[i];
        }
        __syncthreads();
        {
            const int p = tid >> 8, i = (tid >> 4) & 15, j = tid & 15, R0 = 32 * p + 16, C0 = 32 * p; float y = 0.f;
#pragma unroll
            for (int k = 0; k < 16; ++k) y = fmaf(MT[(R0 + i) * 65 + C0 + k], MT[(C0 + k) * 65 + C0 + j], y);
            YF[(p * 16 + i) * 17 + j] = y;
            __syncthreads();
            float t = 0.f;
#pragma unroll
            for (int k = 0; k < 16; ++k) t = fmaf(MT[(R0 + i) * 65 + R0 + k], YF[(p * 16 + k) * 17 + j], t);
            MT[(R0 + i) * 65 + C0 + j] = -t;
        }
        __syncthreads();
        {
            const int j = tid & 31, i0 = tid >> 5; float y0 = 0.f, y1 = 0.f;
#ifdef DN_E2
#pragma unroll
#else
#pragma unroll 8
#endif
            for (int k = 0; k < 32; ++k) { const float tk = MT[k * 65 + j]; y0 = fmaf(MT[(32 + i0) * 65 + k], tk, y0); y1 = fmaf(MT[(48 + i0) * 65 + k], tk, y1); }
            YF[i0 * 33 + j] = y0; YF[(16 + i0) * 33 + j] = y1;
            __syncthreads();
            float t0 = 0.f, t1 = 0.f;
#ifdef DN_E2
#pragma unroll
#else
#pragma unroll 8
#endif
            for (int k = 0; k < 32; ++k) { const float yk = YF[k * 33 + j]; t0 = fmaf(MT[(32 + i0) * 65 + 32 + k], yk, t0); t1 = fmaf(MT[(48 + i0) * 65 + 32 + k], yk, t1); }
            MT[(32 + i0) * 65 + j] = -t0; MT[(48 + i0) * 65 + j] = -t1;
            { const float bj = beta[j], ej = eg[j];
              *(LAS bf16_t*)(lds + T1_OFF + (32 + i0) * 144 + j * 2) = f2bf(-t0 * bj); *(LAS bf16_t*)(lds + T2_OFF + (32 + i0) * 144 + j * 2) = f2bf(t0 * bj * ej);
              *(LAS bf16_t*)(lds + T1_OFF + (48 + i0) * 144 + j * 2) = f2bf(-t1 * bj); *(LAS bf16_t*)(lds + T2_OFF + (48 + i0) * 144 + j * 2) = f2bf(t1 * bj * ej); }
#pragma unroll 1
            for (int q = 0; q < 6; ++q) { const int idx = tid + NTHR * q; int i, jj;
                if (idx < 2048) { i = idx >> 6; jj = idx & 63; } else { const int r2 = idx - 2048; i = 32 + (r2 >> 5); jj = 32 + (r2 & 31); }
                const float tv = MT[i * 65 + jj] * beta[jj];
                *(LAS bf16_t*)(lds + T1_OFF + i * 144 + jj * 2) = f2bf(tv); *(LAS bf16_t*)(lds + T2_OFF + i * 144 + jj * 2) = f2bf(-tv * eg[jj]); }
        }
        __syncthreads();
#ifdef DN_DUP_SOLVE
        }
#endif
        f32x16 accU, accW;
#pragma unroll
        for (int r = 0; r < 16; ++r) { accU[r] = 0.f; accW[r] = 0.f; }
#pragma unroll
        for (int ks = 0; ks < 4; ++ks) { const int kb = (ks * 16 + hi * 8) * 2;
            accU = DN_MFMA(ldf(lds + T1_OFF, 32 * wr + r32, 144, kb), ldf(lds + VT_OFF, 32 * wc + r32, 144, kb), accU);
            accW = DN_MFMA(ldf(lds + T2_OFF, 32 * wr + r32, 144, kb), ldf(lds + KT_OFF, 32 * wc + r32, 144, kb), accW); }
#pragma unroll
        for (int r = 0; r < 16; ++r) *(LAS bf16_t*)(lds + KC_OFF + (32 * wr + crow(r, hi)) * 272 + (32 * wc + r32) * 2) = f2bf(accW[r]);
        __syncthreads();
#ifdef DN_PF_EARLY
        if (n + 1 < 64) DN_LOADC(n + 1);
#endif
        f32x16 accQ;
#pragma unroll
        for (int r = 0; r < 16; ++r) accQ[r] = 0.f;
#if DN_STAGE >= 5
#pragma unroll 2
        for (int ks = 0; ks < 8; ++ks) { const int kb = (ks * 16 + hi * 8) * 2;
            const bf16x8 bs = ldf(lds + ST_OFF, 32 * wc + r32, 272, kb);
            accU = DN_MFMA(ldf(lds + KC_OFF, 32 * wr + r32, 272, kb), bs, accU);
            accQ = DN_MFMA(ldf(lds + QC_OFF, 32 * wr + r32, 272, kb), bs, accQ); }
#pragma unroll
        for (int rg = 0; rg < 4; ++rg) { const int c0 = 32 * wr + 8 * rg + 4 * hi, e = 32 * wc + r32;
            const f32x4 sc = *(const LAS f32x4*)(ekl + c0);
            u32x2 w1, w2; w1.x = cvt_pk_bf16(accU[4 * rg], accU[4 * rg + 1]); w1.y = cvt_pk_bf16(accU[4 * rg + 2], accU[4 * rg + 3]);
            w2.x = cvt_pk_bf16(accU[4 * rg] * sc.x, accU[4 * rg + 1] * sc.y); w2.y = cvt_pk_bf16(accU[4 * rg + 2] * sc.z, accU[4 * rg + 3] * sc.w);
            *(LAS u32x2*)(lds + VN_OFF + e * 144 + c0 * 2) = w1; *(LAS u32x2*)(lds + VNS_OFF + e * 144 + c0 * 2) = w2; }
#else
        accQ = accU;
#endif
        __syncthreads();
#ifndef DN_PF_EARLY
        if (n + 1 < 64) DN_LOADC(n + 1);
#endif
#if DN_STAGE >= 6
#pragma unroll
        for (int r = 0; r < 16; ++r) accQ[r] *= SCALE * eg[32 * wr + crow(r, hi)];
#pragma unroll
        for (int ks = 0; ks < 4; ++ks) { const int kb = (ks * 16 + hi * 8) * 2;
            accQ = DN_MFMA(ldf(lds + AT_OFF, 32 * wr + r32, 144, kb), ldf(lds + VN_OFF, 32 * wc + r32, 144, kb), accQ); }
#endif
#pragma unroll
        for (int r = 0; r < 16; ++r) { const int c = 32 * wr + crow(r, hi);
            *(LAS bf16_t*)(lds + MT_OFF + c * 256 + (32 * wc + r32) * 2) = f2bf(accQ[r]); }
#if DN_STAGE >= 7
        {
            const float egl = scal[0];
#pragma unroll
            for (int r = 0; r < 16; ++r) { accS[0][r] *= egl; accS[1][r] *= egl; }
#pragma unroll
            for (int ks = 0; ks < 4; ++ks) { const int kb = (ks * 16 + hi * 8) * 2;
                const bf16x8 bsn = ldf(lds + VNS_OFF, 32 * wc + r32, 144, kb);
                accS[0] = DN_MFMA(ldf(lds + KT_OFF, 64 * wr + r32, 144, kb), bsn, accS[0]);
                accS[1] = DN_MFMA(ldf(lds + KT_OFF, 64 * wr + 32 + r32, 144, kb), bsn, accS[1]); }
#pragma unroll
            for (int mb = 0; mb < 2; ++mb)
#pragma unroll
                for (int rg = 0; rg < 4; ++rg) { const int d0 = 64 * wr + 32 * mb + 8 * rg + 4 * hi, e = 32 * wc + r32;
                    u32x2 w1; w1.x = cvt_pk_bf16(accS[mb][4 * rg], accS[mb][4 * rg + 1]); w1.y = cvt_pk_bf16(accS[mb][4 * rg + 2], accS[mb][4 * rg + 3]);
                    *(LAS u32x2*)(lds + ST_OFF + e * 272 + d0 * 2) = w1; }
        }
#endif
        __syncthreads();
#pragma unroll
        for (int i = 0; i < 2; ++i) { const int idx = tid + NTHR * i, c = idx >> 4, e8 = (idx & 15) * 8, p = 64 * n + c, l = dir ? SEQ - 1 - p : p;
            const unsigned oo = ((unsigned)(b * SEQ + l) * 1024u + (unsigned)(h * 128 + e8)) * 2u;
            *(u32x4*)((char*)O + oo) = *(const LAS u32x4*)(lds + MT_OFF + c * 256 + e8 * 2); }
    }
#undef DN_LOADC
}
}
namespace gm {
constexpr int WS_OFF = 0, VT_OFF = 34816, ST_OFF = 69632, SL_OFF = 70656, LN_OFF = 138240;
static_assert(LN_OFF + 16384 <= LDS_BYTES - 64, "gmlp LDS map");
struct Args { const bf16_t* P1; const float* ln_g; const float* ln_b; const float* ws; const float* bs; bf16_t* Z; const float* VST; };
__device__ __forceinline__ void unit(const Args& a, int cu, LAS unsigned char* lds) {
    int tid = threadIdx.x; asm volatile("" : "+v"(tid));
    const int w = __builtin_amdgcn_readfirstlane(tid >> 6), lane = tid & 63, r32 = lane & 31, hi = lane >> 5, wr = w >> 2, wc = w & 3;
    const int t0 = cu * 128;
    LAS float* mean = (LAS float*)(lds + ST_OFF); LAS float* rstd = mean + 128; LAS float* SL = (LAS float*)(lds + SL_OFF);
    LAS float* LG = (LAS float*)(lds + LN_OFF); LAS float* LB = LG + 2048;
    f32x4 pw[8]; u32x4 pvv[4], pu[4], pg[4];
#define GM_LOAD_WV(g_) do { _Pragma("unroll") for (int i_ = 0; i_ < 8; ++i_) { const int idx_ = tid + NTHR * i_; pw[i_] = *(const f32x4*)(a.ws + (size_t)(g_) * 16384 + idx_ * 4); } \
        _Pragma("unroll") for (int i_ = 0; i_ < 4; ++i_) { const int idx_ = tid + NTHR * i_, s_ = idx_ & 127, c8_ = (idx_ >> 7) * 8; \
            pvv[i_] = *(const u32x4*)((const char*)a.P1 + (unsigned)(((t0 + s_) * N1 + 2048 + (g_) * 128 + c8_) * 2)); } } while (0)
#define GM_LOAD_UG(g_) do { _Pragma("unroll") for (int i_ = 0; i_ < 4; ++i_) { const int idx_ = tid + NTHR * i_, t_ = idx_ >> 4, c8_ = (idx_ & 15) * 8; \
            const char* pr_ = (const char*)a.P1 + (unsigned)(((t0 + t_) * N1 + (g_) * 128 + c8_) * 2); pu[i_] = *(const u32x4*)pr_; pg[i_] = *(const u32x4*)(pr_ + 8192); } } while (0)
    __syncthreads();
    GM_LOAD_WV(0);
    for (int i = tid; i < 512; i += NTHR) { *(LAS f32x4*)(LG + i * 4) = *(const f32x4*)(a.ln_g + i * 4); *(LAS f32x4*)(LB + i * 4) = *(const f32x4*)(a.ln_b + i * 4); }
    { typedef float f32x2v __attribute__((ext_vector_type(2))); f32x2v pr[16];
#pragma unroll
      for (int q = 0; q < 16; ++q) pr[q] = (lane < 32) ? *(const f32x2v*)(a.VST + ((size_t)(t0 + w * 16 + q) * 32 + lane) * 2) : (f32x2v){0.f, 0.f};
#pragma unroll
      for (int q = 0; q < 16; ++q) { const float S1 = wave_sum(pr[q].x), S2 = wave_sum(pr[q].y); const float mu = S1 * (1.f / 2048.f);
          const float var = fmaxf(S2 * (1.f / 2048.f) - mu * mu, 0.f); if (lane == 0) { mean[w * 16 + q] = mu; rstd[w * 16 + q] = 1.0f / sqrtf(var + EPS); } } }
    __syncthreads();
    for (int g = 0; g < 16; ++g) {
#ifndef GM_UG_LATE
        GM_LOAD_UG(g);
#endif
#pragma unroll
        for (int i = 0; i < 8; ++i) { const int idx = tid + NTHR * i, t = idx >> 5, s4 = (idx & 31) * 4;
            u32x2 o; o.x = cvt_pk_bf16(pw[i].x, pw[i].y); o.y = cvt_pk_bf16(pw[i].z, pw[i].w); *(LAS u32x2*)(lds + WS_OFF + t * 272 + s4 * 2) = o; }
#pragma unroll
        for (int i = 0; i < 4; ++i) { const int idx = tid + NTHR * i, s = idx & 127, c8 = (idx >> 7) * 8; float x[8];
            unpack8(pvv[i], x);
            const float mu = mean[s], rs = rstd[s];
            const f32x4 g0 = *(const LAS f32x4*)(LG + g * 128 + c8), g1 = *(const LAS f32x4*)(LG + g * 128 + c8 + 4), b0 = *(const LAS f32x4*)(LB + g * 128 + c8), b1 = *(const LAS f32x4*)(LB + g * 128 + c8 + 4);
            const float gg[8] = {g0.x, g0.y, g0.z, g0.w, g1.x, g1.y, g1.z, g1.w}, bb[8] = {b0.x, b0.y, b0.z, b0.w, b1.x, b1.y, b1.z, b1.w};
#pragma unroll
            for (int j = 0; j < 8; ++j) *(LAS bf16_t*)(lds + VT_OFF + (c8 + j) * 272 + s * 2) = f2bf((x[j] - mu) * rs * gg[j] + bb[j]); }
        __syncthreads();
        if (g + 1 < 16) GM_LOAD_WV(g + 1);
#ifdef GM_UG_LATE
        GM_LOAD_UG(g);
#endif
        f32x16 acc[2];
#pragma unroll
        for (int r = 0; r < 16; ++r) { acc[0][r] = 0.f; acc[1][r] = 0.f; }
#pragma unroll
        for (int ks = 0; ks < 8; ++ks) { const int kb = (ks * 16 + hi * 8) * 2;
            const bf16x8 bv = *(const LAS bf16x8*)(lds + VT_OFF + (32 * wc + r32) * 272 + kb);
            acc[0] = __builtin_amdgcn_mfma_f32_32x32x16_bf16(*(const LAS bf16x8*)(lds + WS_OFF + (64 * wr + r32) * 272 + kb), bv, acc[0], 0, 0, 0);
            acc[1] = __builtin_amdgcn_mfma_f32_32x32x16_bf16(*(const LAS bf16x8*)(lds + WS_OFF + (64 * wr + 32 + r32) * 272 + kb), bv, acc[1], 0, 0, 0); }
#pragma unroll
        for (int mb = 0; mb < 2; ++mb) { const float* bsp = a.bs + g * 128 + 64 * wr + 32 * mb + 4 * hi;
#pragma unroll
            for (int r = 0; r < 16; ++r) { const int t = 64 * wr + 32 * mb + crow(r, hi);
                SL[t * 132 + 32 * wc + r32] = acc[mb][r] + bsp[(r & 3) + 8 * (r >> 2)]; } }
        __syncthreads();
#pragma unroll
        for (int i = 0; i < 4; ++i) { const int idx = tid + NTHR * i, t = idx >> 4, c8 = (idx & 15) * 8, col = g * 128 + c8; float uu[8], gt[8];
            unpack8(pu[i], uu); unpack8(pg[i], gt);
            const f32x4 s0 = *(const LAS f32x4*)(SL + t * 132 + c8), s1 = *(const LAS f32x4*)(SL + t * 132 + c8 + 4);
            const float sv[8] = {s0.x, s0.y, s0.z, s0.w, s1.x, s1.y, s1.z, s1.w};
#pragma unroll
            for (int e = 0; e < 8; ++e) uu[e] = uu[e] * sv[e] * silu_f(gt[e]);
            *(u32x4*)((char*)a.Z + (unsigned)(((t0 + t) * DM + col) * 2)) = pack8(uu); }
    }
#undef GM_LOAD_WV
#undef GM_LOAD_UG
}
}

#define XB_TMO      128
#define XB_XCNT(j)  (256  + 64 * (j))
#define XB_XSUB(j)  (1280 + 64 * (j))
#define XB_XGEN(j)  (2304 + 64 * (j))
#define XB_TOP      3328
#define XB_TOPGEN   3392
#define XCD_BAR_WORDS 3456
#define XB_SPIN_CAP (1u << 18)

__device__ __forceinline__ unsigned xb_ld(unsigned* p)              { return __hip_atomic_load(p, __ATOMIC_RELAXED, __HIP_MEMORY_SCOPE_AGENT); }
__device__ __forceinline__ unsigned xb_add(unsigned* p, unsigned v) { return __hip_atomic_fetch_add(p, v, __ATOMIC_RELAXED, __HIP_MEMORY_SCOPE_AGENT); }
__device__ __forceinline__ unsigned xb_xcc_id() { return (unsigned)__builtin_amdgcn_s_getreg((3 << 11) | 20) & 0xFu; }
#define XB_SPIN(cond, bar) do { unsigned _sp = 0; while (cond) { __builtin_amdgcn_s_sleep(1); \
    if ((++_sp & 255u) == 0u) { if (xb_ld(&(bar)[XB_TMO])) break; if (_sp > XB_SPIN_CAP) { atomicAdd(&(bar)[XB_TMO], 1u); break; } } } } while (0)

struct XcdBarrier {
    unsigned* bar; unsigned x;
    volatile LAS unsigned* st;
};

__device__ __forceinline__ XcdBarrier xcd_barrier_post(unsigned* bar, volatile LAS unsigned* st) {
    XcdBarrier b; b.bar = bar; b.x = xb_xcc_id(); b.st = st;
    if (threadIdx.x == 0) (void)xb_add(&bar[XB_XCNT(b.x)], 1u);
    return b;
}
__device__ __forceinline__ void xcd_barrier_complete(unsigned* bar, unsigned x, unsigned& nloc, unsigned& nx) {
    const unsigned G = gridDim.x * gridDim.y * gridDim.z;
    unsigned sum, cnt, mine, sp = 0u;
    for (;;) {
        sum = 0u; cnt = 0u; mine = 0u;
#pragma unroll
        for (unsigned j = 0; j < 16; ++j) { const unsigned c = xb_ld(&bar[XB_XCNT(j)]); sum += c; cnt += (c > 0u) ? 1u : 0u; mine = (j == x) ? c : mine; }
        if (sum == G) break;
        __builtin_amdgcn_s_sleep(1);
        if ((++sp & 255u) == 0u) { if (xb_ld(&bar[XB_TMO])) break; if (sp > XB_SPIN_CAP) { atomicAdd(&bar[XB_TMO], 1u); break; } }
    }
    nloc = mine > 0u ? mine : 1u; nx = cnt > 0u ? cnt : 1u;
}

__device__ __forceinline__ void xcd_barrier(const XcdBarrier& b) {
    asm volatile("s_waitcnt vmcnt(0)" ::: "memory");
    __syncthreads();
    if (threadIdx.x == 0) {
        unsigned* bar = b.bar;
        __builtin_amdgcn_s_waitcnt(0);
        unsigned nloc = b.st[0], nx = b.st[1];
        if (nloc == 0u) { xcd_barrier_complete(bar, b.x, nloc, nx); b.st[0] = nloc; b.st[1] = nx; }
        const unsigned old = xb_add(&bar[XB_XSUB(b.x)], 1u);
        const unsigned gen = old / nloc;
        if (old + 1u == (gen + 1u) * nloc) {
            __builtin_amdgcn_fence(__ATOMIC_RELEASE, "agent");
            asm volatile("s_waitcnt vmcnt(0)" ::: "memory");
            const unsigned og = xb_add(&bar[XB_TOP], 1u);
            const unsigned tg = og / nx;
            if (og + 1u == (tg + 1u) * nx) xb_add(&bar[XB_TOPGEN], 1u);
            else XB_SPIN(xb_ld(&bar[XB_TOPGEN]) == tg, bar);
            __builtin_amdgcn_fence(__ATOMIC_ACQUIRE, "agent");
            xb_add(&bar[XB_XGEN(b.x)], 1u);
            asm volatile("s_waitcnt vmcnt(0)" ::: "memory");
        } else {
            XB_SPIN(xb_ld(&bar[XB_XGEN(b.x)]) == gen, bar);
            __builtin_amdgcn_fence(__ATOMIC_ACQUIRE, "agent");
            asm volatile("s_waitcnt vmcnt(0)" ::: "memory");
        }
    }
    __syncthreads();
}

struct KArgs { const float* in[17]; float* out; unsigned char* ws; int ph_lo, ph_hi; };
#ifndef PROBE_END
#define PROBE_END 10
#endif
#ifndef DUMP_OFF
#define DUMP_OFF 0
#define DUMP_N 0
#endif
#ifndef DUP_PHASE
#define DUP_PHASE -1
#endif
#ifndef DUP_N
#define DUP_N 2
#endif
#define REPS(k) for (int rep_ = 0; rep_ < ((DUP_PHASE == (k)) ? DUP_N : 1); ++rep_)
#define REPSYNC(k) do { if (DUP_PHASE == (k) && rep_ + 1 < DUP_N) cg::this_grid().sync(); } while (0)
#ifndef PG_ALIGN59
#define PG_ALIGN59 true
#endif
#ifndef PG_ALIGN17
#define PG_ALIGN17 true
#endif
constexpr int NPHASES = 10;
__global__ void __launch_bounds__(NTHR, 2) fwd_megakernel(KArgs A) {
    __builtin_assume(__builtin_amdgcn_workitem_id_y() == 0); __builtin_assume(__builtin_amdgcn_workitem_id_z() == 0);
    extern __shared__ __attribute__((aligned(16))) unsigned char lds_raw[];
    LAS unsigned char* lds = (LAS unsigned char*)lds_raw;
    const int tid = threadIdx.x, lane = tid & 63, wave = __builtin_amdgcn_readfirstlane(tid >> 6);
    const int G = gridDim.x, bx = blockIdx.x, gw = bx * NWAVES + wave, NGW = G * NWAVES;
    unsigned char* ws = A.ws;
    const float* x = A.in[0];
    bf16_t* W0T = (bf16_t*)(ws + WS_W0T); bf16_t* WO0T = (bf16_t*)(ws + WS_WO0T); bf16_t* W1T = (bf16_t*)(ws + WS_W1T); bf16_t* WO1T = (bf16_t*)(ws + WS_WO1T);
    bf16_t* H = (bf16_t*)(ws + WS_H); bf16_t* PROJ = (bf16_t*)(ws + WS_PROJ); float* LOG = (float*)(ws + WS_LOG); bf16_t* QKV = (bf16_t*)(ws + WS_QKV); bf16_t* YCAT = (bf16_t*)(ws + WS_YCAT);
    bf16_t* OF = H; bf16_t* OB = H + (size_t)TOK * 1024; float* PART = (float*)(ws + WS_PART); float* RSTD = (float*)(ws + WS_RSTD);
    const int lo = A.ph_lo, hi = A.ph_hi;
    volatile LAS unsigned* xst = (volatile LAS unsigned*)(lds + LDS_BYTES - 32);
    if (tid < 2) xst[tid] = 0u;
    __syncthreads();
    XcdBarrier xbar; xbar.bar = (unsigned*)(ws + WS_BAR); xbar.x = 0; xbar.st = xst;
    if (MK_LAUNCHES == 1) xbar = xcd_barrier_post((unsigned*)(ws + WS_BAR), xst);
    if (A.ph_lo < 0) cg::this_grid().sync();
#ifndef PHMASK
#define PHMASK 0x3ff
#endif
#define IN(k) (((PHMASK >> (k)) & 1) && lo <= (k) && (k) < hi)
#ifndef SYNC_REPS
#define SYNC_REPS 1
#endif
#define SEAM(k) do { if (IN(k) && IN((k) + 1)) { for (int sr_ = 0; sr_ < SYNC_REPS; ++sr_) { if (MK_LAUNCHES != 1) cg::this_grid().sync(); else xcd_barrier(xbar); } } } while (0)
    if (IN(0)) REPS(0) { P0Args p{x, A.in[1], A.in[10], A.in[2], A.in[9], A.in[11], A.in[16], W0T, WO0T, W1T, WO1T, H}; p0_prologue(p, lds, gw, NGW, wave, lane); __syncthreads(); REPSYNC(0); }
    SEAM(0);
    if (IN(1)) REPS(1) { { pg8::Gemm g{H, W0T, TOK, P0LD, DM, DM}; pg8::StaticOrder S; S.init(TOK, P0LD, G, bx); pg8::Epi0 E{PROJ, LOG};
            pg8::gemm_phase<pg8::Epi0, pg8::StaticOrder, PG_ALIGN17, true>(lds, g, S, E); }
        for (int hu = bx; hu < 2 * (TOK / 256); hu += G) { const int kh = hu & 1;
            pg8::Gemm g{H + kh * (DM / 2), W0T + (size_t)P0LD * DM + kh * (DM / 2), TOK, 256, DM / 2, DM}; pg8::OneUnit S{hu >> 1}; pg8::EpiLog E{LOG + (size_t)kh * TOK * 32};
            pg8::gemm_phase<pg8::EpiLog, pg8::OneUnit, true, true>(lds, g, S, E); }
        REPSYNC(1); }
    SEAM(1);
    if (IN(2)) {
        REPS(2) { for (int it = gw; it < (TOK / 16) * 6; it += NGW) p2_conv_item(PROJ, A.in[3], QKV, it, lane); REPSYNC(2); }
        for (int t = gw; t < TOK; t += 2 * NGW) p2_rope_tokens<2>(PROJ, A.in[7], A.in[8], t, NGW, lane);
    }
    SEAM(2);
    if (IN(3)) REPS(3) {
        const int nq = 1, qx = 0, DNQ = 128 / nq, ATQ = 1024 / nq;
        int* ctr = (int*)(ws + WS_CTL) + 16 * qx + 128 * rep_; LAS int* slot = (LAS int*)(lds + LDS_BYTES - 16);
        int* dn_done = (int*)(ws + WS_CTL) + 512 + 64 * rep_; int* p4ctr = (int*)(ws + WS_CTL) + 768 + 64 * rep_;
#define FETCH4(item) do { __syncthreads(); if (tid == 0) *slot = atomicAdd(p4ctr, 1); __syncthreads(); item = __builtin_amdgcn_readfirstlane(*slot); } while (0)
        dn::Args da{QKV, LOG, A.in[4], A.in[5], OF, OB};
#define FETCH(item) do { __syncthreads(); if (tid == 0) *slot = atomicAdd(ctr, 1); __syncthreads(); item = __builtin_amdgcn_readfirstlane(*slot); } while (0)
        int item;
#if DUP_PHASE == 31
        for (int r31 = 0; r31 < DUP_N - 1; ++r31) { int* ctr0 = ctr; ctr = (int*)(ws + WS_CTL) + 128 + 64 * r31; FETCH(item); while (item < 128) { dn::unit(da, item, lds); FETCH(item); } ctr = ctr0; cg::this_grid().sync(); }
#endif
#if DUP_PHASE == 32
        { int* ctr0 = ctr; ctr = (int*)(ws + WS_CTL) + 128; FETCH(item); item += 128;
          while (item < DNQ + ATQ) { const int ai = qx * ATQ + (item - DNQ), qb = ai & 15, gq = (ai >> 4) & 3, kvh = (ai >> 6) & 1, b = ai >> 7, h = kvh * 4 + gq;
            const size_t r0 = (size_t)(b * SEQ + qb * 256);
            att::attn_dense_body(PROJ + r0 * P0LD + C_BQ + h * 128, PROJ + (size_t)(b * SEQ) * P0LD + C_BK + kvh * 128, PROJ + (size_t)(b * SEQ) * P0LD + C_BV + kvh * 128,
                                 PROJ + r0 * P0LD + C_BG + h * 128, YCAT + r0 * DM + 1024 + h * 128, SEQ, (char*)lds_raw);
            FETCH(item); item += 128; }
          ctr = ctr0; cg::this_grid().sync(); }
#endif
        FETCH(item);
#ifndef SKIP_DN
        while (item < DNQ) { dn::unit(da, qx * DNQ + item, lds);
            asm volatile("s_waitcnt vmcnt(0)" ::: "memory");
            __syncthreads(); if (tid == 0) { __threadfence(); atomicAdd(dn_done, 1); }
            FETCH(item); }
#endif
#ifndef SKIP_ATT
        while (item < DNQ + ATQ) { const int ai = qx * ATQ + (item - DNQ), qb = ai & 15, gq = (ai >> 4) & 3, kvh = (ai >> 6) & 1, b = ai >> 7, h = kvh * 4 + gq;
            const size_t r0 = (size_t)(b * SEQ + qb * 256);
            att::attn_dense_body(PROJ + r0 * P0LD + C_BQ + h * 128, PROJ + (size_t)(b * SEQ) * P0LD + C_BK + kvh * 128, PROJ + (size_t)(b * SEQ) * P0LD + C_BV + kvh * 128,
                                 PROJ + r0 * P0LD + C_BG + h * 128, YCAT + r0 * DM + 1024 + h * 128, SEQ, (char*)lds_raw);
            FETCH(item); }
#endif
        if (tid == 0) { while (__hip_atomic_load(dn_done, __ATOMIC_RELAXED, __HIP_MEMORY_SCOPE_AGENT) < 128) __builtin_amdgcn_s_sleep(16);
            __threadfence(); }
        __syncthreads();
        for (;;) { int c4; FETCH4(c4); if (c4 >= TOK / 128) break;
            for (int q = 0; q < 16; q += 4) p4_tokens<4>(OF, OB, PROJ, A.in[6], YCAT, c4 * 128 + wave * 16 + q, lane); }
#ifdef LATE_W
        { P0Args pl{x, A.in[1], A.in[10], A.in[2], A.in[9], A.in[11], A.in[16], W0T, WO0T, W1T, WO1T, H}; int* p5ctr = (int*)(ws + WS_CTL) + 896 + 16 * rep_;
          LAS float* scr = (LAS float*)(lds + wave * 16384);
          for (;;) { int c5; __syncthreads(); if (tid == 0) *slot = atomicAdd(p5ctr, 1); __syncthreads(); c5 = __builtin_amdgcn_readfirstlane(*slot);
              if (c5 >= LATE_ITEMS / 16) break;
              p0_late_item(pl, scr, c5 * 16 + wave * 2, lane); p0_late_item(pl, scr, c5 * 16 + wave * 2 + 1, lane); } }
#endif
        REPSYNC(3);
    }
    SEAM(3);
    if (IN(5)) REPS(5) { pg8::Gemm g{YCAT, WO0T, TOK, DM, DM, DM}; pg8::StaticOrder S; S.init(TOK, DM, G, bx); pg8::EpiRes0 E{x, H, PART};
        pg8::gemm_phase<pg8::EpiRes0, pg8::StaticOrder, PG_ALIGN59, true>(lds, g, S, E); REPSYNC(5); }
    SEAM(5);
    if (IN(6)) REPS(6) { for (int r = bx * NTHR + tid; r < TOK; r += G * NTHR) { const f32x4* pp = (const f32x4*)(PART + (size_t)r * 32); float ss = 0.f;
#pragma unroll
            for (int j = 0; j < 8; ++j) { const f32x4 v = pp[j]; ss += (v.x + v.y) + (v.z + v.w); }
            RSTD[r] = 1.0f / sqrtf(ss * (1.f / DM) + EPS); } REPSYNC(6); }
    SEAM(6);
    if (IN(7)) REPS(7) { pg8::Gemm g{H, W1T, TOK, N1, DM, DM}; pg8::StaticOrder S; S.init(TOK, N1, G, bx); pg8::Epi1 E{PROJ, RSTD, (float*)(ws + WS_VST)};
        pg8::gemm_phase<pg8::Epi1, pg8::StaticOrder, PG_ALIGN17, true>(lds, g, S, E); REPSYNC(7); }
    SEAM(7);
    if (IN(8)) REPS(8) { gm::Args ga{PROJ, A.in[12], A.in[13], A.in[14], A.in[15], YCAT, (const float*)(ws + WS_VST)};
        for (int cu = bx; cu < TOK / 128; cu += G) gm::unit(ga, cu, lds); REPSYNC(8); }
    SEAM(8);
    if (IN(9)) { pg8::Gemm g{YCAT, WO1T, TOK, DM, DM, DM}; pg8::StaticOrder S; S.init(TOK, DM, G, bx); pg8::EpiRes1 E{H, A.out};
        pg8::gemm_phase<pg8::EpiRes1, pg8::StaticOrder, PG_ALIGN59, true>(lds, g, S, E); }
#if PROBE_END < 10
    if (lo <= 10 && 10 < hi) { const bf16_t* src = (const bf16_t*)(ws + (size_t)DUMP_OFF); const size_t n = (size_t)DUMP_N, NO = (size_t)TOK * DM;
        for (size_t i = (size_t)bx * NTHR + tid; i < NO; i += (size_t)G * NTHR) { float acc = 0.f; for (size_t k = i; k < n; k += NO) { float v = bf2f(src[k]); if (!(fabsf(v) < 1e30f)) v = 7777.f; acc += v; } A.out[i] = acc; } }
#endif
}

extern "C" void kernel_launch(void* const* d_in, const int* in_sizes, int n_in, void* d_out, int out_size, void* d_ws, size_t ws_size, hipStream_t stream) {
    static int grid = 0;
    if (grid == 0) {
        if (n_in != 17 || in_sizes[0] != TOK * DM || out_size != TOK * DM || ws_size < WS_END) { fprintf(stderr, "kernel_launch: shape/workspace mismatch (n_in %d, ws %zu < %zu)\n", n_in, ws_size, (size_t)WS_END); grid = -1; return; }
        int dev = 0, cus = 0, per_cu = 0;
        (void)hipGetDevice(&dev); (void)hipDeviceGetAttribute(&cus, hipDeviceAttributeMultiprocessorCount, dev);
        if (hipFuncSetAttribute((const void*)fwd_megakernel, hipFuncAttributeMaxDynamicSharedMemorySize, LDS_BYTES) != hipSuccess) { fprintf(stderr, "hipFuncSetAttribute failed\n"); grid = -1; return; }
        if (hipOccupancyMaxActiveBlocksPerMultiprocessor(&per_cu, (const void*)fwd_megakernel, NTHR, LDS_BYTES) != hipSuccess || per_cu < 1) per_cu = 1;
        grid = cus * per_cu;
        fprintf(stderr, "kernel_launch: grid %d (%d CUs x %d)\n", grid, cus, per_cu);
    }
    if (grid < 0) return;
    (void)hipMemsetAsync((char*)d_ws + WS_CTL, 0, WS_CTL_BYTES, stream);
    KArgs a{};
    for (int i = 0; i < 17; ++i) a.in[i] = (const float*)d_in[i];
    a.out = (float*)d_out; a.ws = (unsigned char*)d_ws;
#if MK_LAUNCHES == 1
    a.ph_lo = 0; a.ph_hi = NPHASES;
    void* args[] = {&a};
    hipError_t e = hipLaunchCooperativeKernel((void*)fwd_megakernel, dim3(grid), dim3(NTHR), args, LDS_BYTES, stream);
    if (e != hipSuccess) fprintf(stderr, "cooperative launch failed: %s (grid %d)\n", hipGetErrorString(e), grid);
#else
    for (int p = 0; p < PROBE_END; ++p) { a.ph_lo = p; a.ph_hi = p + 1; hipLaunchKernelGGL(fwd_megakernel, dim3(grid), dim3(NTHR), LDS_BYTES, stream, a); }
#if PROBE_END < 10
    a.ph_lo = 10; a.ph_hi = 11; hipLaunchKernelGGL(fwd_megakernel, dim3(grid), dim3(NTHR), LDS_BYTES, stream, a);
#endif
#endif
}
```
